# Optimizing an MI355X kernel written in HIP

```python
import jax, jax.numpy as jnp
from jax import lax
import numpy as np

D_MODEL = 1024
BATCH = 8
SEQ = 2048
DEPTH = 2
DEC_BATCH = 128
DEC_SEQ = 4
PAST_LEN = 16384
PAGE_SIZE = 128

D_LRU = D_MODEL // 2
LRU_BLOCKS = 8
LRU_BW = D_LRU // LRU_BLOCKS
CONV_W = 4
LRU_C = 8.0
D_RWKV = D_MODEL - D_LRU
RWKV_HEAD = 64
RWKV_HEADS = D_RWKV // RWKV_HEAD
R_DECAY = 64
R_ICLR = 64
R_GATE = 128
D_MIX = D_LRU + D_RWKV
RWKV_PROJ_W = 3 * D_RWKV + R_DECAY + R_ICLR + R_GATE
IN_W = 2 * D_LRU + RWKV_PROJ_W
D_FF = 256 * ((8 * D_MODEL // 3 + 255) // 256)
N_MOD = 9
NORM_EPS = 1e-6
GN_EPS = 64e-5
L2_EPS = 1e-12

kernel_name = "hybrid_rglru_rwkv7_adaln_step"


def _rms(x, g):
    xf = x.astype(jnp.float32)
    y = xf * lax.rsqrt(jnp.mean(xf * xf, axis=-1, keepdims=True) + NORM_EPS)
    return (y * g.astype(jnp.float32)).astype(x.dtype)


def _modulate(h, shift, scale):
    return h * (1 + scale[:, None, :]) + shift[:, None, :]


def _swiglu(h, w_gate, w_up, w_down):
    return (jax.nn.silu(h @ w_gate) * (h @ w_up)) @ w_down


def _linear_scan(a, b, h0):
    b = b.at[:, 0].add(a[:, 0] * h0)

    def combine(left, right):
        a_l, b_l = left
        a_r, b_r = right
        return a_l * a_r, a_r * b_l + b_r

    _, h = lax.associative_scan(combine, (a, b), axis=1)
    return h


def _wkv7(S0, r, w, k, v, a, b):
    def step(S, inp):
        r_t, w_t, k_t, v_t, a_t, b_t = inp
        sa = jnp.einsum("bhvk,bhk->bhv", S, a_t)
        S = S * w_t[:, :, None, :] + sa[..., None] * b_t[:, :, None, :] + v_t[..., None] * k_t[:, :, None, :]
        return S, jnp.einsum("bhvk,bhk->bhv", S, r_t)

    xs = tuple(jnp.moveaxis(t, 1, 0) for t in (r, w, k, v, a, b))
    S, ys = lax.scan(step, S0, xs)
    return jnp.moveaxis(ys, 0, 1), S


def _rglru_group(xb, gb, conv_buf, h0, p):
    B, T, _ = xb.shape
    f32 = jnp.float32
    xpad = jnp.concatenate([conv_buf.astype(xb.dtype), xb], axis=1)
    cw = p["lru_conv_w"]
    xc = xpad[:, CONV_W - 1:] * cw[CONV_W - 1] + p["lru_conv_b"]
    for j in range(CONV_W - 1):
        xc = xc + xpad[:, j:j + T] * cw[j]
    xcb = xc.reshape(B, T, LRU_BLOCKS, LRU_BW)
    gate_x = jax.nn.sigmoid((jnp.einsum("btnc,ncd->btnd", xcb, p["lru_wx"]).reshape(B, T, D_LRU) + p["lru_bx"]).astype(f32))
    gate_a = jax.nn.sigmoid((jnp.einsum("btnc,ncd->btnd", xcb, p["lru_wa"]).reshape(B, T, D_LRU) + p["lru_ba"]).astype(f32))
    log_a = -LRU_C * gate_a * jax.nn.softplus(-p["lru_lambda"].astype(f32))
    a = jnp.exp(log_a)
    b = jnp.sqrt(-jnp.expm1(2.0 * log_a)) * gate_x * xc.astype(f32)
    h = _linear_scan(a, b, h0.astype(f32))
    y = (h * jax.nn.gelu(gb.astype(f32))).astype(xb.dtype)
    return y, xpad[:, T:], h[:, -1]


def _rwkv7_group(pr, shift_buf, S0, p):
    B, T, _ = pr.shape
    f32 = jnp.float32
    prev = jnp.concatenate([shift_buf[:, None, :].astype(pr.dtype), pr[:, :-1]], axis=1)
    xs = pr + (prev - pr) * p["rwkv_mu"]
    o1, o2, o3 = D_RWKV, 2 * D_RWKV, 3 * D_RWKV
    o4, o5 = o3 + R_DECAY, o3 + R_DECAY + R_ICLR
    r, k, v = xs[..., :o1], xs[..., o1:o2], xs[..., o2:o3]
    wd, ad, gd = xs[..., o3:o4], xs[..., o4:o5], xs[..., o5:]
    w_log = -jax.nn.softplus(-(p["rwkv_w0"] + jnp.tanh(wd) @ p["rwkv_w2"]).astype(f32)) - 0.5
    decay = jnp.exp(-jnp.exp(w_log))
    a_rate = jax.nn.sigmoid((p["rwkv_a0"] + ad @ p["rwkv_a2"]).astype(f32))
    g = (jax.nn.sigmoid(gd) @ p["rwkv_g2"]).astype(f32)

    def heads(t):
        return t.reshape(B, T, RWKV_HEADS, RWKV_HEAD)

    kf = k.astype(f32)
    kk = heads(kf * p["rwkv_k_k"])
    kk = kk / jnp.maximum(jnp.sqrt(jnp.sum(kk * kk, axis=-1, keepdims=True)), L2_EPS)
    kf = kf * (1.0 + (a_rate - 1.0) * p["rwkv_k_a"])
    rh, kh, vh = heads(r.astype(f32)), heads(kf), heads(v.astype(f32))
    y, S = _wkv7(S0.astype(f32), rh, heads(decay), kh, vh, -kk, kk * heads(a_rate))
    mu = jnp.mean(y, axis=-1, keepdims=True)
    var = jnp.mean(jnp.square(y - mu), axis=-1, keepdims=True)
    yn = ((y - mu) * lax.rsqrt(var + GN_EPS)).reshape(B, T, D_RWKV) * p["rwkv_ln_w"] + p["rwkv_ln_b"]
    bonus = jnp.sum(rh * kh * p["rwkv_r_k"], axis=-1, keepdims=True) * vh
    out = (yn + bonus.reshape(B, T, D_RWKV)) * g
    return out.astype(pr.dtype), pr[:, -1], S


def _mixer(h, conv_buf, h0, shift_buf, S0, p):
    proj = h @ p["w_in"]
    y_lru, n_conv, n_h = _rglru_group(proj[..., :D_LRU], proj[..., D_LRU:2 * D_LRU], conv_buf, h0, p)
    y_rw, n_shift, n_S = _rwkv7_group(proj[..., 2 * D_LRU:], shift_buf, S0, p)
    out = jnp.concatenate([y_lru, y_rw], axis=-1) @ p["w_out"]
    return out, (n_conv, n_h, n_shift, n_S)


def _trunk(x, c, conv, hst, shift, wkv, params, final_norm):
    cs = jax.nn.silu(c)
    outs = ([], [], [], [])
    for l in range(DEPTH):
        p = {name: arr[l] for name, arr in params.items()}
        mod = cs @ p["w_ada"] + p["b_ada"]
        sh1, sc1, g1, sh2, sc2, g2, sh3, sc3, g3 = jnp.split(mod, N_MOD, axis=-1)
        h = _modulate(_rms(x, p["ffn1_norm"]), sh1, sc1)
        x = x + 0.5 * g1[:, None, :] * _swiglu(h, p["ffn1_w_gate"], p["ffn1_w_up"], p["ffn1_w_down"])
        h = _modulate(_rms(x, p["mix_norm"]), sh2, sc2)
        m, new = _mixer(h, conv[l], hst[l], shift[l], wkv[l], p)
        x = x + g2[:, None, :] * m
        h = _modulate(_rms(x, p["ffn2_norm"]), sh3, sc3)
        x = x + 0.5 * g3[:, None, :] * _swiglu(h, p["ffn2_w_gate"], p["ffn2_w_up"], p["ffn2_w_down"])
        for lst, s in zip(outs, new):
            lst.append(s.astype(x.dtype))
    y = _rms(x, final_norm)
    return y, tuple(jnp.stack(lst) for lst in outs)


def setup_inputs(seed: int = 0) -> dict:
    key = jax.random.key(seed)
    ks = list(jax.random.split(key, 48))
    f32 = jnp.float32

    def nrm(i, shape, s):
        return s * jax.random.normal(ks[i], shape, f32)

    d = D_MODEL
    lam_u = jax.random.uniform(ks[40], (DEPTH, D_LRU), f32, 0.9, 0.999)
    lam_s = lam_u ** (1.0 / LRU_C)
    return {
        "x_prompt": nrm(0, (BATCH, SEQ, d), 1.0),
        "x_sample": nrm(1, (DEC_BATCH, DEC_SEQ, d), 1.0),
        "c_prompt": nrm(2, (BATCH, d), 1.0),
        "c_sample": nrm(3, (DEC_BATCH, d), 1.0),
        "state_lru_conv": nrm(4, (DEPTH, DEC_BATCH, CONV_W - 1, D_LRU), 1.0),
        "state_lru_h": nrm(5, (DEPTH, DEC_BATCH, D_LRU), 0.5),
        "state_rwkv_shift": nrm(6, (DEPTH, DEC_BATCH, RWKV_PROJ_W), 1.0),
        "state_rwkv_wkv": nrm(7, (DEPTH, DEC_BATCH, RWKV_HEADS, RWKV_HEAD, RWKV_HEAD), 0.3),
        "w_ada": nrm(8, (DEPTH, d, N_MOD * d), 0.5 * d ** -0.5),
        "b_ada": nrm(9, (DEPTH, N_MOD * d), 0.02),
        "ffn1_norm": 1.0 + nrm(10, (DEPTH, d), 0.05),
        "ffn1_w_gate": nrm(11, (DEPTH, d, D_FF), d ** -0.5),
        "ffn1_w_up": nrm(12, (DEPTH, d, D_FF), d ** -0.5),
        "ffn1_w_down": nrm(13, (DEPTH, D_FF, d), D_FF ** -0.5),
        "mix_norm": 1.0 + nrm(14, (DEPTH, d), 0.05),
        "w_in": nrm(15, (DEPTH, d, IN_W), d ** -0.5),
        "w_out": nrm(16, (DEPTH, D_MIX, d), D_MIX ** -0.5),
        "lru_conv_w": nrm(17, (DEPTH, CONV_W, D_LRU), CONV_W ** -0.5),
        "lru_conv_b": nrm(18, (DEPTH, D_LRU), 0.02),
        "lru_wx": nrm(19, (DEPTH, LRU_BLOCKS, LRU_BW, LRU_BW), LRU_BW ** -0.5),
        "lru_bx": nrm(20, (DEPTH, D_LRU), 0.02),
        "lru_wa": nrm(21, (DEPTH, LRU_BLOCKS, LRU_BW, LRU_BW), LRU_BW ** -0.5),
        "lru_ba": nrm(22, (DEPTH, D_LRU), 0.02),
        "lru_lambda": jnp.log(lam_s) - jnp.log1p(-lam_s),
        "rwkv_mu": jax.random.uniform(ks[23], (DEPTH, RWKV_PROJ_W), f32, 0.0, 1.0),
        "rwkv_w0": jax.random.uniform(ks[24], (DEPTH, D_RWKV), f32, -6.0, -1.0),
        "rwkv_w2": nrm(25, (DEPTH, R_DECAY, D_RWKV), 0.5 * R_DECAY ** -0.5),
        "rwkv_a0": nrm(26, (DEPTH, D_RWKV), 0.5),
        "rwkv_a2": nrm(27, (DEPTH, R_ICLR, D_RWKV), 0.5 * R_ICLR ** -0.5),
        "rwkv_g2": nrm(28, (DEPTH, R_GATE, D_RWKV), R_GATE ** -0.5),
        "rwkv_k_k": 0.85 + nrm(29, (DEPTH, D_RWKV), 0.05),
        "rwkv_k_a": 1.0 + nrm(30, (DEPTH, D_RWKV), 0.05),
        "rwkv_r_k": nrm(31, (DEPTH, RWKV_HEADS, RWKV_HEAD), 0.1),
        "rwkv_ln_w": 1.0 + nrm(32, (DEPTH, D_RWKV), 0.05),
        "rwkv_ln_b": nrm(33, (DEPTH, D_RWKV), 0.02),
        "ffn2_norm": 1.0 + nrm(34, (DEPTH, d), 0.05),
        "ffn2_w_gate": nrm(35, (DEPTH, d, D_FF), d ** -0.5),
        "ffn2_w_up": nrm(36, (DEPTH, d, D_FF), d ** -0.5),
        "ffn2_w_down": nrm(37, (DEPTH, D_FF, d), D_FF ** -0.5),
        "final_norm": 1.0 + nrm(38, (d,), 0.05),
    }


def reference(x_prompt, x_sample, c_prompt, c_sample, state_lru_conv, state_lru_h, state_rwkv_shift, state_rwkv_wkv,
              w_ada, b_ada, ffn1_norm, ffn1_w_gate, ffn1_w_up, ffn1_w_down, mix_norm, w_in, w_out,
              lru_conv_w, lru_conv_b, lru_wx, lru_bx, lru_wa, lru_ba, lru_lambda,
              rwkv_mu, rwkv_w0, rwkv_w2, rwkv_a0, rwkv_a2, rwkv_g2, rwkv_k_k, rwkv_k_a, rwkv_r_k, rwkv_ln_w, rwkv_ln_b,
              ffn2_norm, ffn2_w_gate, ffn2_w_up, ffn2_w_down, final_norm):
    params = dict(
        w_ada=w_ada, b_ada=b_ada, ffn1_norm=ffn1_norm, ffn1_w_gate=ffn1_w_gate, ffn1_w_up=ffn1_w_up,
        ffn1_w_down=ffn1_w_down, mix_norm=mix_norm, w_in=w_in, w_out=w_out,
        lru_conv_w=lru_conv_w, lru_conv_b=lru_conv_b, lru_wx=lru_wx, lru_bx=lru_bx, lru_wa=lru_wa,
        lru_ba=lru_ba, lru_lambda=lru_lambda, rwkv_mu=rwkv_mu, rwkv_w0=rwkv_w0, rwkv_w2=rwkv_w2,
        rwkv_a0=rwkv_a0, rwkv_a2=rwkv_a2, rwkv_g2=rwkv_g2, rwkv_k_k=rwkv_k_k, rwkv_k_a=rwkv_k_a,
        rwkv_r_k=rwkv_r_k, rwkv_ln_w=rwkv_ln_w, rwkv_ln_b=rwkv_ln_b, ffn2_norm=ffn2_norm,
        ffn2_w_gate=ffn2_w_gate, ffn2_w_up=ffn2_w_up, ffn2_w_down=ffn2_w_down)
    B = x_prompt.shape[0]
    dt = x_prompt.dtype
    z_conv = jnp.zeros((DEPTH, B, CONV_W - 1, D_LRU), dt)
    z_h = jnp.zeros((DEPTH, B, D_LRU), dt)
    z_shift = jnp.zeros((DEPTH, B, RWKV_PROJ_W), dt)
    z_wkv = jnp.zeros((DEPTH, B, RWKV_HEADS, RWKV_HEAD, RWKV_HEAD), dt)
    y_prompt, p_state = _trunk(x_prompt, c_prompt, z_conv, z_h, z_shift, z_wkv, params, final_norm)
    y_sample, s_state = _trunk(x_sample, c_sample, state_lru_conv, state_lru_h, state_rwkv_shift, state_rwkv_wkv,
                               params, final_norm)
    p_conv, p_h, p_shift, p_wkv = p_state
    s_conv, s_h, s_shift, s_wkv = s_state
    return (y_prompt, y_sample, p_conv, p_h, p_shift, p_wkv, s_conv, s_h, s_shift, s_wkv)
```

```cpp
#include <hip/hip_runtime.h>
#include <hip/hip_cooperative_groups.h>
#include <cstdio>
namespace cg = cooperative_groups;

#define LAS __attribute__((address_space(3)))
typedef unsigned short bf16_t;
typedef short bf16x8 __attribute__((ext_vector_type(8)));
typedef float f32x4 __attribute__((ext_vector_type(4)));
typedef float f32x2 __attribute__((ext_vector_type(2)));
typedef unsigned u32x4 __attribute__((ext_vector_type(4)));
typedef unsigned u32x2 __attribute__((ext_vector_type(2)));

constexpr int D = 1024, MTP = 16384, MTS = 512, MT = 16896, FF = 2816, INW = 2816, PW = 1792, NMR = 136;
constexpr int LDS_BYTES = 131072;
constexpr size_t SZ_WGU = (size_t)5632 * 1024 * 2, SZ_WD = (size_t)1024 * 2816 * 2, SZ_WIN = (size_t)2816 * 1024 * 2, SZ_WOUT = (size_t)1024 * 1024 * 2;
constexpr size_t WS_WGU1 = 4096, WS_WD1 = WS_WGU1 + SZ_WGU, WS_WIN = WS_WD1 + SZ_WD, WS_WOUT = WS_WIN + SZ_WIN, WS_WGU2 = WS_WOUT + SZ_WOUT, WS_WD2 = WS_WGU2 + SZ_WGU;
constexpr size_t WS_MOD = WS_WD2 + SZ_WD, SZ_MOD = (size_t)2 * NMR * 9216 * 4;
constexpr size_t WS_AADA = WS_MOD + SZ_MOD, SZ_AADA = (size_t)256 * 1024 * 2;
constexpr size_t WS_HB = WS_AADA + SZ_AADA, SZ_HB = (size_t)MT * 1024 * 2;
constexpr size_t WS_R1 = WS_HB + SZ_HB, SZ_R1 = (size_t)MT * 2816 * 2;
constexpr size_t WS_R2 = WS_R1 + SZ_R1, SZ_ARR = (size_t)MT * 512 * 2;
constexpr size_t WS_END = WS_R2 + 8 * SZ_ARR;
enum { A_LA = 0, A_GX, A_R, A_EW, A_KF, A_V, A_KK, A_BB };
constexpr size_t O_PCONV = (size_t)MT * 1024, O_PH = O_PCONV + 24576, O_PSHIFT = O_PH + 8192, O_PWKV = O_PSHIFT + 28672, O_SCONV = O_PWKV + 524288,
                 O_SH = O_SCONV + 393216, O_SSHIFT = O_SH + 131072, O_SWKV = O_SSHIFT + 458752;
enum { I_XP = 0, I_XS, I_CP, I_CS, I_SCONV, I_SH, I_SSHIFT, I_SWKV, I_WADA, I_BADA, I_F1N, I_F1G, I_F1U, I_F1D, I_MIXN, I_WIN, I_WOUT, I_CONVW, I_CONVB, I_LWX, I_LBX,
       I_LWA, I_LBA, I_LAM, I_MU, I_W0, I_W2, I_A0, I_A2, I_G2, I_KK, I_KA, I_RK, I_LNW, I_LNB, I_F2N, I_F2G, I_F2U, I_F2D, I_FN };

struct Params { const float* in[40]; float* out; unsigned char* ws; };
typedef const __attribute__((address_space(4))) Params* PP;
struct Ids { int wv, bid, nb; };
__device__ __forceinline__ int make_tid(int wv) { int lane_v; asm volatile("v_mbcnt_lo_u32_b32 %0, -1, 0\n\tv_mbcnt_hi_u32_b32 %0, -1, %0" : "=v"(lane_v)); return wv * 64 + lane_v; }
#define TID tid_local
#define BID (I.bid)
#define NB (I.nb)

__device__ __forceinline__ float bf2f(bf16_t h) { return __uint_as_float((unsigned)h << 16); }
__device__ __forceinline__ unsigned cvt_pk_bf16(float lo, float hi) { unsigned r; asm("v_cvt_pk_bf16_f32 %0, %1, %2" : "=v"(r) : "v"(lo), "v"(hi)); return r; }
__device__ __forceinline__ bf16_t f2bf(float f) { return (bf16_t)(cvt_pk_bf16(f, 0.f) & 0xffffu); }
__device__ __forceinline__ float rcpf(float x) { return __builtin_amdgcn_rcpf(x); }
__device__ __forceinline__ float sigmoidf(float x) { return rcpf(1.0f + __expf(-x)); }
__device__ __forceinline__ float tanh_f(float x) { return 1.0f - 2.0f * rcpf(1.0f + __expf(2.0f * x)); }
__device__ __forceinline__ float gelu_tanh(float x) { const float u = 0.7978845608f * (x + 0.044715f * x * x * x); return 0.5f * x * (1.0f + tanh_f(u)); }
__device__ __forceinline__ float softplusf(float x) { return fmaxf(x, 0.f) + log1pf(__expf(-fabsf(x))); }
template <int CTRL> __device__ __forceinline__ float dpp_mov(float x) {
    return __builtin_bit_cast(float, __builtin_amdgcn_update_dpp(0, __builtin_bit_cast(int, x), CTRL, 0xF, 0xF, true));
}
__device__ __forceinline__ float row16_allsum(float x) {
    x += dpp_mov<0xB1>(x); x += dpp_mov<0x4E>(x); x += dpp_mov<0x141>(x); x += dpp_mov<0x140>(x); return x;
}
__device__ __forceinline__ float wave_sum(float x) {
    x = row16_allsum(x);
    const float a = __builtin_bit_cast(float, __builtin_amdgcn_readlane(__builtin_bit_cast(int, x), 0)), b = __builtin_bit_cast(float, __builtin_amdgcn_readlane(__builtin_bit_cast(int, x), 16)),
                c = __builtin_bit_cast(float, __builtin_amdgcn_readlane(__builtin_bit_cast(int, x), 32)), d = __builtin_bit_cast(float, __builtin_amdgcn_readlane(__builtin_bit_cast(int, x), 48));
    return (a + b) + (c + d);
}
__device__ __forceinline__ int mod_row(int r) { return r < MTP ? (r >> 11) : 8 + ((r - MTP) >> 2); }
__device__ __forceinline__ int t_in_seq(int r) { return r < MTP ? (r & 2047) : ((r - MTP) & 3); }

namespace pg8 {
constexpr int BM = 256, BK = 64, HALF = 128, HTB = HALF * BK * 2, STAGE_BYTES = 8 * HTB, NXCD = 8, WGM = 8;
__device__ __forceinline__ int lds_byte(int r, int c) { const int st = (r >> 4) * 2 + (c >> 5), rr = r & 15, cc = c & 31, ob = rr * 64 + cc * 2; return st * 1024 + (ob ^ (((ob >> 9) & 1) << 5)); }
__device__ __forceinline__ void stage_rc(int b, int& R, int& C) { const int st = b / 1024, sb = b % 1024, swz = sb ^ (((sb >> 9) & 1) << 5); R = (st >> 1) * 16 + swz / 64; C = (st & 1) * 32 + (swz % 64) / 2; }
struct Unit { int pm, pn; };
struct Gemm { const bf16_t* A; const bf16_t* Bt; int M, N, K; };
struct StaticOrder {
    int nM, nN, nwg, G, c;
    __device__ void init(int M, int N, int G_, int c_) { nM = M / BM; nN = N / BM; nwg = nM * nN; G = G_; c = c_; }
    __device__ bool next(int i, Unit& u) const {
        const long L = (long)i * G + c; if (L >= nwg) return false;
        int wgid = (int)L; { const int q = nwg / NXCD, r = nwg % NXCD, xcd = wgid % NXCD, off = wgid / NXCD; wgid = (xcd < r ? xcd * (q + 1) : r * (q + 1) + (xcd - r) * q) + off; }
        const int nig = WGM * nN, gid = wgid / nig, fm = gid * WGM, gsz = (nM - fm) < WGM ? (nM - fm) : WGM;
        u.pm = fm + ((wgid % nig) % gsz); u.pn = (wgid % nig) / gsz; return true;
    }
};
template <class Epi>
__device__ __forceinline__ void gemm_phase(LAS unsigned char* lds, const Gemm g, const StaticOrder& S, const Epi& E, const Ids I) {
    const int tid_local = make_tid(I.wv);
    const int tid = TID, wid = __builtin_amdgcn_readfirstlane(tid >> 6), lane = tid & 63, wr = wid >> 2, wc = wid & 3, fr = lane & 15, fq = lane >> 4;
    const int K = g.K, nt = K / BK;
    unsigned voffA[2], voffB[2];
#pragma unroll
    for (int i = 0; i < 2; ++i) { int R, C; stage_rc(tid * 16 + i * 8192, R, C); voffA[i] = (unsigned)(R * K + C) * 2u; voffB[i] = (unsigned)(R * K + C) * 2u; }
    const size_t kstep = (size_t)(BK * 2);
    const size_t hstep = (size_t)HALF * K * 2;
    const size_t tstep = 2 * hstep;
    const unsigned ldsw = (unsigned)wid * 1024u;
    const int aoff = lds_byte(wr * 64 + fr, fq * 8), boff = lds_byte(wc * 32 + fr, fq * 8);
#define PG8_SA(b, h) (((b) * 2 + (h)) * HTB)
#define PG8_SB(b, h) ((4 + (b) * 2 + (h)) * HTB)
#define PG8_STAGE(bufoff, gbase, voff) do { _Pragma("unroll") for (int _i = 0; _i < 2; ++_i) \
        __builtin_amdgcn_global_load_lds((const unsigned*)((const char*)(gbase) + (voff)[_i]), (LAS unsigned*)(lds + (bufoff) + ldsw + _i * 8192), 16, 0, 0); } while (0)
#define PG8_LDA(dst, b, h) do { _Pragma("unroll") for (int m = 0; m < 4; ++m) _Pragma("unroll") for (int k = 0; k < 2; ++k) dst[m][k] = *(const LAS bf16x8*)(lds + PG8_SA(b, h) + aoff + m * 2048 + k * 1024); } while (0)
#define PG8_LDB(dst, b, h) do { _Pragma("unroll") for (int n = 0; n < 2; ++n) _Pragma("unroll") for (int k = 0; k < 2; ++k) dst[n][k] = *(const LAS bf16x8*)(lds + PG8_SB(b, h) + boff + n * 2048 + k * 1024); } while (0)
#define PG8_MMA(ai, bj, At, Bt) do { __builtin_amdgcn_s_setprio(1); _Pragma("unroll") for (int m = 0; m < 4; ++m) _Pragma("unroll") for (int n = 0; n < 2; ++n) _Pragma("unroll") for (int k = 0; k < 2; ++k) \
        acc[ai][bj][m][n] = __builtin_amdgcn_mfma_f32_16x16x32_bf16(Bt[n][k], At[m][k], acc[ai][bj][m][n], 0, 0, 0); __builtin_amdgcn_s_setprio(0); } while (0)
#define PG8_WAIT_V(n) asm volatile("s_waitcnt vmcnt(" #n ")" ::: "memory")
#define PG8_WAIT_L(n) asm volatile("s_waitcnt lgkmcnt(" #n ")" ::: "memory")
#define PG8_BAR __builtin_amdgcn_s_barrier()
#define PG8_SCHED __builtin_amdgcn_sched_barrier(0)
    Unit cur, nxt; int ui = 0;
    if (!S.next(0, cur)) return;
    f32x4 acc[2][2][4][2];
#pragma unroll
    for (int a = 0; a < 2; ++a)
#pragma unroll
        for (int b = 0; b < 2; ++b)
#pragma unroll
            for (int m = 0; m < 4; ++m)
#pragma unroll
                for (int n = 0; n < 2; ++n) acc[a][b][m][n] = (f32x4){0.f, 0.f, 0.f, 0.f};
    bf16x8 At[4][2], B0[2][2], B1[2][2];
    const char* cA = (const char*)g.A + (size_t)cur.pm * tstep; const char* cB = (const char*)g.Bt + (size_t)cur.pn * tstep;
    PG8_STAGE(PG8_SB(0, 0), cB, voffB); PG8_STAGE(PG8_SA(0, 0), cA, voffA); PG8_STAGE(PG8_SB(0, 1), cB + hstep, voffB); PG8_STAGE(PG8_SA(0, 1), cA + hstep, voffA);
    if (wr == 1) PG8_BAR;
    PG8_WAIT_V(4); PG8_BAR;
    PG8_STAGE(PG8_SB(1, 0), cB + kstep, voffB); PG8_STAGE(PG8_SA(1, 0), cA + kstep, voffA); PG8_STAGE(PG8_SB(1, 1), cB + hstep + kstep, voffB);
    PG8_WAIT_V(6); PG8_BAR;
    for (;;) {
        const bool has_next = S.next(ui + 1, nxt);
        const char* nA = has_next ? (const char*)g.A + (size_t)nxt.pm * tstep : cA; const char* nB = has_next ? (const char*)g.Bt + (size_t)nxt.pn * tstep : cB;
        for (int t = 0; t < nt; t += 2) {
            const bool last = (t == nt - 2);
            const char* a1 = cA + (size_t)(t + 1) * kstep;
            const char* a2 = last ? nA : cA + (size_t)(t + 2) * kstep; const char* b2 = last ? nB : cB + (size_t)(t + 2) * kstep;
            const char* a3 = a2 + kstep; const char* b3 = b2 + kstep;
            PG8_LDB(B0, 0, 0); PG8_SCHED; PG8_LDA(At, 0, 0); PG8_STAGE(PG8_SA(1, 1), a1 + hstep, voffA);
            PG8_WAIT_L(8); PG8_BAR; PG8_WAIT_L(0); PG8_MMA(0, 0, At, B0); PG8_BAR; PG8_SCHED;
            PG8_LDB(B1, 0, 1); PG8_STAGE(PG8_SB(0, 0), b2, voffB);
            PG8_BAR; PG8_WAIT_L(0); PG8_MMA(0, 1, At, B1); PG8_BAR;
            PG8_LDA(At, 0, 1); PG8_STAGE(PG8_SA(0, 0), a2, voffA);
            PG8_BAR; PG8_WAIT_L(0); PG8_MMA(1, 0, At, B0); PG8_BAR; PG8_SCHED;
            PG8_STAGE(PG8_SB(0, 1), b2 + hstep, voffB);
            PG8_WAIT_V(6); PG8_BAR; PG8_MMA(1, 1, At, B1); PG8_BAR;
            PG8_LDB(B0, 1, 0); PG8_SCHED; PG8_LDA(At, 1, 0); PG8_STAGE(PG8_SA(0, 1), a2 + hstep, voffA);
            PG8_WAIT_L(8); PG8_BAR; PG8_WAIT_L(0); PG8_MMA(0, 0, At, B0); PG8_BAR; PG8_SCHED;
            PG8_LDB(B1, 1, 1); PG8_STAGE(PG8_SB(1, 0), b3, voffB);
            PG8_BAR; PG8_WAIT_L(0); PG8_MMA(0, 1, At, B1); PG8_BAR;
            PG8_LDA(At, 1, 1); PG8_STAGE(PG8_SA(1, 0), a3, voffA);
            PG8_BAR; PG8_WAIT_L(0); PG8_MMA(1, 0, At, B0); PG8_BAR; PG8_SCHED;
            PG8_STAGE(PG8_SB(1, 1), b3 + hstep, voffB);
            PG8_WAIT_V(6); PG8_BAR; PG8_MMA(1, 1, At, B1); PG8_BAR;
        }
        E(acc, cur, wr, wc, fr, fq);
        if (!has_next) break;
#pragma unroll
        for (int a = 0; a < 2; ++a)
#pragma unroll
            for (int b = 0; b < 2; ++b)
#pragma unroll
                for (int m = 0; m < 4; ++m)
#pragma unroll
                    for (int n = 0; n < 2; ++n) acc[a][b][m][n] = (f32x4){0.f, 0.f, 0.f, 0.f};
        cur = nxt; cA = nA; cB = nB; ++ui;
    }
    PG8_WAIT_V(0);
    if (wr == 0) PG8_BAR;
    PG8_BAR;
#undef PG8_SA
#undef PG8_SB
#undef PG8_STAGE
#undef PG8_LDA
#undef PG8_LDB
#undef PG8_MMA
#undef PG8_WAIT_V
#undef PG8_WAIT_L
#undef PG8_BAR
#undef PG8_SCHED
}
}

struct EpiSwiGLU {
    bf16_t* act;
    __device__ __forceinline__ void operator()(const f32x4 (&acc)[2][2][4][2], const pg8::Unit& u, int wr, int wc, int fr, int fq) const {
        const int row0 = u.pm * 256 + wr * 64 + fr, col0 = u.pn * 128 + wc * 32 + 4 * fq;
#pragma unroll
        for (int ai = 0; ai < 2; ++ai)
#pragma unroll
            for (int m = 0; m < 4; ++m) { bf16_t* rowp = act + (size_t)(row0 + ai * 128 + m * 16) * FF + col0;
#pragma unroll
                for (int n = 0; n < 2; ++n) { const f32x4 gv = acc[ai][0][m][n], uv = acc[ai][1][m][n]; float o[4];
#pragma unroll
                    for (int j = 0; j < 4; ++j) o[j] = gv[j] * sigmoidf(gv[j]) * uv[j];
                    u32x2 w; w.x = cvt_pk_bf16(o[0], o[1]); w.y = cvt_pk_bf16(o[2], o[3]); *(u32x2*)(rowp + n * 16) = w; } }
    }
};
struct EpiResid {
    float* x; const float* gate; float scale;
    __device__ __forceinline__ void operator()(const f32x4 (&acc)[2][2][4][2], const pg8::Unit& u, int wr, int wc, int fr, int fq) const {
        const int row0 = u.pm * 256 + wr * 64 + fr, col0 = u.pn * 256 + wc * 32 + 4 * fq;
#pragma unroll
        for (int ai = 0; ai < 2; ++ai)
#pragma unroll
            for (int m = 0; m < 4; ++m) { const int row = row0 + ai * 128 + m * 16; float* rowp = x + (size_t)row * D + col0; const float* gp = gate + (size_t)mod_row(row) * 9216 + col0;
#pragma unroll
                for (int bj = 0; bj < 2; ++bj)
#pragma unroll
                    for (int n = 0; n < 2; ++n) { const f32x4 xv = *(const f32x4*)(rowp + bj * 128 + n * 16), gv = *(const f32x4*)(gp + bj * 128 + n * 16);
                        *(f32x4*)(rowp + bj * 128 + n * 16) = xv + (gv * scale) * acc[ai][bj][m][n]; }
                asm volatile("" ::: "memory"); }
    }
};
struct EpiProj {
    bf16_t* o;
    __device__ __forceinline__ void operator()(const f32x4 (&acc)[2][2][4][2], const pg8::Unit& u, int wr, int wc, int fr, int fq) const {
        const int row0 = u.pm * 256 + wr * 64 + fr, col0 = u.pn * 256 + wc * 32 + 4 * fq;
#pragma unroll
        for (int ai = 0; ai < 2; ++ai)
#pragma unroll
            for (int m = 0; m < 4; ++m) { bf16_t* rowp = o + (size_t)(row0 + ai * 128 + m * 16) * INW + col0;
#pragma unroll
                for (int bj = 0; bj < 2; ++bj)
#pragma unroll
                    for (int n = 0; n < 2; ++n) { const f32x4 v = acc[ai][bj][m][n]; u32x2 w; w.x = cvt_pk_bf16(v[0], v[1]); w.y = cvt_pk_bf16(v[2], v[3]); *(u32x2*)(rowp + bj * 128 + n * 16) = w; } }
    }
};
struct EpiAda {
    float* mod; const float* bias;
    __device__ __forceinline__ void operator()(const f32x4 (&acc)[2][2][4][2], const pg8::Unit& u, int wr, int wc, int fr, int fq) const {
        const int row0 = wr * 64 + fr, colg0 = u.pn * 256 + wc * 32 + 4 * fq; const int l = (u.pn >= 36) ? 1 : 0; const int col0 = colg0 - l * 9216;
#pragma unroll
        for (int ai = 0; ai < 2; ++ai)
#pragma unroll
            for (int m = 0; m < 4; ++m) { const int row = row0 + ai * 128 + m * 16;
                if (row < NMR) { float* rowp = mod + ((size_t)l * NMR + row) * 9216 + col0;
#pragma unroll
                    for (int bj = 0; bj < 2; ++bj)
#pragma unroll
                        for (int n = 0; n < 2; ++n) { const f32x4 bv = *(const f32x4*)(bias + colg0 + bj * 128 + n * 16); *(f32x4*)(rowp + bj * 128 + n * 16) = acc[ai][bj][m][n] + bv; } } }
    }
};
template <class Epi> __device__ __forceinline__ void run_gemm(LAS unsigned char* lds, const bf16_t* A, const bf16_t* Bt, int M, int N, int K, const Epi& E, const Ids I) {
    pg8::Gemm g{A, Bt, M, N, K}; pg8::StaticOrder S; S.init(M, N, (int)NB, (int)BID); pg8::gemm_phase<Epi>(lds, g, S, E, I);
}

__device__ __forceinline__ void conv_tile(const float* __restrict__ src, int K, int N, bf16_t* __restrict__ dst, int mode, int u, LAS float* T, const Ids I) {
    const int tid_local = make_tid(I.wv);
    const int tid = TID; const int tilesN = N >> 6; const int tk = u / tilesN, tn = u - tk * tilesN;
#pragma unroll
    for (int i = 0; i < 2; ++i) { const int kk = (tid >> 4) + 32 * i, n4 = (tid & 15) * 4;
        const f32x4 v = *(const f32x4*)(src + (size_t)(tk * 64 + kk) * N + tn * 64 + n4);
        T[(n4 + 0) * 65 + kk] = v[0]; T[(n4 + 1) * 65 + kk] = v[1]; T[(n4 + 2) * 65 + kk] = v[2]; T[(n4 + 3) * 65 + kk] = v[3]; }
    __syncthreads();
    const int n = tid >> 3, k8 = (tid & 7) * 8; const int ng = tn * 64 + n; const int dr = (mode == 0) ? ng : (((ng >> 7) << 8) + (mode == 2 ? 128 : 0) + (ng & 127));
    const LAS float* tp = T + n * 65 + k8;
    u32x4 w; w.x = cvt_pk_bf16(tp[0], tp[1]); w.y = cvt_pk_bf16(tp[2], tp[3]); w.z = cvt_pk_bf16(tp[4], tp[5]); w.w = cvt_pk_bf16(tp[6], tp[7]);
    *(u32x4*)(dst + (size_t)dr * K + tk * 64 + k8) = w;
    __syncthreads();
}
__device__ __forceinline__ void convert_layer(PP P, int l, LAS unsigned char* lds, const Ids I) {
    LAS float* T = (LAS float*)lds; unsigned char* ws = P->ws;
    const size_t wl = (size_t)l * 1024 * 2816;
    for (int u = BID; u < 7 * 704 + 256; u += NB) {
        const int mi = u / 704, uu = u - mi * 704;
        if (mi == 0)      conv_tile(P->in[I_F1G] + wl, 1024, 2816, (bf16_t*)(ws + WS_WGU1), 1, uu, T, I);
        else if (mi == 1) conv_tile(P->in[I_F1U] + wl, 1024, 2816, (bf16_t*)(ws + WS_WGU1), 2, uu, T, I);
        else if (mi == 2) conv_tile(P->in[I_F1D] + wl, 2816, 1024, (bf16_t*)(ws + WS_WD1), 0, uu, T, I);
        else if (mi == 3) conv_tile(P->in[I_WIN] + wl, 1024, 2816, (bf16_t*)(ws + WS_WIN), 0, uu, T, I);
        else if (mi == 4) conv_tile(P->in[I_F2G] + wl, 1024, 2816, (bf16_t*)(ws + WS_WGU2), 1, uu, T, I);
        else if (mi == 5) conv_tile(P->in[I_F2U] + wl, 1024, 2816, (bf16_t*)(ws + WS_WGU2), 2, uu, T, I);
        else if (mi == 6) conv_tile(P->in[I_F2D] + wl, 2816, 1024, (bf16_t*)(ws + WS_WD2), 0, uu, T, I);
        else              conv_tile(P->in[I_WOUT] + (size_t)l * 1024 * 1024, 1024, 1024, (bf16_t*)(ws + WS_WOUT), 0, uu, T, I);
    }
}
__device__ __forceinline__ void phase_prologue(PP P, LAS unsigned char* lds, const Ids I) {
    const int tid_local = make_tid(I.wv);
    convert_layer(P, 0, lds, I);
    LAS float* T = (LAS float*)lds;
    for (int u = BID; u < 2 * 2304; u += NB) {
        const int l = u / 2304, uu = u - l * 2304;
        conv_tile(P->in[I_WADA] + (size_t)l * 1024 * 9216, 1024, 9216, (bf16_t*)(P->ws + WS_R2) + (size_t)l * 9216 * 1024, 0, uu, T, I);
    }
    bf16_t* aada = (bf16_t*)(P->ws + WS_AADA);
    for (int idx = BID * 512 + TID; idx < 256 * 1024; idx += NB * 512) {
        const int row = idx >> 10, col = idx & 1023; float v = 0.f;
        if (row < 8) v = P->in[I_CP][row * 1024 + col]; else if (row < NMR) v = P->in[I_CS][(row - 8) * 1024 + col];
        aada[idx] = f2bf(v * sigmoidf(v));
    }
}

__device__ __forceinline__ void phase_norm(PP P, int l, int which, const Ids I) {
    const int tid_local = make_tid(I.wv);
    const int lane = TID & 63, gw = BID * 8 + __builtin_amdgcn_readfirstlane(TID >> 6), nw = NB * 8;
    float* xb = P->out; bf16_t* hb = (bf16_t*)(P->ws + WS_HB);
    const float* gamma = which == 0 ? P->in[I_F1N] + l * 1024 : which == 1 ? P->in[I_MIXN] + l * 1024 : which == 2 ? P->in[I_F2N] + l * 1024 : P->in[I_FN];
    const float* modl = (const float*)(P->ws + WS_MOD) + (size_t)l * NMR * 9216;
    const bool from_in = (which == 0 && l == 0);
    for (int row = gw; row < MT; row += nw) {
        const float* xr = from_in ? (row < MTP ? P->in[I_XP] + (size_t)row * D : P->in[I_XS] + (size_t)(row - MTP) * D) : xb + (size_t)row * D;
        f32x4 v[4]; float ss = 0.f;
#pragma unroll
        for (int i = 0; i < 4; ++i) { v[i] = *(const f32x4*)(xr + lane * 4 + 256 * i); ss += v[i][0] * v[i][0] + v[i][1] * v[i][1] + v[i][2] * v[i][2] + v[i][3] * v[i][3]; }
        ss = wave_sum(ss);
        const float rstd = rsqrtf(ss * (1.0f / 1024.0f) + 1e-6f);
        if (which == 3) {
#pragma unroll
            for (int i = 0; i < 4; ++i) { const int col = lane * 4 + 256 * i; const f32x4 g4 = *(const f32x4*)(gamma + col); *(f32x4*)(xb + (size_t)row * D + col) = v[i] * rstd * g4; }
        } else {
            const float* mr = modl + (size_t)mod_row(row) * 9216 + which * 3 * 1024;
#pragma unroll
            for (int i = 0; i < 4; ++i) { const int col = lane * 4 + 256 * i; const f32x4 g4 = *(const f32x4*)(gamma + col), sh = *(const f32x4*)(mr + col), sc = *(const f32x4*)(mr + 1024 + col);
                const f32x4 h = (v[i] * rstd * g4) * (sc + 1.0f) + sh; u32x2 w; w.x = cvt_pk_bf16(h[0], h[1]); w.y = cvt_pk_bf16(h[2], h[3]);
                *(u32x2*)(hb + (size_t)row * D + col) = w;
                if (from_in) *(f32x4*)(xb + (size_t)row * D + col) = v[i]; }
        }
    }
}

__device__ __forceinline__ void phase_m1(PP P, int l, LAS unsigned char* lds, const Ids I) {
    const int tid_local = make_tid(I.wv);
    const int tid = TID; unsigned char* ws = P->ws;
    const bf16_t* PR = (const bf16_t*)(ws + WS_R1);
    bf16_t* arr = (bf16_t*)(ws + WS_R2); const size_t AS = (size_t)MT * 512;
    {
        LAS float* XC = (LAS float*)lds; LAS float* WX = XC + 64 * 68; LAS float* WA = WX + 4096;
        const int d = tid & 63, tg = tid >> 6;
        for (int u = BID; u < 264 * 8; u += NB) {
            const int tt = u >> 3, n = u & 7, r0 = tt * 64, chg = n * 64 + d;
            const float* wx = P->in[I_LWX] + ((size_t)l * 8 + n) * 4096; const float* wa = P->in[I_LWA] + ((size_t)l * 8 + n) * 4096;
#pragma unroll
            for (int i = 0; i < 8; ++i) { WX[tid + 512 * i] = wx[tid + 512 * i]; WA[tid + 512 * i] = wa[tid + 512 * i]; }
            const float* cw = P->in[I_CONVW] + (size_t)l * 4 * 512; const float cwv[4] = {cw[chg], cw[512 + chg], cw[1024 + chg], cw[1536 + chg]}; const float cb = P->in[I_CONVB][l * 512 + chg];
#pragma unroll
            for (int i = 0; i < 8; ++i) { const int r = r0 + tg * 8 + i, t = t_in_seq(r); float a = cb;
#pragma unroll
                for (int j = 0; j < 4; ++j) { const int ts = t - 3 + j; float xv;
                    if (ts >= 0) xv = bf2f(PR[(size_t)(r - 3 + j) * INW + chg]);
                    else xv = (r < MTP) ? 0.f : P->in[I_SCONV][(((size_t)l * 128 + ((r - MTP) >> 2)) * 3 + (ts + 3)) * 512 + chg];
                    a += xv * cwv[j]; }
                XC[d * 68 + tg * 8 + i] = a; }
            __syncthreads();
            float ax[8], aa[8];
#pragma unroll
            for (int i = 0; i < 8; ++i) { ax[i] = 0.f; aa[i] = 0.f; }
#pragma unroll 4
            for (int c = 0; c < 64; ++c) { const float wxv = WX[c * 64 + d], wav = WA[c * 64 + d];
                const f32x4 x0 = *(const LAS f32x4*)(XC + c * 68 + tg * 8), x1 = *(const LAS f32x4*)(XC + c * 68 + tg * 8 + 4);
#pragma unroll
                for (int i = 0; i < 4; ++i) { ax[i] += x0[i] * wxv; aa[i] += x0[i] * wav; ax[4 + i] += x1[i] * wxv; aa[4 + i] += x1[i] * wav; } }
            const float bx = P->in[I_LBX][l * 512 + chg], ba = P->in[I_LBA][l * 512 + chg], sp = softplusf(-P->in[I_LAM][l * 512 + chg]);
#pragma unroll
            for (int i = 0; i < 8; ++i) { const int r = r0 + tg * 8 + i; const float gxv = sigmoidf(ax[i] + bx), gav = sigmoidf(aa[i] + ba), la = -8.0f * gav * sp, xc = XC[d * 68 + tg * 8 + i];
                arr[A_LA * AS + (size_t)r * 512 + chg] = f2bf(la); arr[A_GX * AS + (size_t)r * 512 + chg] = f2bf(gxv * xc); }
            __syncthreads();
        }
    }
    {
        LAS float* TW = (LAS float*)lds; LAS float* AD = TW + 1024;
        const int d = tid; const float* mu = P->in[I_MU] + (size_t)l * PW;
        const float w0 = P->in[I_W0][l * 512 + d], a0 = P->in[I_A0][l * 512 + d], kkw = P->in[I_KK][l * 512 + d], kaw = P->in[I_KA][l * 512 + d];
        const float mur = mu[d], muk = mu[512 + d], muv = mu[1024 + d];
        const float* w2 = P->in[I_W2] + (size_t)l * 64 * 512 + d; const float* a2 = P->in[I_A2] + (size_t)l * 64 * 512 + d;
        for (int u = BID; u < MT / 16; u += NB) {
            const int r0 = u * 16;
#pragma unroll
            for (int i = 0; i < 4; ++i) { const int idx = tid + 512 * i, tok = idx >> 7, col = idx & 127, r = r0 + tok, t = t_in_seq(r);
                const float cur = bf2f(PR[(size_t)r * INW + 2560 + col]);
                const float prev = t > 0 ? bf2f(PR[(size_t)(r - 1) * INW + 2560 + col]) : (r < MTP ? 0.f : P->in[I_SSHIFT][((size_t)l * 128 + ((r - MTP) >> 2)) * PW + 1536 + col]);
                const float xs = cur + (prev - cur) * mu[1536 + col];
                if (col < 64) TW[col * 16 + tok] = tanh_f(xs); else AD[(col - 64) * 16 + tok] = xs; }
            __syncthreads();
            float aw[16], aa[16];
#pragma unroll
            for (int i = 0; i < 16; ++i) { aw[i] = 0.f; aa[i] = 0.f; }
#pragma unroll 2
            for (int c = 0; c < 64; ++c) { const float w2v = w2[c * 512], a2v = a2[c * 512];
#pragma unroll
                for (int q = 0; q < 4; ++q) { const f32x4 tw = *(const LAS f32x4*)(TW + c * 16 + q * 4), ad = *(const LAS f32x4*)(AD + c * 16 + q * 4);
#pragma unroll
                    for (int j = 0; j < 4; ++j) { aw[q * 4 + j] += tw[j] * w2v; aa[q * 4 + j] += ad[j] * a2v; } } }
#pragma unroll 4
            for (int i = 0; i < 16; ++i) { const int r = r0 + i, t = t_in_seq(r); const bf16_t* pc = PR + (size_t)r * INW + 1024 + d;
                const float cr = bf2f(pc[0]), ck = bf2f(pc[512]), cv = bf2f(pc[1024]); float pr_, pk_, pv_;
                if (t > 0) { pr_ = bf2f(pc[-INW]); pk_ = bf2f(pc[512 - INW]); pv_ = bf2f(pc[1024 - INW]); }
                else if (r < MTP) { pr_ = 0.f; pk_ = 0.f; pv_ = 0.f; }
                else { const float* sp = P->in[I_SSHIFT] + ((size_t)l * 128 + ((r - MTP) >> 2)) * PW + d; pr_ = sp[0]; pk_ = sp[512]; pv_ = sp[1024]; }
                const float xr = cr + (pr_ - cr) * mur, xk = ck + (pk_ - ck) * muk, xv = cv + (pv_ - cv) * muv;
                const float ew = 0.60653066f * sigmoidf(w0 + aw[i]);
                const float ar = sigmoidf(a0 + aa[i]);
                float kk = xk * kkw; const float ssq = wave_sum(kk * kk); kk = kk / fmaxf(sqrtf(ssq), 1e-12f);
                const float kf = xk * (1.0f + (ar - 1.0f) * kaw);
                const size_t o = (size_t)r * 512 + d;
                arr[A_R * AS + o] = f2bf(xr); arr[A_EW * AS + o] = f2bf(ew); arr[A_KF * AS + o] = f2bf(kf); arr[A_V * AS + o] = f2bf(xv); arr[A_KK * AS + o] = f2bf(kk); arr[A_BB * AS + o] = f2bf(kk * ar); }
            __syncthreads();
        }
    }
    for (int idx = BID * 512 + tid; idx < NMR * 3328; idx += NB * 512) {
        const int m = idx / 3328, e = idx - m * 3328;
        if (e < 1536) { const int j = e >> 9, ch = e & 511; const int row = (m < 8) ? m * 2048 + 2045 + j : MTP + (m - 8) * 4 + 1 + j; const float v = bf2f(PR[(size_t)row * INW + ch]);
            if (m < 8) P->out[O_PCONV + (((size_t)l * 8 + m) * 3 + j) * 512 + ch] = v; else P->out[O_SCONV + (((size_t)l * 128 + (m - 8)) * 3 + j) * 512 + ch] = v; }
        else { const int col = e - 1536; const int row = (m < 8) ? m * 2048 + 2047 : MTP + (m - 8) * 4 + 3; const float v = bf2f(PR[(size_t)row * INW + 1024 + col]);
            if (m < 8) P->out[O_PSHIFT + ((size_t)l * 8 + m) * PW + col] = v; else P->out[O_SSHIFT + ((size_t)l * 128 + (m - 8)) * PW + col] = v; }
    }
}

__device__ __forceinline__ void scan_lru(PP P, int l, LAS unsigned char* lds, const Ids I) {
    const int tid = make_tid(I.wv); unsigned char* ws = P->ws;
    const bf16_t* PR = (const bf16_t*)(ws + WS_R1); const bf16_t* LA = (const bf16_t*)(ws + WS_R2) + (size_t)A_LA * MT * 512; const bf16_t* GX = (const bf16_t*)(ws + WS_R2) + (size_t)A_GX * MT * 512;
    bf16_t* ymix = (bf16_t*)(ws + WS_HB); float* out = P->out;
    LAS f32x2* AB = (LAS f32x2*)lds;
    for (int u = BID; u < 256; u += NB) {
        const int b = u >> 5, ch = (u & 31) * 16 + (tid & 15), chunk = tid >> 4; const unsigned row0 = (unsigned)b * 2048u + (unsigned)chunk * 64u;
        float A = 1.f, B = 0.f;
#pragma unroll 4
        for (unsigned s = 0; s < 64; ++s) { const unsigned o = (row0 + s) * 512u + ch; const float la = bf2f(LA[o]), gx = bf2f(GX[o]); const float a = __expf(la), bb = sqrtf(fmaxf(1.f - a * a, 0.f)) * gx;
            B = a * B + bb; A *= a; }
        AB[chunk * 16 + (tid & 15)] = (f32x2){A, B};
        __syncthreads();
        float h = 0.f;
        for (int c = 0; c < chunk; ++c) { const f32x2 ab = AB[c * 16 + (tid & 15)]; h = ab.x * h + ab.y; }
#pragma unroll 4
        for (unsigned s = 0; s < 64; ++s) { const unsigned row = row0 + s, o = row * 512u + ch; const float la = bf2f(LA[o]), gx = bf2f(GX[o]); const float a = __expf(la), bb = sqrtf(fmaxf(1.f - a * a, 0.f)) * gx;
            h = a * h + bb; const float gb = bf2f(PR[row * (unsigned)INW + 512u + ch]); ymix[row * 1024u + ch] = f2bf(h * gelu_tanh(gb)); }
        if (chunk == 31) out[O_PH + (unsigned)(l * 8 + b) * 512u + ch] = h;
        __syncthreads();
    }
    for (int g = BID * 512 + tid; g < 128 * 512; g += NB * 512) {
        const int sb = g >> 9, ch = g & 511; float h = P->in[I_SH][(unsigned)(l * 128 + sb) * 512u + ch];
#pragma unroll
        for (unsigned s = 0; s < 4; ++s) { const unsigned row = (unsigned)MTP + sb * 4 + s, o = row * 512u + ch; const float la = bf2f(LA[o]), gx = bf2f(GX[o]); const float a = __expf(la), bb = sqrtf(fmaxf(1.f - a * a, 0.f)) * gx;
            h = a * h + bb; const float gb = bf2f(PR[row * (unsigned)INW + 512u + ch]); ymix[row * 1024u + ch] = f2bf(h * gelu_tanh(gb)); }
        out[O_SH + (unsigned)(l * 128 + sb) * 512u + ch] = h;
    }
}
__device__ __forceinline__ void unpack8(const u32x4 w, float (&f)[8]) {
#pragma unroll
    for (int i = 0; i < 4; ++i) { f[2 * i] = __uint_as_float(w[i] << 16); f[2 * i + 1] = __uint_as_float(w[i] & 0xffff0000u); }
}
__device__ __forceinline__ f32x4 unpack4(const u32x2 w) { return (f32x4){__uint_as_float(w[0] << 16), __uint_as_float(w[0] & 0xffff0000u), __uint_as_float(w[1] << 16), __uint_as_float(w[1] & 0xffff0000u)}; }
__device__ __forceinline__ void scan_wkv_sample(PP P, int l, const Ids I) {
    const int tid = make_tid(I.wv), wave = __builtin_amdgcn_readfirstlane(tid >> 6), lane = tid & 63, rowl = lane >> 4, kseg = lane & 15; unsigned char* ws = P->ws;
    const bf16_t* arr = (const bf16_t*)(ws + WS_R2); const unsigned AS = (unsigned)MT * 512u; bf16_t* ymix = (bf16_t*)(ws + WS_HB);
    const float* sin_ = P->in[I_SWKV]; float* out = P->out;
    const int gw = BID * 8 + wave, nw = NB * 8;
    for (int q = gw; q < 128 * 8 * 16; q += nw) {
        const int pair = q >> 4, rgp = q & 15, sb = pair >> 3, h = pair & 7, vrow = rgp * 4 + rowl;
        const unsigned so = ((unsigned)((l * 128 + sb) * 8 + h) * 64u + vrow) * 64u + kseg * 4;
        f32x4 S = *(const f32x4*)(sin_ + so);
        f32x4 r_[4], w_[4], k_[4], a_[4], b_[4]; float v_[4];
#pragma unroll
        for (int s = 0; s < 4; ++s) { const unsigned row = (unsigned)MTP + sb * 4 + s, o = row * 512u + h * 64 + kseg * 4;
            r_[s] = unpack4(*(const u32x2*)(arr + A_R * AS + o)); w_[s] = unpack4(*(const u32x2*)(arr + A_EW * AS + o)); k_[s] = unpack4(*(const u32x2*)(arr + A_KF * AS + o));
            a_[s] = unpack4(*(const u32x2*)(arr + A_KK * AS + o)); b_[s] = unpack4(*(const u32x2*)(arr + A_BB * AS + o)); v_[s] = bf2f(arr[A_V * AS + row * 512u + h * 64 + vrow]); }
#pragma unroll
        for (int s = 0; s < 4; ++s) { const unsigned row = (unsigned)MTP + sb * 4 + s;
            const float p = (S[0] * a_[s][0] + S[1] * a_[s][1]) + (S[2] * a_[s][2] + S[3] * a_[s][3]); const float sa = -row16_allsum(p);
#pragma unroll
            for (int j = 0; j < 4; ++j) S[j] = fmaf(S[j], __expf(-w_[s][j]), fmaf(sa, b_[s][j], v_[s] * k_[s][j]));
            const float y = row16_allsum((S[0] * r_[s][0] + S[1] * r_[s][1]) + (S[2] * r_[s][2] + S[3] * r_[s][3]));
            if (kseg == 0) ymix[row * 1024u + 512u + h * 64 + vrow] = f2bf(y); }
        *(f32x4*)(out + O_SWKV + so) = S;
    }
}
__device__ __forceinline__ void scan_wkv_prompt(PP P, int l, LAS unsigned char* lds, const Ids I) {
    const int tid = make_tid(I.wv), wave = __builtin_amdgcn_readfirstlane(tid >> 6), lane = tid & 63, rowl = lane >> 4, kseg = lane & 15; unsigned char* ws = P->ws;
    const bf16_t* arr = (const bf16_t*)(ws + WS_R2); const unsigned AS = (unsigned)MT * 512u; bf16_t* ymix = (bf16_t*)(ws + WS_HB); float* out = P->out;
    LAS float* buf = (LAS float*)lds;
    LAS float* ybuf = buf + 2 * 32 * 336;
    for (int u = BID; u < 256; u += NB) {
        const int bh = u >> 2, rg = u & 3, b = bh >> 3, h = bh & 7; const unsigned rowbase = (unsigned)b * 2048u;
        const int lt = tid & 255, ls = lt >> 3, part = lt & 7;
#define WKV_LOAD(cc) do { const unsigned row = rowbase + (unsigned)(cc) * 32u + ls; const unsigned o = row * 512u + h * 64 + part * 8; \
            const u32x4 vr = *(const u32x4*)(arr + A_R * AS + o), vw = *(const u32x4*)(arr + A_EW * AS + o), vk = *(const u32x4*)(arr + A_KF * AS + o), va = *(const u32x4*)(arr + A_KK * AS + o), vb = *(const u32x4*)(arr + A_BB * AS + o); \
            u32x4 vvv = (u32x4){0u, 0u, 0u, 0u}; if (part < 2) vvv = *(const u32x4*)(arr + A_V * AS + row * 512u + h * 64 + rg * 16 + part * 8); \
            LAS float* dp = buf + ((cc) & 1) * (32 * 336) + ls * 336 + part * 8; float f[8]; \
            unpack8(vr, f); *(LAS f32x4*)(dp) = (f32x4){f[0], f[1], f[2], f[3]}; *(LAS f32x4*)(dp + 4) = (f32x4){f[4], f[5], f[6], f[7]}; \
            unpack8(vw, f); *(LAS f32x4*)(dp + 64) = (f32x4){__expf(-f[0]), __expf(-f[1]), __expf(-f[2]), __expf(-f[3])}; *(LAS f32x4*)(dp + 68) = (f32x4){__expf(-f[4]), __expf(-f[5]), __expf(-f[6]), __expf(-f[7])}; \
            unpack8(vk, f); *(LAS f32x4*)(dp + 128) = (f32x4){f[0], f[1], f[2], f[3]}; *(LAS f32x4*)(dp + 132) = (f32x4){f[4], f[5], f[6], f[7]}; \
            unpack8(va, f); *(LAS f32x4*)(dp + 192) = (f32x4){f[0], f[1], f[2], f[3]}; *(LAS f32x4*)(dp + 196) = (f32x4){f[4], f[5], f[6], f[7]}; \
            unpack8(vb, f); *(LAS f32x4*)(dp + 256) = (f32x4){f[0], f[1], f[2], f[3]}; *(LAS f32x4*)(dp + 260) = (f32x4){f[4], f[5], f[6], f[7]}; \
            if (part < 2) { unpack8(vvv, f); *(LAS f32x4*)(dp + 320) = (f32x4){f[0], f[1], f[2], f[3]}; *(LAS f32x4*)(dp + 324) = (f32x4){f[4], f[5], f[6], f[7]}; } } while (0)
#define WKV_FLUSH(cc) do { const LAS float* yb = ybuf + ((cc) & 1) * 512 + ls * 16 + part * 2; const unsigned row = rowbase + (unsigned)(cc) * 32u + ls; \
            *(unsigned*)(ymix + row * 1024u + 512u + h * 64 + rg * 16 + part * 2) = cvt_pk_bf16(yb[0], yb[1]); } while (0)
        if (wave >= 4) WKV_LOAD(0);
        float S0 = 0.f, S1 = 0.f, S2 = 0.f, S3 = 0.f;
#pragma unroll 1
        for (int c = 0; c < 64; ++c) {
            __syncthreads();
            if (wave < 4) {
                const LAS float* bp = buf + (c & 1) * (32 * 336) + kseg * 4; LAS float* yb = ybuf + (c & 1) * 512; const int vo = 320 + wave * 4 + rowl - kseg * 4;
                f32x4 r4 = *(const LAS f32x4*)(bp), w4 = *(const LAS f32x4*)(bp + 64), k4 = *(const LAS f32x4*)(bp + 128), a4 = *(const LAS f32x4*)(bp + 192), b4 = *(const LAS f32x4*)(bp + 256); float vv = bp[vo];
#pragma unroll 1
                for (int half = 0; half < 2; ++half) {
                    float ykeep = 0.f;
#pragma unroll
                    for (int s = 0; s < 16; ++s) {
                        const LAS float* np = bp + (half * 16 + s + 1) * 336;
                        const f32x4 nr4 = *(const LAS f32x4*)(np), nw4 = *(const LAS f32x4*)(np + 64), nk4 = *(const LAS f32x4*)(np + 128), na4 = *(const LAS f32x4*)(np + 192), nb4 = *(const LAS f32x4*)(np + 256); const float nvv = np[vo];
                        const float p = (S0 * a4[0] + S1 * a4[1]) + (S2 * a4[2] + S3 * a4[3]); const float sa = -row16_allsum(p);
                        S0 = fmaf(S0, w4[0], fmaf(sa, b4[0], vv * k4[0])); S1 = fmaf(S1, w4[1], fmaf(sa, b4[1], vv * k4[1]));
                        S2 = fmaf(S2, w4[2], fmaf(sa, b4[2], vv * k4[2])); S3 = fmaf(S3, w4[3], fmaf(sa, b4[3], vv * k4[3]));
                        const float y = row16_allsum((S0 * r4[0] + S1 * r4[1]) + (S2 * r4[2] + S3 * r4[3]));
                        ykeep = (kseg == s) ? y : ykeep;
                        r4 = nr4; w4 = nw4; k4 = nk4; a4 = na4; b4 = nb4; vv = nvv;
                        asm volatile("" : "+v"(S0), "+v"(S1), "+v"(S2), "+v"(S3), "+v"(ykeep) :: "memory"); __builtin_amdgcn_sched_barrier(0);
                    }
                    yb[(half * 16 + kseg) * 16 + wave * 4 + rowl] = ykeep;
                }
            } else {
                if (c > 0) WKV_FLUSH(c - 1);
                if (c + 1 < 64) WKV_LOAD(c + 1);
            }
        }
        __syncthreads();
        if (wave >= 4) WKV_FLUSH(63);
        else { const int vrow = rg * 16 + wave * 4 + rowl; *(f32x4*)(out + O_PWKV + ((unsigned)((l * 8 + b) * 8 + h) * 64u + vrow) * 64u + kseg * 4) = (f32x4){S0, S1, S2, S3}; }
        __syncthreads();
#undef WKV_LOAD
#undef WKV_FLUSH
    }
}
__device__ __forceinline__ void phase_scan(PP P, int l, LAS unsigned char* lds, const Ids I) {
    scan_lru(P, l, lds, I);
    scan_wkv_sample(P, l, I);
    scan_wkv_prompt(P, l, lds, I);
}

__device__ __forceinline__ void phase_m2(PP P, int l, LAS unsigned char* lds, const Ids I) {
    const int tid_local = make_tid(I.wv);
    const int tid = TID, d = tid; unsigned char* ws = P->ws;
    const bf16_t* PR = (const bf16_t*)(ws + WS_R1); const bf16_t* arr = (const bf16_t*)(ws + WS_R2); const size_t AS = (size_t)MT * 512;
    bf16_t* ymix = (bf16_t*)(ws + WS_HB);
    LAS float* SG = (LAS float*)lds;
    const float* mu = P->in[I_MU] + (size_t)l * PW; const float* g2 = P->in[I_G2] + (size_t)l * 128 * 512 + d;
    const float lnw = P->in[I_LNW][l * 512 + d], lnb = P->in[I_LNB][l * 512 + d], rk = P->in[I_RK][l * 512 + d];
    for (int u = BID; u < MT / 16; u += NB) {
        const int r0 = u * 16;
#pragma unroll
        for (int i = 0; i < 4; ++i) { const int idx = tid + 512 * i, tok = idx >> 7, col = idx & 127, r = r0 + tok, t = t_in_seq(r);
            const float cur = bf2f(PR[(size_t)r * INW + 2688 + col]);
            const float prev = t > 0 ? bf2f(PR[(size_t)(r - 1) * INW + 2688 + col]) : (r < MTP ? 0.f : P->in[I_SSHIFT][((size_t)l * 128 + ((r - MTP) >> 2)) * PW + 1664 + col]);
            SG[col * 16 + tok] = sigmoidf(cur + (prev - cur) * mu[1664 + col]); }
        __syncthreads();
        float ag[16];
#pragma unroll
        for (int i = 0; i < 16; ++i) ag[i] = 0.f;
#pragma unroll 2
        for (int c = 0; c < 128; ++c) { const float gv = g2[c * 512];
#pragma unroll
            for (int q = 0; q < 4; ++q) { const f32x4 sg = *(const LAS f32x4*)(SG + c * 16 + q * 4);
#pragma unroll
                for (int j = 0; j < 4; ++j) ag[q * 4 + j] += sg[j] * gv; } }
#pragma unroll 4
        for (int i = 0; i < 16; ++i) { const size_t r = (size_t)r0 + i; const float y = bf2f(ymix[r * 1024 + 512 + d]);
            const float m = wave_sum(y) * (1.0f / 64.0f), dy = y - m, var = wave_sum(dy * dy) * (1.0f / 64.0f);
            const float yn = dy * rsqrtf(var + 64e-5f) * lnw + lnb;
            const float rr = bf2f(arr[A_R * AS + r * 512 + d]), kf = bf2f(arr[A_KF * AS + r * 512 + d]), vv = bf2f(arr[A_V * AS + r * 512 + d]);
            const float bs = wave_sum(rr * kf * rk);
            ymix[r * 1024 + 512 + d] = f2bf((yn + bs * vv) * ag[i]); }
        __syncthreads();
    }
}

__global__ void __launch_bounds__(512) mega(Params Pval) {
    extern __shared__ __attribute__((aligned(16))) unsigned char lds_raw[];
    LAS unsigned char* lds = (LAS unsigned char*)lds_raw;
    cg::grid_group grid = cg::this_grid();
    const int NSTEP = 2 + 2 * 12 + 1;
    const int wave_s = __builtin_amdgcn_readfirstlane((int)threadIdx.x >> 6);
#pragma unroll 1
    for (int step = 0; step < NSTEP; ++step) {
        Ids I; I.bid = (int)blockIdx.x; I.nb = (int)gridDim.x; int wv = wave_s;
        unsigned long long pv = (unsigned long long)__builtin_amdgcn_kernarg_segment_ptr();
        asm volatile("" : "+s"(wv), "+s"(I.bid), "+s"(I.nb), "+s"(pv));
        I.bid = __builtin_amdgcn_readfirstlane(I.bid); I.nb = __builtin_amdgcn_readfirstlane(I.nb);
        I.wv = __builtin_amdgcn_readfirstlane(wv);
        PP P = (PP)(((unsigned long long)(unsigned)__builtin_amdgcn_readfirstlane((int)(pv >> 32)) << 32) | (unsigned long long)(unsigned)__builtin_amdgcn_readfirstlane((int)pv));
        unsigned char* ws = P->ws;
        if (step == 0) phase_prologue(P, lds, I);
        else if (step == 1) { EpiAda E{(float*)(ws + WS_MOD), P->in[I_BADA]}; run_gemm(lds, (const bf16_t*)(ws + WS_AADA), (const bf16_t*)(ws + WS_R2), 256, 2 * 9216, 1024, E, I); }
        else if (step == NSTEP - 1) phase_norm(P, 0, 3, I);
        else {
            const int l = (step - 2) / 12, sub = (step - 2) % 12;
            const float* modl = (const float*)(ws + WS_MOD) + (size_t)l * NMR * 9216;
            if (sub == 0 || sub == 3 || sub == 9) {
                if (sub == 0 && l == 1) convert_layer(P, 1, lds, I);
                phase_norm(P, l, sub == 0 ? 0 : (sub == 3 ? 1 : 2), I);
            } else if (sub == 1 || sub == 10) {
                EpiSwiGLU E{(bf16_t*)(ws + WS_R1)}; run_gemm(lds, (const bf16_t*)(ws + WS_HB), (const bf16_t*)(ws + (sub == 1 ? WS_WGU1 : WS_WGU2)), MT, 2 * FF, 1024, E, I);
            } else if (sub == 2 || sub == 8 || sub == 11) {
                const int gk = sub == 2 ? 2 : (sub == 8 ? 5 : 8);
                EpiResid E{P->out, modl + gk * 1024, sub == 8 ? 1.0f : 0.5f};
                const bf16_t* A = (const bf16_t*)(ws + (sub == 8 ? WS_HB : WS_R1)); const bf16_t* Bt = (const bf16_t*)(ws + (sub == 2 ? WS_WD1 : (sub == 8 ? WS_WOUT : WS_WD2)));
                run_gemm(lds, A, Bt, MT, 1024, sub == 8 ? 1024 : FF, E, I);
            } else if (sub == 4) {
                EpiProj E{(bf16_t*)(ws + WS_R1)}; run_gemm(lds, (const bf16_t*)(ws + WS_HB), (const bf16_t*)(ws + WS_WIN), MT, INW, 1024, E, I);
            } else if (sub == 5) phase_m1(P, l, lds, I);
            else if (sub == 6) phase_scan(P, l, lds, I);
            else phase_m2(P, l, lds, I);
        }
        if (step != NSTEP - 1) grid.sync();
    }
}

extern "C" void kernel_launch(void* const* d_in, const int* in_sizes, int n_in, void* d_out, int out_size, void* d_ws, size_t ws_size, hipStream_t stream) {
    static int grid_blocks = 0;
    if (!grid_blocks) {
        if (n_in != 40 || ws_size < WS_END) { fprintf(stderr, "kernel_launch: need 40 inputs and %zu bytes of workspace; got %d, %zu\n", (size_t)WS_END, n_in, ws_size); grid_blocks = -1; return; }
        int dev = 0, cus = 0, per_cu = 0;
        hipGetDevice(&dev);
        hipDeviceGetAttribute(&cus, hipDeviceAttributeMultiprocessorCount, dev);
        hipFuncSetAttribute((const void*)mega, hipFuncAttributeMaxDynamicSharedMemorySize, LDS_BYTES);
        hipOccupancyMaxActiveBlocksPerMultiprocessor(&per_cu, (const void*)mega, 512, LDS_BYTES);
        if (per_cu < 1) { fprintf(stderr, "kernel_launch: occupancy query says %d blocks per CU\n", per_cu); grid_blocks = -1; return; }
        grid_blocks = cus;
    }
    if (grid_blocks < 0) return;
    Params p{};
    for (int i = 0; i < 40; ++i) p.in[i] = (const float*)d_in[i];
    p.out = (float*)d_out; p.ws = (unsigned char*)d_ws;
    void* args[] = {&p};
    hipError_t e = hipLaunchCooperativeKernel((const void*)mega, dim3(grid_blocks), dim3(512), args, LDS_BYTES, stream);
    if (e != hipSuccess) fprintf(stderr, "cooperative launch failed: %s (grid %d)\n", hipGetErrorString(e), grid_blocks);
}
```

```cpp
#include <hip/hip_runtime.h>
#include <hip/hip_cooperative_groups.h>
#include <cstdio>
namespace cg = cooperative_groups;

#define LAS __attribute__((address_space(3)))
typedef unsigned short bf16_t;
typedef short bf16x8 __attribute__((ext_vector_type(8)));
typedef float f32x4 __attribute__((ext_vector_type(4)));
typedef float f32x2 __attribute__((ext_vector_type(2)));
typedef unsigned u32x4 __attribute__((ext_vector_type(4)));
typedef unsigned u32x2 __attribute__((ext_vector_type(2)));

constexpr int D = 1024, MTP = 16384, MTS = 512, MT = 16896, FF = 2816, INW = 2816, PW = 1792, NMR = 136;
#ifndef PROBE
#define PROBE 0
#endif
constexpr int LDS_MAIN = 131072, LDS_BYTES = LDS_MAIN + 16;
constexpr size_t SZ_WGU = (size_t)5632 * 1024 * 2, SZ_WD = (size_t)1024 * 2816 * 2, SZ_WIN = (size_t)2816 * 1024 * 2, SZ_WOUT = (size_t)1024 * 1024 * 2;
constexpr size_t WS_WGU1 = 16384, WS_WD1 = WS_WGU1 + SZ_WGU, WS_WIN = WS_WD1 + SZ_WD, WS_WOUT = WS_WIN + SZ_WIN, WS_WGU2 = WS_WOUT + SZ_WOUT, WS_WD2 = WS_WGU2 + SZ_WGU;
constexpr size_t WS_MOD = WS_WD2 + SZ_WD, SZ_MOD = (size_t)2 * NMR * 9216 * 4;
constexpr size_t WS_AADA = WS_MOD + SZ_MOD, SZ_AADA = (size_t)256 * 1024 * 2;
constexpr size_t WS_HB = WS_AADA + SZ_AADA, SZ_HB = (size_t)MT * 1024 * 2;
constexpr size_t WS_R1 = WS_HB + SZ_HB, SZ_R1 = (size_t)MT * 2816 * 2;
constexpr size_t WS_R2 = WS_R1 + SZ_R1, SZ_ARR = (size_t)MT * 512 * 2;
constexpr size_t WS_END = WS_R2 + 8 * SZ_ARR;
enum { A_LA = 0, A_GX, A_R, A_EW, A_KF, A_V, A_KK, A_BB };
constexpr size_t O_PCONV = (size_t)MT * 1024, O_PH = O_PCONV + 24576, O_PSHIFT = O_PH + 8192, O_PWKV = O_PSHIFT + 28672, O_SCONV = O_PWKV + 524288,
                 O_SH = O_SCONV + 393216, O_SSHIFT = O_SH + 131072, O_SWKV = O_SSHIFT + 458752;
enum { I_XP = 0, I_XS, I_CP, I_CS, I_SCONV, I_SH, I_SSHIFT, I_SWKV, I_WADA, I_BADA, I_F1N, I_F1G, I_F1U, I_F1D, I_MIXN, I_WIN, I_WOUT, I_CONVW, I_CONVB, I_LWX, I_LBX,
       I_LWA, I_LBA, I_LAM, I_MU, I_W0, I_W2, I_A0, I_A2, I_G2, I_KK, I_KA, I_RK, I_LNW, I_LNB, I_F2N, I_F2G, I_F2U, I_F2D, I_FN };

struct Params { const float* in[40]; float* out; unsigned char* ws; };
typedef const __attribute__((address_space(4))) Params* PP;
struct Ids { int wv, bid, nb; };
__device__ __forceinline__ int make_tid(int wv) { int lane_v; asm volatile("v_mbcnt_lo_u32_b32 %0, -1, 0\n\tv_mbcnt_hi_u32_b32 %0, -1, %0" : "=v"(lane_v)); return wv * 64 + lane_v; }
#define TID tid_local
#define BID (I.bid)
#define NB (I.nb)

__device__ __forceinline__ float bf2f(bf16_t h) { return __uint_as_float((unsigned)h << 16); }
__device__ __forceinline__ unsigned cvt_pk_bf16(float lo, float hi) { unsigned r; asm("v_cvt_pk_bf16_f32 %0, %1, %2" : "=v"(r) : "v"(lo), "v"(hi)); return r; }
__device__ __forceinline__ bf16_t f2bf(float f) { return (bf16_t)(cvt_pk_bf16(f, 0.f) & 0xffffu); }
__device__ __forceinline__ float rcpf(float x) { return __builtin_amdgcn_rcpf(x); }
__device__ __forceinline__ float sigmoidf(float x) { return rcpf(1.0f + __expf(-x)); }
__device__ __forceinline__ float tanh_f(float x) { return 1.0f - 2.0f * rcpf(1.0f + __expf(2.0f * x)); }
__device__ __forceinline__ float gelu_tanh(float x) { const float u = 0.7978845608f * (x + 0.044715f * x * x * x); return 0.5f * x * (1.0f + tanh_f(u)); }
__device__ __forceinline__ float softplusf(float x) { return fmaxf(x, 0.f) + log1pf(__expf(-fabsf(x))); }
template <int CTRL> __device__ __forceinline__ float dpp_mov(float x) {
    return __builtin_bit_cast(float, __builtin_amdgcn_update_dpp(0, __builtin_bit_cast(int, x), CTRL, 0xF, 0xF, true));
}
__device__ __forceinline__ float row16_allsum(float x) {
    x += dpp_mov<0xB1>(x); x += dpp_mov<0x4E>(x); x += dpp_mov<0x141>(x); x += dpp_mov<0x140>(x); return x;
}
__device__ __forceinline__ float wave_sum(float x) {
    x = row16_allsum(x);
    const float a = __builtin_bit_cast(float, __builtin_amdgcn_readlane(__builtin_bit_cast(int, x), 0)), b = __builtin_bit_cast(float, __builtin_amdgcn_readlane(__builtin_bit_cast(int, x), 16)),
                c = __builtin_bit_cast(float, __builtin_amdgcn_readlane(__builtin_bit_cast(int, x), 32)), d = __builtin_bit_cast(float, __builtin_amdgcn_readlane(__builtin_bit_cast(int, x), 48));
    return (a + b) + (c + d);
}
__device__ __forceinline__ void unpack8(const u32x4 w, float (&f)[8]) {
#pragma unroll
    for (int i = 0; i < 4; ++i) { f[2 * i] = __uint_as_float(w[i] << 16); f[2 * i + 1] = __uint_as_float(w[i] & 0xffff0000u); }
}
__device__ __forceinline__ int mod_row(int r) { return r < MTP ? (r >> 11) : 8 + ((r - MTP) >> 2); }
__device__ __forceinline__ int t_in_seq(int r) { return r < MTP ? (r & 2047) : ((r - MTP) & 3); }

namespace pg8 {
constexpr int BM = 256, BK = 64, HALF = 128, HTB = HALF * BK * 2, STAGE_BYTES = 8 * HTB, NXCD = 8, WGM = 8;
__device__ __forceinline__ int lds_byte(int r, int c) { const int st = (r >> 4) * 2 + (c >> 5), rr = r & 15, cc = c & 31, ob = rr * 64 + cc * 2; return st * 1024 + (ob ^ (((ob >> 9) & 1) << 5)); }
__device__ __forceinline__ void stage_rc(int b, int& R, int& C) { const int st = b / 1024, sb = b % 1024, swz = sb ^ (((sb >> 9) & 1) << 5); R = (st >> 1) * 16 + swz / 64; C = (st & 1) * 32 + (swz % 64) / 2; }
struct Unit { int pm, pn; };
struct Gemm { const bf16_t* A; const bf16_t* Bt; int M, N, K; };
struct StaticOrder {
    int nM, nN, nwg, G, c;
    __device__ void init(int M, int N, int G_, int c_) { nM = M / BM; nN = N / BM; nwg = nM * nN; G = G_; c = c_; }
    __device__ bool next(int i, Unit& u) const {
        const long L = (long)i * G + c; if (L >= nwg) return false;
        int wgid = (int)L; { const int q = nwg / NXCD, r = nwg % NXCD, xcd = wgid % NXCD, off = wgid / NXCD; wgid = (xcd < r ? xcd * (q + 1) : r * (q + 1) + (xcd - r) * q) + off; }
        const int nig = WGM * nN, gid = wgid / nig, fm = gid * WGM, gsz = (nM - fm) < WGM ? (nM - fm) : WGM;
        u.pm = fm + ((wgid % nig) % gsz); u.pn = (wgid % nig) / gsz; return true;
    }
};
template <class Epi>
__device__ __forceinline__ void gemm_phase(LAS unsigned char* lds, const Gemm g, const StaticOrder& S, const Epi& E, const Ids I) {
    const int tid_local = make_tid(I.wv);
    const int tid = TID, wid = __builtin_amdgcn_readfirstlane(tid >> 6), lane = tid & 63, wr = wid >> 2, wc = wid & 3, fr = lane & 15, fq = lane >> 4;
    const int K = g.K, nt = K / BK;
    unsigned voffA[2], voffB[2];
#pragma unroll
    for (int i = 0; i < 2; ++i) { int R, C; stage_rc(tid * 16 + i * 8192, R, C); voffA[i] = (unsigned)(R * K + C) * 2u; voffB[i] = (unsigned)(R * K + C) * 2u; }
    const size_t kstep = (size_t)(BK * 2);
    const size_t hstep = (size_t)HALF * K * 2;
    const size_t tstep = 2 * hstep;
    const unsigned ldsw = (unsigned)wid * 1024u;
    const int aoff = lds_byte(wr * 64 + fr, fq * 8), boff = lds_byte(wc * 32 + fr, fq * 8);
#define PG8_SA(b, h) (((b) * 2 + (h)) * HTB)
#define PG8_SB(b, h) ((4 + (b) * 2 + (h)) * HTB)
#define PG8_STAGE(bufoff, gbase, voff) do { _Pragma("unroll") for (int _i = 0; _i < 2; ++_i) \
        __builtin_amdgcn_global_load_lds((const unsigned*)((const char*)(gbase) + (voff)[_i]), (LAS unsigned*)(lds + (bufoff) + ldsw + _i * 8192), 16, 0, 0); } while (0)
#define PG8_LDA(dst, b, h) do { _Pragma("unroll") for (int m = 0; m < 4; ++m) _Pragma("unroll") for (int k = 0; k < 2; ++k) dst[m][k] = *(const LAS bf16x8*)(lds + PG8_SA(b, h) + aoff + m * 2048 + k * 1024); } while (0)
#define PG8_LDB(dst, b, h) do { _Pragma("unroll") for (int n = 0; n < 2; ++n) _Pragma("unroll") for (int k = 0; k < 2; ++k) dst[n][k] = *(const LAS bf16x8*)(lds + PG8_SB(b, h) + boff + n * 2048 + k * 1024); } while (0)
#define PG8_MMA(ai, bj, At, Bt) do { __builtin_amdgcn_s_setprio(1); _Pragma("unroll") for (int m = 0; m < 4; ++m) _Pragma("unroll") for (int n = 0; n < 2; ++n) _Pragma("unroll") for (int k = 0; k < 2; ++k) \
        acc[ai][bj][m][n] = __builtin_amdgcn_mfma_f32_16x16x32_bf16(Bt[n][k], At[m][k], acc[ai][bj][m][n], 0, 0, 0); __builtin_amdgcn_s_setprio(0); } while (0)
#define PG8_WAIT_V(n) asm volatile("s_waitcnt vmcnt(" #n ")" ::: "memory")
#define PG8_WAIT_L(n) asm volatile("s_waitcnt lgkmcnt(" #n ")" ::: "memory")
#define PG8_BAR __builtin_amdgcn_s_barrier()
#define PG8_SCHED __builtin_amdgcn_sched_barrier(0)
    Unit cur, nxt; int ui = 0;
    if (!S.next(0, cur)) return;
    f32x4 acc[2][2][4][2];
#pragma unroll
    for (int a = 0; a < 2; ++a)
#pragma unroll
        for (int b = 0; b < 2; ++b)
#pragma unroll
            for (int m = 0; m < 4; ++m)
#pragma unroll
                for (int n = 0; n < 2; ++n) acc[a][b][m][n] = (f32x4){0.f, 0.f, 0.f, 0.f};
    bf16x8 At[4][2], B0[2][2], B1[2][2];
    const char* cA = (const char*)g.A + (size_t)cur.pm * tstep; const char* cB = (const char*)g.Bt + (size_t)cur.pn * tstep;
    PG8_STAGE(PG8_SB(0, 0), cB, voffB); PG8_STAGE(PG8_SA(0, 0), cA, voffA); PG8_STAGE(PG8_SB(0, 1), cB + hstep, voffB); PG8_STAGE(PG8_SA(0, 1), cA + hstep, voffA);
    if (wr == 1) PG8_BAR;
    PG8_WAIT_V(4); PG8_BAR;
    PG8_STAGE(PG8_SB(1, 0), cB + kstep, voffB); PG8_STAGE(PG8_SA(1, 0), cA + kstep, voffA); PG8_STAGE(PG8_SB(1, 1), cB + hstep + kstep, voffB);
    PG8_WAIT_V(6); PG8_BAR;
    for (;;) {
        const bool has_next = S.next(ui + 1, nxt);
        const char* nA = has_next ? (const char*)g.A + (size_t)nxt.pm * tstep : cA; const char* nB = has_next ? (const char*)g.Bt + (size_t)nxt.pn * tstep : cB;
        for (int t = 0; t < nt; t += 2) {
            const bool last = (t == nt - 2);
            const char* a1 = cA + (size_t)(t + 1) * kstep;
            const char* a2 = last ? nA : cA + (size_t)(t + 2) * kstep; const char* b2 = last ? nB : cB + (size_t)(t + 2) * kstep;
            const char* a3 = a2 + kstep; const char* b3 = b2 + kstep;
            PG8_LDB(B0, 0, 0); PG8_SCHED; PG8_LDA(At, 0, 0); PG8_STAGE(PG8_SA(1, 1), a1 + hstep, voffA);
            PG8_WAIT_L(8); PG8_BAR; PG8_WAIT_L(0); PG8_MMA(0, 0, At, B0); PG8_BAR; PG8_SCHED;
            PG8_LDB(B1, 0, 1); PG8_STAGE(PG8_SB(0, 0), b2, voffB);
            PG8_BAR; PG8_WAIT_L(0); PG8_MMA(0, 1, At, B1); PG8_BAR;
            PG8_LDA(At, 0, 1); PG8_STAGE(PG8_SA(0, 0), a2, voffA);
            PG8_BAR; PG8_WAIT_L(0); PG8_MMA(1, 0, At, B0); PG8_BAR; PG8_SCHED;
            PG8_STAGE(PG8_SB(0, 1), b2 + hstep, voffB);
            PG8_WAIT_V(6); PG8_BAR; PG8_MMA(1, 1, At, B1); PG8_BAR;
            PG8_LDB(B0, 1, 0); PG8_SCHED; PG8_LDA(At, 1, 0); PG8_STAGE(PG8_SA(0, 1), a2 + hstep, voffA);
            PG8_WAIT_L(8); PG8_BAR; PG8_WAIT_L(0); PG8_MMA(0, 0, At, B0); PG8_BAR; PG8_SCHED;
            PG8_LDB(B1, 1, 1); PG8_STAGE(PG8_SB(1, 0), b3, voffB);
            PG8_BAR; PG8_WAIT_L(0); PG8_MMA(0, 1, At, B1); PG8_BAR;
            PG8_LDA(At, 1, 1); PG8_STAGE(PG8_SA(1, 0), a3, voffA);
            PG8_BAR; PG8_WAIT_L(0); PG8_MMA(1, 0, At, B0); PG8_BAR; PG8_SCHED;
            PG8_STAGE(PG8_SB(1, 1), b3 + hstep, voffB);
            PG8_WAIT_V(6); PG8_BAR; PG8_MMA(1, 1, At, B1); PG8_BAR;
        }
        E(acc, cur, wr, wc, fr, fq);
        if (!has_next) break;
#pragma unroll
        for (int a = 0; a < 2; ++a)
#pragma unroll
            for (int b = 0; b < 2; ++b)
#pragma unroll
                for (int m = 0; m < 4; ++m)
#pragma unroll
                    for (int n = 0; n < 2; ++n) acc[a][b][m][n] = (f32x4){0.f, 0.f, 0.f, 0.f};
        cur = nxt; cA = nA; cB = nB; ++ui;
    }
    PG8_WAIT_V(0);
    if (wr == 0) PG8_BAR;
    PG8_BAR;
#undef PG8_SA
#undef PG8_SB
#undef PG8_STAGE
#undef PG8_LDA
#undef PG8_LDB
#undef PG8_MMA
#undef PG8_WAIT_V
#undef PG8_WAIT_L
#undef PG8_BAR
#undef PG8_SCHED
}
}

struct EpiSwiGLU {
    bf16_t* act;
    __device__ __forceinline__ void operator()(const f32x4 (&acc)[2][2][4][2], const pg8::Unit& u, int wr, int wc, int fr, int fq) const {
        const int row0 = u.pm * 256 + wr * 64 + fr, col0 = u.pn * 128 + wc * 32 + 4 * fq;
#pragma unroll
        for (int ai = 0; ai < 2; ++ai)
#pragma unroll
            for (int m = 0; m < 4; ++m) { bf16_t* rowp = act + (size_t)(row0 + ai * 128 + m * 16) * FF + col0;
#pragma unroll
                for (int n = 0; n < 2; ++n) { const f32x4 gv = acc[ai][0][m][n], uv = acc[ai][1][m][n]; float o[4];
#pragma unroll
                    for (int j = 0; j < 4; ++j) o[j] = gv[j] * sigmoidf(gv[j]) * uv[j];
                    u32x2 w; w.x = cvt_pk_bf16(o[0], o[1]); w.y = cvt_pk_bf16(o[2], o[3]); *(u32x2*)(rowp + n * 16) = w; } }
    }
};
struct EpiResid {
    float* x; const float* gate; float scale;
    __device__ __forceinline__ void operator()(const f32x4 (&acc)[2][2][4][2], const pg8::Unit& u, int wr, int wc, int fr, int fq) const {
        const int row0 = u.pm * 256 + wr * 64 + fr, col0 = u.pn * 256 + wc * 32 + 4 * fq;
#pragma unroll
        for (int ai = 0; ai < 2; ++ai)
#pragma unroll
            for (int m = 0; m < 4; ++m) { const int row = row0 + ai * 128 + m * 16; float* rowp = x + (size_t)row * D + col0; const float* gp = gate + (size_t)mod_row(row) * 9216 + col0;
#pragma unroll
                for (int bj = 0; bj < 2; ++bj)
#pragma unroll
                    for (int n = 0; n < 2; ++n) { const f32x4 xv = *(const f32x4*)(rowp + bj * 128 + n * 16), gv = *(const f32x4*)(gp + bj * 128 + n * 16);
                        *(f32x4*)(rowp + bj * 128 + n * 16) = xv + (gv * scale) * acc[ai][bj][m][n]; }
                asm volatile("" ::: "memory"); }
    }
};
struct EpiProj {
    bf16_t* o;
    __device__ __forceinline__ void operator()(const f32x4 (&acc)[2][2][4][2], const pg8::Unit& u, int wr, int wc, int fr, int fq) const {
        const int row0 = u.pm * 256 + wr * 64 + fr, col0 = u.pn * 256 + wc * 32 + 4 * fq;
#pragma unroll
        for (int ai = 0; ai < 2; ++ai)
#pragma unroll
            for (int m = 0; m < 4; ++m) { bf16_t* rowp = o + (size_t)(row0 + ai * 128 + m * 16) * INW + col0;
#pragma unroll
                for (int bj = 0; bj < 2; ++bj)
#pragma unroll
                    for (int n = 0; n < 2; ++n) { const f32x4 v = acc[ai][bj][m][n]; u32x2 w; w.x = cvt_pk_bf16(v[0], v[1]); w.y = cvt_pk_bf16(v[2], v[3]); *(u32x2*)(rowp + bj * 128 + n * 16) = w; } }
    }
};
struct EpiAda {
    float* mod; const float* bias;
    __device__ __forceinline__ void operator()(const f32x4 (&acc)[2][2][4][2], const pg8::Unit& u, int wr, int wc, int fr, int fq) const {
        const int row0 = wr * 64 + fr, colg0 = u.pn * 256 + wc * 32 + 4 * fq; const int l = (u.pn >= 36) ? 1 : 0; const int col0 = colg0 - l * 9216;
#pragma unroll
        for (int ai = 0; ai < 2; ++ai)
#pragma unroll
            for (int m = 0; m < 4; ++m) { const int row = row0 + ai * 128 + m * 16;
                if (row < NMR) { float* rowp = mod + ((size_t)l * NMR + row) * 9216 + col0;
#pragma unroll
                    for (int bj = 0; bj < 2; ++bj)
#pragma unroll
                        for (int n = 0; n < 2; ++n) { const f32x4 bv = *(const f32x4*)(bias + colg0 + bj * 128 + n * 16); *(f32x4*)(rowp + bj * 128 + n * 16) = acc[ai][bj][m][n] + bv; } } }
    }
};
template <class Epi> __device__ __forceinline__ void run_gemm(LAS unsigned char* lds, const bf16_t* A, const bf16_t* Bt, int M, int N, int K, const Epi& E, const Ids I) {
    pg8::Gemm g{A, Bt, M, N, K}; pg8::StaticOrder S; S.init(M, N, (int)NB, (int)BID); pg8::gemm_phase<Epi>(lds, g, S, E, I);
}

__device__ __forceinline__ void conv_tile(const float* __restrict__ src, int K, int N, bf16_t* __restrict__ dst, int mode, int u, LAS float* T, const Ids I) {
    const int tid_local = make_tid(I.wv);
    const int tid = TID; const int tilesN = N >> 6; const int tk = u / tilesN, tn = u - tk * tilesN;
#pragma unroll
    for (int i = 0; i < 2; ++i) { const int kk = (tid >> 4) + 32 * i, n4 = (tid & 15) * 4;
        const f32x4 v = *(const f32x4*)(src + (size_t)(tk * 64 + kk) * N + tn * 64 + n4);
        T[(n4 + 0) * 65 + kk] = v[0]; T[(n4 + 1) * 65 + kk] = v[1]; T[(n4 + 2) * 65 + kk] = v[2]; T[(n4 + 3) * 65 + kk] = v[3]; }
    __syncthreads();
    const int n = tid >> 3, k8 = (tid & 7) * 8; const int ng = tn * 64 + n; const int dr = (mode == 0) ? ng : (((ng >> 7) << 8) + (mode == 2 ? 128 : 0) + (ng & 127));
    const LAS float* tp = T + n * 65 + k8;
    u32x4 w; w.x = cvt_pk_bf16(tp[0], tp[1]); w.y = cvt_pk_bf16(tp[2], tp[3]); w.z = cvt_pk_bf16(tp[4], tp[5]); w.w = cvt_pk_bf16(tp[6], tp[7]);
    *(u32x4*)(dst + (size_t)dr * K + tk * 64 + k8) = w;
    __syncthreads();
}
__device__ __forceinline__ void convert_layer(PP P, int l, LAS unsigned char* lds, const Ids I) {
    LAS float* T = (LAS float*)lds; unsigned char* ws = P->ws;
    const size_t wl = (size_t)l * 1024 * 2816;
    for (int u = BID; u < 7 * 704 + 256; u += NB) {
        const int mi = u / 704, uu = u - mi * 704;
        if (mi == 0)      conv_tile(P->in[I_F1G] + wl, 1024, 2816, (bf16_t*)(ws + WS_WGU1), 1, uu, T, I);
        else if (mi == 1) conv_tile(P->in[I_F1U] + wl, 1024, 2816, (bf16_t*)(ws + WS_WGU1), 2, uu, T, I);
        else if (mi == 2) conv_tile(P->in[I_F1D] + wl, 2816, 1024, (bf16_t*)(ws + WS_WD1), 0, uu, T, I);
        else if (mi == 3) conv_tile(P->in[I_WIN] + wl, 1024, 2816, (bf16_t*)(ws + WS_WIN), 0, uu, T, I);
        else if (mi == 4) conv_tile(P->in[I_F2G] + wl, 1024, 2816, (bf16_t*)(ws + WS_WGU2), 1, uu, T, I);
        else if (mi == 5) conv_tile(P->in[I_F2U] + wl, 1024, 2816, (bf16_t*)(ws + WS_WGU2), 2, uu, T, I);
        else if (mi == 6) conv_tile(P->in[I_F2D] + wl, 2816, 1024, (bf16_t*)(ws + WS_WD2), 0, uu, T, I);
        else              conv_tile(P->in[I_WOUT] + (size_t)l * 1024 * 1024, 1024, 1024, (bf16_t*)(ws + WS_WOUT), 0, uu, T, I);
    }
}
__device__ __forceinline__ void phase_prologue(PP P, LAS unsigned char* lds, const Ids I) {
    const int tid_local = make_tid(I.wv);
    convert_layer(P, 0, lds, I);
    LAS float* T = (LAS float*)lds;
    for (int u = BID; u < 2 * 2304; u += NB) {
        const int l = u / 2304, uu = u - l * 2304;
        conv_tile(P->in[I_WADA] + (size_t)l * 1024 * 9216, 1024, 9216, (bf16_t*)(P->ws + WS_R2) + (size_t)l * 9216 * 1024, 0, uu, T, I);
    }
    bf16_t* aada = (bf16_t*)(P->ws + WS_AADA);
    for (int idx = BID * 512 + TID; idx < 256 * 1024; idx += NB * 512) {
        const int row = idx >> 10, col = idx & 1023; float v = 0.f;
        if (row < 8) v = P->in[I_CP][row * 1024 + col]; else if (row < NMR) v = P->in[I_CS][(row - 8) * 1024 + col];
        aada[idx] = f2bf(v * sigmoidf(v));
    }
}

__device__ __forceinline__ void phase_norm(PP P, int l, int which, const Ids I) {
    const int tid_local = make_tid(I.wv);
    const int lane = TID & 63, gw = BID * 8 + __builtin_amdgcn_readfirstlane(TID >> 6), nw = NB * 8;
    float* xb = P->out; bf16_t* hb = (bf16_t*)(P->ws + WS_HB);
    const float* gamma = which == 0 ? P->in[I_F1N] + l * 1024 : which == 1 ? P->in[I_MIXN] + l * 1024 : which == 2 ? P->in[I_F2N] + l * 1024 : P->in[I_FN];
    const float* modl = (const float*)(P->ws + WS_MOD) + (size_t)l * NMR * 9216;
    const bool from_in = (which == 0 && l == 0);
    for (int row = gw; row < MT; row += nw) {
        const float* xr = from_in ? (row < MTP ? P->in[I_XP] + (size_t)row * D : P->in[I_XS] + (size_t)(row - MTP) * D) : xb + (size_t)row * D;
        f32x4 v[4]; float ss = 0.f;
#pragma unroll
        for (int i = 0; i < 4; ++i) { v[i] = *(const f32x4*)(xr + lane * 4 + 256 * i); ss += v[i][0] * v[i][0] + v[i][1] * v[i][1] + v[i][2] * v[i][2] + v[i][3] * v[i][3]; }
        ss = wave_sum(ss);
        const float rstd = rsqrtf(ss * (1.0f / 1024.0f) + 1e-6f);
        if (which == 3) {
#pragma unroll
            for (int i = 0; i < 4; ++i) { const int col = lane * 4 + 256 * i; const f32x4 g4 = *(const f32x4*)(gamma + col); *(f32x4*)(xb + (size_t)row * D + col) = v[i] * rstd * g4; }
        } else {
            const float* mr = modl + (size_t)mod_row(row) * 9216 + which * 3 * 1024;
#pragma unroll
            for (int i = 0; i < 4; ++i) { const int col = lane * 4 + 256 * i; const f32x4 g4 = *(const f32x4*)(gamma + col), sh = *(const f32x4*)(mr + col), sc = *(const f32x4*)(mr + 1024 + col);
                const f32x4 h = (v[i] * rstd * g4) * (sc + 1.0f) + sh; u32x2 w; w.x = cvt_pk_bf16(h[0], h[1]); w.y = cvt_pk_bf16(h[2], h[3]);
                *(u32x2*)(hb + (size_t)row * D + col) = w;
                if (from_in) *(f32x4*)(xb + (size_t)row * D + col) = v[i]; }
        }
    }
}

__device__ __forceinline__ void phase_m1(PP P, int l, LAS unsigned char* lds, const Ids I) {
    const int tid_local = make_tid(I.wv);
    const int tid = TID; unsigned char* ws = P->ws;
    const bf16_t* PR = (const bf16_t*)(ws + WS_R1);
    bf16_t* arr = (bf16_t*)(ws + WS_R2); const size_t AS = (size_t)MT * 512;
    {
        LAS float* XC = (LAS float*)lds; LAS float* WX = XC + 64 * 68; LAS float* WA = WX + 4096;
        const int d = tid & 63, tg = tid >> 6;
        for (int u = BID; u < 264 * 8; u += NB) {
            const int tt = u >> 3, n = u & 7, r0 = tt * 64, chg = n * 64 + d;
            const float* wx = P->in[I_LWX] + ((size_t)l * 8 + n) * 4096; const float* wa = P->in[I_LWA] + ((size_t)l * 8 + n) * 4096;
#pragma unroll
            for (int i = 0; i < 8; ++i) { WX[tid + 512 * i] = wx[tid + 512 * i]; WA[tid + 512 * i] = wa[tid + 512 * i]; }
            const float* cw = P->in[I_CONVW] + (size_t)l * 4 * 512; const float cwv[4] = {cw[chg], cw[512 + chg], cw[1024 + chg], cw[1536 + chg]}; const float cb = P->in[I_CONVB][l * 512 + chg];
#pragma unroll
            for (int i = 0; i < 8; ++i) { const int r = r0 + tg * 8 + i, t = t_in_seq(r); float a = cb;
#pragma unroll
                for (int j = 0; j < 4; ++j) { const int ts = t - 3 + j; float xv;
                    if (ts >= 0) xv = bf2f(PR[(size_t)(r - 3 + j) * INW + chg]);
                    else xv = (r < MTP) ? 0.f : P->in[I_SCONV][(((size_t)l * 128 + ((r - MTP) >> 2)) * 3 + (ts + 3)) * 512 + chg];
                    a += xv * cwv[j]; }
                XC[d * 68 + tg * 8 + i] = a; }
            __syncthreads();
            float ax[8], aa[8];
#pragma unroll
            for (int i = 0; i < 8; ++i) { ax[i] = 0.f; aa[i] = 0.f; }
#pragma unroll 4
            for (int c = 0; c < 64; ++c) { const float wxv = WX[c * 64 + d], wav = WA[c * 64 + d];
                const f32x4 x0 = *(const LAS f32x4*)(XC + c * 68 + tg * 8), x1 = *(const LAS f32x4*)(XC + c * 68 + tg * 8 + 4);
#pragma unroll
                for (int i = 0; i < 4; ++i) { ax[i] += x0[i] * wxv; aa[i] += x0[i] * wav; ax[4 + i] += x1[i] * wxv; aa[4 + i] += x1[i] * wav; } }
            const float bx = P->in[I_LBX][l * 512 + chg], ba = P->in[I_LBA][l * 512 + chg], sp = softplusf(-P->in[I_LAM][l * 512 + chg]);
#pragma unroll
            for (int i = 0; i < 8; ++i) { const int r = r0 + tg * 8 + i; const float gxv = sigmoidf(ax[i] + bx), gav = sigmoidf(aa[i] + ba), la = -8.0f * gav * sp, xc = XC[d * 68 + tg * 8 + i];
                arr[A_LA * AS + (size_t)r * 512 + chg] = f2bf(la); arr[A_GX * AS + (size_t)r * 512 + chg] = f2bf(gxv * xc); }
            __syncthreads();
        }
    }
    {
        LAS float* XS = (LAS float*)lds;
        const int d = tid; const float* mu = P->in[I_MU] + (size_t)l * PW;
        const float w0 = P->in[I_W0][l * 512 + d], a0 = P->in[I_A0][l * 512 + d], kkw = P->in[I_KK][l * 512 + d], kaw = P->in[I_KA][l * 512 + d];
        float w2c[64], a2c[64];
        { const float* w2 = P->in[I_W2] + (size_t)l * 64 * 512 + d; const float* a2 = P->in[I_A2] + (size_t)l * 64 * 512 + d;
#pragma unroll
          for (int c = 0; c < 64; ++c) { w2c[c] = w2[c * 512]; a2c[c] = a2[c * 512]; } }
        for (int u = BID; u < MT / 8; u += NB) {
            const int r0 = u * 8;
#pragma unroll
            for (int it = 0; it < 4; ++it) { const int e = tid + 512 * it;
                if (e < 8 * 224) { const int tok = e / 224, col = (e - tok * 224) * 8, r = r0 + tok, t = t_in_seq(r);
                    float cf[8], pf[8]; unpack8(*(const u32x4*)(PR + (size_t)r * INW + 1024 + col), cf);
                    if (t > 0) unpack8(*(const u32x4*)(PR + (size_t)(r - 1) * INW + 1024 + col), pf);
                    else if (r < MTP) {
#pragma unroll
                        for (int j = 0; j < 8; ++j) pf[j] = 0.f; }
                    else { const float* sp = P->in[I_SSHIFT] + ((size_t)l * 128 + ((r - MTP) >> 2)) * PW + col; const f32x4 s0 = *(const f32x4*)sp, s1 = *(const f32x4*)(sp + 4);
#pragma unroll
                        for (int j = 0; j < 4; ++j) { pf[j] = s0[j]; pf[4 + j] = s1[j]; } }
                    const f32x4 m0 = *(const f32x4*)(mu + col), m1 = *(const f32x4*)(mu + col + 4); float xs[8];
#pragma unroll
                    for (int j = 0; j < 4; ++j) { xs[j] = cf[j] + (pf[j] - cf[j]) * m0[j]; xs[4 + j] = cf[4 + j] + (pf[4 + j] - cf[4 + j]) * m1[j]; }
                    if (col >= 1536 && col < 1600) {
#pragma unroll
                        for (int j = 0; j < 8; ++j) xs[j] = tanh_f(xs[j]); }
                    *(LAS f32x4*)(XS + tok * 1792 + col) = (f32x4){xs[0], xs[1], xs[2], xs[3]}; *(LAS f32x4*)(XS + tok * 1792 + col + 4) = (f32x4){xs[4], xs[5], xs[6], xs[7]}; } }
            __syncthreads();
#pragma unroll 1
            for (int i = 0; i < 8; ++i) { const int r = r0 + i; const LAS float* xp = XS + i * 1792;
                float aw0 = 0.f, aw1 = 0.f, aa0 = 0.f, aa1 = 0.f;
#pragma unroll
                for (int q = 0; q < 16; ++q) { const f32x4 tw = *(const LAS f32x4*)(xp + 1536 + q * 4), ad = *(const LAS f32x4*)(xp + 1600 + q * 4);
                    aw0 += tw[0] * w2c[q * 4 + 0]; aw1 += tw[1] * w2c[q * 4 + 1]; aw0 += tw[2] * w2c[q * 4 + 2]; aw1 += tw[3] * w2c[q * 4 + 3];
                    aa0 += ad[0] * a2c[q * 4 + 0]; aa1 += ad[1] * a2c[q * 4 + 1]; aa0 += ad[2] * a2c[q * 4 + 2]; aa1 += ad[3] * a2c[q * 4 + 3]; }
                const float xr = xp[d], xk = xp[512 + d], xv = xp[1024 + d];
                const float ew = 0.60653066f * sigmoidf(w0 + (aw0 + aw1));
                const float ar = sigmoidf(a0 + (aa0 + aa1));
                float kk = xk * kkw; const float ssq = wave_sum(kk * kk); kk = kk / fmaxf(sqrtf(ssq), 1e-12f);
                const float kf = xk * (1.0f + (ar - 1.0f) * kaw);
                const size_t o = (size_t)r * 512 + d;
                arr[A_R * AS + o] = f2bf(xr); arr[A_EW * AS + o] = f2bf(ew); arr[A_KF * AS + o] = f2bf(kf); arr[A_V * AS + o] = f2bf(xv); arr[A_KK * AS + o] = f2bf(kk); arr[A_BB * AS + o] = f2bf(kk * ar); }
            __syncthreads();
        }
    }
    for (int idx = BID * 512 + tid; idx < NMR * 3328; idx += NB * 512) {
        const int m = idx / 3328, e = idx - m * 3328;
        if (e < 1536) { const int j = e >> 9, ch = e & 511; const int row = (m < 8) ? m * 2048 + 2045 + j : MTP + (m - 8) * 4 + 1 + j; const float v = bf2f(PR[(size_t)row * INW + ch]);
            if (m < 8) P->out[O_PCONV + (((size_t)l * 8 + m) * 3 + j) * 512 + ch] = v; else P->out[O_SCONV + (((size_t)l * 128 + (m - 8)) * 3 + j) * 512 + ch] = v; }
        else { const int col = e - 1536; const int row = (m < 8) ? m * 2048 + 2047 : MTP + (m - 8) * 4 + 3; const float v = bf2f(PR[(size_t)row * INW + 1024 + col]);
            if (m < 8) P->out[O_PSHIFT + ((size_t)l * 8 + m) * PW + col] = v; else P->out[O_SSHIFT + ((size_t)l * 128 + (m - 8)) * PW + col] = v; }
    }
}

__device__ __forceinline__ void scan_lru(PP P, int l, LAS unsigned char* lds, const Ids I) {
    const int tid = make_tid(I.wv); unsigned char* ws = P->ws;
    const bf16_t* PR = (const bf16_t*)(ws + WS_R1); const bf16_t* LA = (const bf16_t*)(ws + WS_R2) + (size_t)A_LA * MT * 512; const bf16_t* GX = (const bf16_t*)(ws + WS_R2) + (size_t)A_GX * MT * 512;
    bf16_t* ymix = (bf16_t*)(ws + WS_HB); float* out = P->out;
    LAS f32x2* AB = (LAS f32x2*)lds;
    for (int u = BID; u < 256; u += NB) {
        const int b = u >> 5, ch = (u & 31) * 16 + (tid & 15), chunk = tid >> 4; const unsigned row0 = (unsigned)b * 2048u + (unsigned)chunk * 64u;
        float A = 1.f, B = 0.f;
#pragma unroll 4
        for (unsigned s = 0; s < 64; ++s) { const unsigned o = (row0 + s) * 512u + ch; const float la = bf2f(LA[o]), gx = bf2f(GX[o]); const float a = __expf(la), bb = sqrtf(fmaxf(1.f - a * a, 0.f)) * gx;
            B = a * B + bb; A *= a; }
        AB[chunk * 16 + (tid & 15)] = (f32x2){A, B};
        __syncthreads();
        float h = 0.f;
        for (int c = 0; c < chunk; ++c) { const f32x2 ab = AB[c * 16 + (tid & 15)]; h = ab.x * h + ab.y; }
#pragma unroll 4
        for (unsigned s = 0; s < 64; ++s) { const unsigned row = row0 + s, o = row * 512u + ch; const float la = bf2f(LA[o]), gx = bf2f(GX[o]); const float a = __expf(la), bb = sqrtf(fmaxf(1.f - a * a, 0.f)) * gx;
            h = a * h + bb; const float gb = bf2f(PR[row * (unsigned)INW + 512u + ch]); ymix[row * 1024u + ch] = f2bf(h * gelu_tanh(gb)); }
        if (chunk == 31) out[O_PH + (unsigned)(l * 8 + b) * 512u + ch] = h;
        __syncthreads();
    }
    for (int g = BID * 512 + tid; g < 128 * 512; g += NB * 512) {
        const int sb = g >> 9, ch = g & 511; float h = P->in[I_SH][(unsigned)(l * 128 + sb) * 512u + ch];
#pragma unroll
        for (unsigned s = 0; s < 4; ++s) { const unsigned row = (unsigned)MTP + sb * 4 + s, o = row * 512u + ch; const float la = bf2f(LA[o]), gx = bf2f(GX[o]); const float a = __expf(la), bb = sqrtf(fmaxf(1.f - a * a, 0.f)) * gx;
            h = a * h + bb; const float gb = bf2f(PR[row * (unsigned)INW + 512u + ch]); ymix[row * 1024u + ch] = f2bf(h * gelu_tanh(gb)); }
        out[O_SH + (unsigned)(l * 128 + sb) * 512u + ch] = h;
    }
}
__device__ __forceinline__ f32x4 unpack4(const u32x2 w) { return (f32x4){__uint_as_float(w[0] << 16), __uint_as_float(w[0] & 0xffff0000u), __uint_as_float(w[1] << 16), __uint_as_float(w[1] & 0xffff0000u)}; }
__device__ __forceinline__ void scan_wkv_sample(PP P, int l, const Ids I) {
    const int tid = make_tid(I.wv), wave = __builtin_amdgcn_readfirstlane(tid >> 6), lane = tid & 63, rowl = lane >> 4, kseg = lane & 15; unsigned char* ws = P->ws;
    const bf16_t* arr = (const bf16_t*)(ws + WS_R2); const unsigned AS = (unsigned)MT * 512u; bf16_t* ymix = (bf16_t*)(ws + WS_HB);
    const float* sin_ = P->in[I_SWKV]; float* out = P->out;
    const int gw = BID * 8 + wave, nw = NB * 8;
    for (int q = gw; q < 128 * 8 * 16; q += nw) {
        const int pair = q >> 4, rgp = q & 15, sb = pair >> 3, h = pair & 7, vrow = rgp * 4 + rowl;
        const unsigned so = ((unsigned)((l * 128 + sb) * 8 + h) * 64u + vrow) * 64u + kseg * 4;
        f32x4 S = *(const f32x4*)(sin_ + so);
        f32x4 r_[4], w_[4], k_[4], a_[4], b_[4]; float v_[4];
#pragma unroll
        for (int s = 0; s < 4; ++s) { const unsigned row = (unsigned)MTP + sb * 4 + s, o = row * 512u + h * 64 + kseg * 4;
            r_[s] = unpack4(*(const u32x2*)(arr + A_R * AS + o)); w_[s] = unpack4(*(const u32x2*)(arr + A_EW * AS + o)); k_[s] = unpack4(*(const u32x2*)(arr + A_KF * AS + o));
            a_[s] = unpack4(*(const u32x2*)(arr + A_KK * AS + o)); b_[s] = unpack4(*(const u32x2*)(arr + A_BB * AS + o)); v_[s] = bf2f(arr[A_V * AS + row * 512u + h * 64 + vrow]); }
#pragma unroll
        for (int s = 0; s < 4; ++s) { const unsigned row = (unsigned)MTP + sb * 4 + s;
            const float p = (S[0] * a_[s][0] + S[1] * a_[s][1]) + (S[2] * a_[s][2] + S[3] * a_[s][3]); const float sa = -row16_allsum(p);
#pragma unroll
            for (int j = 0; j < 4; ++j) S[j] = fmaf(S[j], __expf(-w_[s][j]), fmaf(sa, b_[s][j], v_[s] * k_[s][j]));
            const float y = row16_allsum((S[0] * r_[s][0] + S[1] * r_[s][1]) + (S[2] * r_[s][2] + S[3] * r_[s][3]));
            if (kseg == 0) ymix[row * 1024u + 512u + h * 64 + vrow] = f2bf(y); }
        *(f32x4*)(out + O_SWKV + so) = S;
    }
}
__device__ __forceinline__ void scan_wkv_prompt(PP P, int l, LAS unsigned char* lds, const Ids I) {
    const int tid = make_tid(I.wv), wave = __builtin_amdgcn_readfirstlane(tid >> 6), lane = tid & 63, rowl = lane >> 4, kseg = lane & 15; unsigned char* ws = P->ws;
    const bf16_t* arr = (const bf16_t*)(ws + WS_R2); const unsigned AS = (unsigned)MT * 512u; bf16_t* ymix = (bf16_t*)(ws + WS_HB); float* out = P->out;
    LAS float* buf = (LAS float*)lds;
    LAS float* ybuf = buf + 2 * 32 * 336;
    for (int u = BID; u < 256; u += NB) {
        const int bh = u >> 2, rg = u & 3, b = bh >> 3, h = bh & 7; const unsigned rowbase = (unsigned)b * 2048u;
        const int lt = tid & 255, ls = lt >> 3, part = lt & 7;
#define WKV_LOAD(cc) do { const unsigned row = rowbase + (unsigned)(cc) * 32u + ls; const unsigned o = row * 512u + h * 64 + part * 8; \
            const u32x4 vr = *(const u32x4*)(arr + A_R * AS + o), vw = *(const u32x4*)(arr + A_EW * AS + o), vk = *(const u32x4*)(arr + A_KF * AS + o), va = *(const u32x4*)(arr + A_KK * AS + o), vb = *(const u32x4*)(arr + A_BB * AS + o); \
            u32x4 vvv = (u32x4){0u, 0u, 0u, 0u}; if (part < 2) vvv = *(const u32x4*)(arr + A_V * AS + row * 512u + h * 64 + rg * 16 + part * 8); \
            LAS float* dp = buf + ((cc) & 1) * (32 * 336) + ls * 336 + part * 8; float f[8]; \
            unpack8(vr, f); *(LAS f32x4*)(dp) = (f32x4){f[0], f[1], f[2], f[3]}; *(LAS f32x4*)(dp + 4) = (f32x4){f[4], f[5], f[6], f[7]}; \
            unpack8(vw, f); *(LAS f32x4*)(dp + 64) = (f32x4){__expf(-f[0]), __expf(-f[1]), __expf(-f[2]), __expf(-f[3])}; *(LAS f32x4*)(dp + 68) = (f32x4){__expf(-f[4]), __expf(-f[5]), __expf(-f[6]), __expf(-f[7])}; \
            unpack8(vk, f); *(LAS f32x4*)(dp + 128) = (f32x4){f[0], f[1], f[2], f[3]}; *(LAS f32x4*)(dp + 132) = (f32x4){f[4], f[5], f[6], f[7]}; \
            unpack8(va, f); *(LAS f32x4*)(dp + 192) = (f32x4){f[0], f[1], f[2], f[3]}; *(LAS f32x4*)(dp + 196) = (f32x4){f[4], f[5], f[6], f[7]}; \
            unpack8(vb, f); *(LAS f32x4*)(dp + 256) = (f32x4){f[0], f[1], f[2], f[3]}; *(LAS f32x4*)(dp + 260) = (f32x4){f[4], f[5], f[6], f[7]}; \
            if (part < 2) { unpack8(vvv, f); *(LAS f32x4*)(dp + 320) = (f32x4){f[0], f[1], f[2], f[3]}; *(LAS f32x4*)(dp + 324) = (f32x4){f[4], f[5], f[6], f[7]}; } } while (0)
#define WKV_FLUSH(cc) do { const LAS float* yb = ybuf + ((cc) & 1) * 512 + ls * 16 + part * 2; const unsigned row = rowbase + (unsigned)(cc) * 32u + ls; \
            *(unsigned*)(ymix + row * 1024u + 512u + h * 64 + rg * 16 + part * 2) = cvt_pk_bf16(yb[0], yb[1]); } while (0)
        if (wave >= 4) WKV_LOAD(0);
        float S0 = 0.f, S1 = 0.f, S2 = 0.f, S3 = 0.f;
#pragma unroll 1
        for (int c = 0; c < 64; ++c) {
            __syncthreads();
            if (wave < 4) {
                const LAS float* bp = buf + (c & 1) * (32 * 336) + kseg * 4; LAS float* yb = ybuf + (c & 1) * 512; const int vo = 320 + wave * 4 + rowl - kseg * 4;
                f32x4 r4 = *(const LAS f32x4*)(bp), w4 = *(const LAS f32x4*)(bp + 64), k4 = *(const LAS f32x4*)(bp + 128), a4 = *(const LAS f32x4*)(bp + 192), b4 = *(const LAS f32x4*)(bp + 256); float vv = bp[vo];
#pragma unroll 1
                for (int half = 0; half < 2; ++half) {
                    float ykeep = 0.f;
#pragma unroll
                    for (int s = 0; s < 16; ++s) {
                        const LAS float* np = bp + (half * 16 + s + 1) * 336;
                        const f32x4 nr4 = *(const LAS f32x4*)(np), nw4 = *(const LAS f32x4*)(np + 64), nk4 = *(const LAS f32x4*)(np + 128), na4 = *(const LAS f32x4*)(np + 192), nb4 = *(const LAS f32x4*)(np + 256); const float nvv = np[vo];
                        const float p = (S0 * a4[0] + S1 * a4[1]) + (S2 * a4[2] + S3 * a4[3]); const float sa = -row16_allsum(p);
                        S0 = fmaf(S0, w4[0], fmaf(sa, b4[0], vv * k4[0])); S1 = fmaf(S1, w4[1], fmaf(sa, b4[1], vv * k4[1]));
                        S2 = fmaf(S2, w4[2], fmaf(sa, b4[2], vv * k4[2])); S3 = fmaf(S3, w4[3], fmaf(sa, b4[3], vv * k4[3]));
                        const float y = row16_allsum((S0 * r4[0] + S1 * r4[1]) + (S2 * r4[2] + S3 * r4[3]));
                        ykeep = (kseg == s) ? y : ykeep;
                        r4 = nr4; w4 = nw4; k4 = nk4; a4 = na4; b4 = nb4; vv = nvv;
                        asm volatile("" : "+v"(S0), "+v"(S1), "+v"(S2), "+v"(S3), "+v"(ykeep) :: "memory"); __builtin_amdgcn_sched_barrier(0);
                    }
                    yb[(half * 16 + kseg) * 16 + wave * 4 + rowl] = ykeep;
                }
            } else {
                if (c > 0) WKV_FLUSH(c - 1);
                if (c + 1 < 64) WKV_LOAD(c + 1);
            }
        }
        __syncthreads();
        if (wave >= 4) WKV_FLUSH(63);
        else { const int vrow = rg * 16 + wave * 4 + rowl; *(f32x4*)(out + O_PWKV + ((unsigned)((l * 8 + b) * 8 + h) * 64u + vrow) * 64u + kseg * 4) = (f32x4){S0, S1, S2, S3}; }
        __syncthreads();
#undef WKV_LOAD
#undef WKV_FLUSH
    }
}
__device__ __forceinline__ void phase_scan(PP P, int l, LAS unsigned char* lds, const Ids I) {
    scan_lru(P, l, lds, I);
    scan_wkv_sample(P, l, I);
    scan_wkv_prompt(P, l, lds, I);
}

__device__ __forceinline__ void phase_m2(PP P, int l, LAS unsigned char* lds, const Ids I) {
    const int tid_local = make_tid(I.wv);
    const int tid = TID, d = tid; unsigned char* ws = P->ws;
    const bf16_t* PR = (const bf16_t*)(ws + WS_R1); const bf16_t* arr = (const bf16_t*)(ws + WS_R2); const size_t AS = (size_t)MT * 512;
    bf16_t* ymix = (bf16_t*)(ws + WS_HB);
    LAS float* SG = (LAS float*)lds;
    LAS float* LY = SG + 1024; LAS float* LR = LY + 4096; LAS float* LK = LR + 4096; LAS float* LV = LK + 4096;
    const float* mu = P->in[I_MU] + (size_t)l * PW;
    const float lnw = P->in[I_LNW][l * 512 + d], lnb = P->in[I_LNB][l * 512 + d], rk = P->in[I_RK][l * 512 + d];
    float g2c[128];
    { const float* g2 = P->in[I_G2] + (size_t)l * 128 * 512 + d;
#pragma unroll
      for (int c = 0; c < 128; ++c) g2c[c] = g2[c * 512]; }
    for (int u = BID; u < MT / 8; u += NB) {
        const int r0 = u * 8;
#pragma unroll
        for (int i = 0; i < 2; ++i) { const int idx = tid + 512 * i, tok = idx >> 7, col = idx & 127, r = r0 + tok, t = t_in_seq(r);
            const float cur = bf2f(PR[(size_t)r * INW + 2688 + col]);
            const float prev = t > 0 ? bf2f(PR[(size_t)(r - 1) * INW + 2688 + col]) : (r < MTP ? 0.f : P->in[I_SSHIFT][((size_t)l * 128 + ((r - MTP) >> 2)) * PW + 1664 + col]);
            SG[tok * 128 + col] = sigmoidf(cur + (prev - cur) * mu[1664 + col]); }
        { const int tok = tid >> 6, c8 = (tid & 63) * 8; const size_t r = (size_t)r0 + tok; float f[8];
            unpack8(*(const u32x4*)(ymix + r * 1024 + 512 + c8), f); *(LAS f32x4*)(LY + tok * 512 + c8) = (f32x4){f[0], f[1], f[2], f[3]}; *(LAS f32x4*)(LY + tok * 512 + c8 + 4) = (f32x4){f[4], f[5], f[6], f[7]};
            unpack8(*(const u32x4*)(arr + A_R * AS + r * 512 + c8), f); *(LAS f32x4*)(LR + tok * 512 + c8) = (f32x4){f[0], f[1], f[2], f[3]}; *(LAS f32x4*)(LR + tok * 512 + c8 + 4) = (f32x4){f[4], f[5], f[6], f[7]};
            unpack8(*(const u32x4*)(arr + A_KF * AS + r * 512 + c8), f); *(LAS f32x4*)(LK + tok * 512 + c8) = (f32x4){f[0], f[1], f[2], f[3]}; *(LAS f32x4*)(LK + tok * 512 + c8 + 4) = (f32x4){f[4], f[5], f[6], f[7]};
            unpack8(*(const u32x4*)(arr + A_V * AS + r * 512 + c8), f); *(LAS f32x4*)(LV + tok * 512 + c8) = (f32x4){f[0], f[1], f[2], f[3]}; *(LAS f32x4*)(LV + tok * 512 + c8 + 4) = (f32x4){f[4], f[5], f[6], f[7]}; }
        __syncthreads();
#pragma unroll 1
        for (int i = 0; i < 8; ++i) { const size_t r = (size_t)r0 + i; const float y = LY[i * 512 + d], rr = LR[i * 512 + d], kf = LK[i * 512 + d], vv = LV[i * 512 + d];
            float g0 = 0.f, g1 = 0.f, g2_ = 0.f, g3 = 0.f;
#pragma unroll
            for (int q = 0; q < 32; ++q) { const f32x4 sg = *(const LAS f32x4*)(SG + i * 128 + q * 4);
                g0 += sg[0] * g2c[q * 4 + 0]; g1 += sg[1] * g2c[q * 4 + 1]; g2_ += sg[2] * g2c[q * 4 + 2]; g3 += sg[3] * g2c[q * 4 + 3]; }
            const float m = wave_sum(y) * (1.0f / 64.0f), dy = y - m, var = wave_sum(dy * dy) * (1.0f / 64.0f);
            const float yn = dy * rsqrtf(var + 64e-5f) * lnw + lnb;
            const float bs = wave_sum(rr * kf * rk);
            ymix[r * 1024 + 512 + d] = f2bf((yn + bs * vv) * ((g0 + g1) + (g2_ + g3))); }
        __syncthreads();
    }
}

#define XB_TMO      128
#define XB_XCNT(j)  (256  + 64 * (j))
#define XB_XSUB(j)  (1280 + 64 * (j))
#define XB_XGEN(j)  (2304 + 64 * (j))
#define XB_TOP      3328
#define XB_TOPGEN   3392
#define XCD_BAR_WORDS 3456
#define XB_SPIN_CAP (1u << 18)
__device__ __forceinline__ unsigned xb_ld(unsigned* p)              { return __hip_atomic_load(p, __ATOMIC_RELAXED, __HIP_MEMORY_SCOPE_AGENT); }
__device__ __forceinline__ unsigned xb_add(unsigned* p, unsigned v) { return __hip_atomic_fetch_add(p, v, __ATOMIC_RELAXED, __HIP_MEMORY_SCOPE_AGENT); }
__device__ __forceinline__ unsigned xb_xcc_id() { return (unsigned)__builtin_amdgcn_s_getreg((3 << 11) | 20) & 0xFu; }
#define XB_SPIN(cond, bar) do { unsigned _sp = 0; while (cond) { __builtin_amdgcn_s_sleep(1); \
    if ((++_sp & 255u) == 0u) { if (xb_ld(&(bar)[XB_TMO])) break; if (_sp > XB_SPIN_CAP) { atomicAdd(&(bar)[XB_TMO], 1u); break; } } } } while (0)
__device__ __forceinline__ void xcd_barrier_complete(unsigned* bar, unsigned x, unsigned G, unsigned& nloc, unsigned& nx) {
    unsigned sum, cnt, mine, sp = 0u;
    for (;;) {
        sum = 0u; cnt = 0u; mine = 0u;
#pragma unroll
        for (unsigned j = 0; j < 16; ++j) { const unsigned c = xb_ld(&bar[XB_XCNT(j)]); sum += c; cnt += (c > 0u) ? 1u : 0u; mine = (j == x) ? c : mine; }
        if (sum == G) break;
        __builtin_amdgcn_s_sleep(1);
        if ((++sp & 255u) == 0u) { if (xb_ld(&bar[XB_TMO])) break; if (sp > XB_SPIN_CAP) { atomicAdd(&bar[XB_TMO], 1u); break; } }
    }
    nloc = mine > 0u ? mine : 1u; nx = cnt > 0u ? cnt : 1u;
}
__device__ __forceinline__ void xcd_barrier(unsigned* bar, volatile LAS unsigned* st, const Ids I) {
    asm volatile("s_waitcnt vmcnt(0)" ::: "memory");
    __syncthreads();
    if (make_tid(I.wv) == 0) {
        const unsigned x = xb_xcc_id();
        __builtin_amdgcn_s_waitcnt(0);
        unsigned nloc = st[0], nx = st[1];
        if (nloc == 0u) { xcd_barrier_complete(bar, x, (unsigned)I.nb, nloc, nx); st[0] = nloc; st[1] = nx; }
        const unsigned old = xb_add(&bar[XB_XSUB(x)], 1u);
        const unsigned gen = old / nloc;
        if (old + 1u == (gen + 1u) * nloc) {
            __builtin_amdgcn_fence(__ATOMIC_RELEASE, "agent");
            asm volatile("s_waitcnt vmcnt(0)" ::: "memory");
            const unsigned og = xb_add(&bar[XB_TOP], 1u);
            const unsigned tg = og / nx;
            if (og + 1u == (tg + 1u) * nx) xb_add(&bar[XB_TOPGEN], 1u);
            else XB_SPIN(xb_ld(&bar[XB_TOPGEN]) == tg, bar);
            __builtin_amdgcn_fence(__ATOMIC_ACQUIRE, "agent");
            xb_add(&bar[XB_XGEN(x)], 1u);
            asm volatile("s_waitcnt vmcnt(0)" ::: "memory");
        } else {
            XB_SPIN(xb_ld(&bar[XB_XGEN(x)]) == gen, bar);
            __builtin_amdgcn_fence(__ATOMIC_ACQUIRE, "agent");
            asm volatile("s_waitcnt vmcnt(0)" ::: "memory");
        }
    }
    __syncthreads();
}

__global__ void __launch_bounds__(512) mega(Params Pval) {
    extern __shared__ __attribute__((aligned(16))) unsigned char lds_raw[];
    LAS unsigned char* lds = (LAS unsigned char*)lds_raw;
    cg::grid_group grid = cg::this_grid();
    const int NSTEP = 2 + 2 * 12 + 1;
    const int wave_s = __builtin_amdgcn_readfirstlane((int)threadIdx.x >> 6);
    {
        volatile LAS unsigned* st0 = (volatile LAS unsigned*)(lds + LDS_MAIN);
        if (threadIdx.x == 0) { st0[0] = 0u; st0[1] = 0u; (void)xb_add(&((unsigned*)Pval.ws)[XB_XCNT(xb_xcc_id())], 1u); }
        __syncthreads();
    }
#pragma unroll 1
    for (int step = 0; step < NSTEP; ++step) {
        Ids I; I.bid = (int)blockIdx.x; I.nb = (int)gridDim.x; int wv = wave_s;
        unsigned long long pv = (unsigned long long)__builtin_amdgcn_kernarg_segment_ptr();
        asm volatile("" : "+s"(wv), "+s"(I.bid), "+s"(I.nb), "+s"(pv));
        I.bid = __builtin_amdgcn_readfirstlane(I.bid); I.nb = __builtin_amdgcn_readfirstlane(I.nb);
        I.wv = __builtin_amdgcn_readfirstlane(wv);
        PP P = (PP)(((unsigned long long)(unsigned)__builtin_amdgcn_readfirstlane((int)(pv >> 32)) << 32) | (unsigned long long)(unsigned)__builtin_amdgcn_readfirstlane((int)pv));
        unsigned char* ws = P->ws;
        const bool mid = (step >= 2 && step < NSTEP - 1);
        const int l = mid ? (step - 2) / 12 : 0, sub = mid ? (step - 2) % 12 : -1;
        int nrep = 1;
#if PROBE == 1
        if (step == 1 || sub == 1 || sub == 4 || sub == 10) nrep = 2;
#elif PROBE == 2
        if (sub == 6) nrep = 2;
#elif PROBE == 3
        if (step == 0 || sub == 0 || sub == 3 || sub == 9 || sub == 5) nrep = 2;
#elif PROBE == 4
        if (step == 0) nrep = 2;
#elif PROBE == 5
        if (sub == 5) nrep = 2;
#elif PROBE == 6
        if (sub == 3 || sub == 9) nrep = 2;
#elif PROBE == 7
        if (step == 1) { for (int e = 0; e < 20; ++e) xcd_barrier((unsigned*)ws, (volatile LAS unsigned*)(lds + LDS_MAIN), I); }
#endif
#pragma unroll 1
        for (int rep = 0; rep < nrep; ++rep) {
        if (step == 0) phase_prologue(P, lds, I);
        else if (step == 1) { EpiAda E{(float*)(ws + WS_MOD), P->in[I_BADA]}; run_gemm(lds, (const bf16_t*)(ws + WS_AADA), (const bf16_t*)(ws + WS_R2), 256, 2 * 9216, 1024, E, I); }
        else if (step == NSTEP - 1) phase_norm(P, 0, 3, I);
        else {
            const float* modl = (const float*)(ws + WS_MOD) + (size_t)l * NMR * 9216;
            if (sub == 0 || sub == 3 || sub == 9) {
                if (sub == 0 && l == 1) convert_layer(P, 1, lds, I);
                phase_norm(P, l, sub == 0 ? 0 : (sub == 3 ? 1 : 2), I);
            } else if (sub == 1 || sub == 10) {
                EpiSwiGLU E{(bf16_t*)(ws + WS_R1)}; run_gemm(lds, (const bf16_t*)(ws + WS_HB), (const bf16_t*)(ws + (sub == 1 ? WS_WGU1 : WS_WGU2)), MT, 2 * FF, 1024, E, I);
            } else if (sub == 2 || sub == 8 || sub == 11) {
                const int gk = sub == 2 ? 2 : (sub == 8 ? 5 : 8);
                EpiResid E{P->out, modl + gk * 1024, sub == 8 ? 1.0f : 0.5f};
                const bf16_t* A = (const bf16_t*)(ws + (sub == 8 ? WS_HB : WS_R1)); const bf16_t* Bt = (const bf16_t*)(ws + (sub == 2 ? WS_WD1 : (sub == 8 ? WS_WOUT : WS_WD2)));
                run_gemm(lds, A, Bt, MT, 1024, sub == 8 ? 1024 : FF, E, I);
            } else if (sub == 4) {
                EpiProj E{(bf16_t*)(ws + WS_R1)}; run_gemm(lds, (const bf16_t*)(ws + WS_HB), (const bf16_t*)(ws + WS_WIN), MT, INW, 1024, E, I);
            } else if (sub == 5) phase_m1(P, l, lds, I);
            else if (sub == 6) phase_scan(P, l, lds, I);
            else phase_m2(P, l, lds, I);
        }
        if (step == 0) grid.sync();
        else if (step != NSTEP - 1) xcd_barrier((unsigned*)ws, (volatile LAS unsigned*)(lds + LDS_MAIN), I);
        }
    }
}

extern "C" void kernel_launch(void* const* d_in, const int* in_sizes, int n_in, void* d_out, int out_size, void* d_ws, size_t ws_size, hipStream_t stream) {
    static int grid_blocks = 0;
    if (!grid_blocks) {
        if (n_in != 40 || ws_size < WS_END) { fprintf(stderr, "kernel_launch: need 40 inputs and %zu bytes of workspace; got %d, %zu\n", (size_t)WS_END, n_in, ws_size); grid_blocks = -1; return; }
        int dev = 0, cus = 0, per_cu = 0;
        hipGetDevice(&dev);
        hipDeviceGetAttribute(&cus, hipDeviceAttributeMultiprocessorCount, dev);
        hipFuncSetAttribute((const void*)mega, hipFuncAttributeMaxDynamicSharedMemorySize, LDS_BYTES);
        hipOccupancyMaxActiveBlocksPerMultiprocessor(&per_cu, (const void*)mega, 512, LDS_BYTES);
        if (per_cu < 1) { fprintf(stderr, "kernel_launch: occupancy query says %d blocks per CU\n", per_cu); grid_blocks = -1; return; }
        grid_blocks = cus;
    }
    if (grid_blocks < 0) return;
    Params p{};
    for (int i = 0; i < 40; ++i) p.in[i] = (const float*)d_in[i];
    p.out = (float*)d_out; p.ws = (unsigned char*)d_ws;
    if (hipMemsetAsync(d_ws, 0, 16384, stream) != hipSuccess) { fprintf(stderr, "kernel_launch: memset of the barrier words failed\n"); return; }
    void* args[] = {&p};
    hipError_t e = hipLaunchCooperativeKernel((const void*)mega, dim3(grid_blocks), dim3(512), args, LDS_BYTES, stream);
    if (e != hipSuccess) fprintf(stderr, "cooperative launch failed: %s (grid %d)\n", hipGetErrorString(e), grid_blocks);
}
```

```cpp
#include <hip/hip_runtime.h>
#include <hip/hip_cooperative_groups.h>
#include <cstdio>
namespace cg = cooperative_groups;

#define LAS __attribute__((address_space(3)))
typedef unsigned short bf16_t;
typedef short bf16x8 __attribute__((ext_vector_type(8)));
typedef float f32x4 __attribute__((ext_vector_type(4)));
typedef float f32x2 __attribute__((ext_vector_type(2)));
typedef unsigned u32x4 __attribute__((ext_vector_type(4)));
typedef unsigned u32x2 __attribute__((ext_vector_type(2)));

constexpr int D = 1024, MTP = 16384, MTS = 512, MT = 16896, FF = 2816, INW = 2816, PW = 1792, NMR = 136;
#ifndef PROBE
#define PROBE 0
#endif
constexpr int LDS_MAIN = 155648, LDS_BYTES = LDS_MAIN + 16;
constexpr size_t SZ_WGU = (size_t)5632 * 1024 * 2, SZ_WD = (size_t)1024 * 2816 * 2, SZ_WIN = (size_t)2816 * 1024 * 2, SZ_WOUT = (size_t)1024 * 1024 * 2;
constexpr size_t WS_WGU1 = 16384, WS_WD1 = WS_WGU1 + SZ_WGU, WS_WIN = WS_WD1 + SZ_WD, WS_WOUT = WS_WIN + SZ_WIN, WS_WGU2 = WS_WOUT + SZ_WOUT, WS_WD2 = WS_WGU2 + SZ_WGU;
constexpr size_t WS_MOD = WS_WD2 + SZ_WD, SZ_MOD = (size_t)2 * NMR * 9216 * 4;
constexpr size_t WS_AADA = WS_MOD + SZ_MOD, SZ_AADA = (size_t)256 * 1024 * 2;
constexpr size_t WS_HB = WS_AADA + SZ_AADA, SZ_HB = (size_t)MT * 1024 * 2;
constexpr size_t WS_R1 = WS_HB + SZ_HB, SZ_R1 = (size_t)MT * 2816 * 2;
constexpr size_t WS_R2 = WS_R1 + SZ_R1, SZ_ARR = (size_t)MT * 512 * 2;
constexpr size_t WS_END = WS_R2 + 8 * SZ_ARR;
enum { A_LA = 0, A_GX, A_R, A_EW, A_KF, A_V, A_KK, A_BB };
constexpr size_t O_PCONV = (size_t)MT * 1024, O_PH = O_PCONV + 24576, O_PSHIFT = O_PH + 8192, O_PWKV = O_PSHIFT + 28672, O_SCONV = O_PWKV + 524288,
                 O_SH = O_SCONV + 393216, O_SSHIFT = O_SH + 131072, O_SWKV = O_SSHIFT + 458752;
enum { I_XP = 0, I_XS, I_CP, I_CS, I_SCONV, I_SH, I_SSHIFT, I_SWKV, I_WADA, I_BADA, I_F1N, I_F1G, I_F1U, I_F1D, I_MIXN, I_WIN, I_WOUT, I_CONVW, I_CONVB, I_LWX, I_LBX,
       I_LWA, I_LBA, I_LAM, I_MU, I_W0, I_W2, I_A0, I_A2, I_G2, I_KK, I_KA, I_RK, I_LNW, I_LNB, I_F2N, I_F2G, I_F2U, I_F2D, I_FN };

struct Params { const float* in[40]; float* out; unsigned char* ws; };
typedef const __attribute__((address_space(4))) Params* PP;
struct Ids { int wv, bid, nb; };
__device__ __forceinline__ int make_tid(int wv) { int lane_v; asm volatile("v_mbcnt_lo_u32_b32 %0, -1, 0\n\tv_mbcnt_hi_u32_b32 %0, -1, %0" : "=v"(lane_v)); return wv * 64 + lane_v; }
#define TID tid_local
#define BID (I.bid)
#define NB (I.nb)

__device__ __forceinline__ float bf2f(bf16_t h) { return __uint_as_float((unsigned)h << 16); }
__device__ __forceinline__ unsigned cvt_pk_bf16(float lo, float hi) { unsigned r; asm("v_cvt_pk_bf16_f32 %0, %1, %2" : "=v"(r) : "v"(lo), "v"(hi)); return r; }
__device__ __forceinline__ bf16_t f2bf(float f) { return (bf16_t)(cvt_pk_bf16(f, 0.f) & 0xffffu); }
__device__ __forceinline__ float rcpf(float x) { return __builtin_amdgcn_rcpf(x); }
__device__ __forceinline__ float sigmoidf(float x) { return rcpf(1.0f + __expf(-x)); }
__device__ __forceinline__ float tanh_f(float x) { return 1.0f - 2.0f * rcpf(1.0f + __expf(2.0f * x)); }
__device__ __forceinline__ float gelu_tanh(float x) { const float u = 0.7978845608f * (x + 0.044715f * x * x * x); return 0.5f * x * (1.0f + tanh_f(u)); }
__device__ __forceinline__ float softplusf(float x) { return fmaxf(x, 0.f) + log1pf(__expf(-fabsf(x))); }
template <int CTRL> __device__ __forceinline__ float dpp_mov(float x) {
    return __builtin_bit_cast(float, __builtin_amdgcn_update_dpp(0, __builtin_bit_cast(int, x), CTRL, 0xF, 0xF, true));
}
__device__ __forceinline__ float row16_allsum(float x) {
    x += dpp_mov<0xB1>(x); x += dpp_mov<0x4E>(x); x += dpp_mov<0x141>(x); x += dpp_mov<0x140>(x); return x;
}
__device__ __forceinline__ float wave_sum(float x) {
    x = row16_allsum(x);
    const float a = __builtin_bit_cast(float, __builtin_amdgcn_readlane(__builtin_bit_cast(int, x), 0)), b = __builtin_bit_cast(float, __builtin_amdgcn_readlane(__builtin_bit_cast(int, x), 16)),
                c = __builtin_bit_cast(float, __builtin_amdgcn_readlane(__builtin_bit_cast(int, x), 32)), d = __builtin_bit_cast(float, __builtin_amdgcn_readlane(__builtin_bit_cast(int, x), 48));
    return (a + b) + (c + d);
}
__device__ __forceinline__ void unpack8(const u32x4 w, float (&f)[8]) {
#pragma unroll
    for (int i = 0; i < 4; ++i) { f[2 * i] = __uint_as_float(w[i] << 16); f[2 * i + 1] = __uint_as_float(w[i] & 0xffff0000u); }
}
__device__ __forceinline__ int mod_row(int r) { return r < MTP ? (r >> 11) : 8 + ((r - MTP) >> 2); }
__device__ __forceinline__ int t_in_seq(int r) { return r < MTP ? (r & 2047) : ((r - MTP) & 3); }

namespace pg8 {
constexpr int BM = 256, BK = 64, HALF = 128, HTB = HALF * BK * 2, STAGE_BYTES = 8 * HTB, NXCD = 8, WGM = 8;
__device__ __forceinline__ int lds_byte(int r, int c) { const int st = (r >> 4) * 2 + (c >> 5), rr = r & 15, cc = c & 31, ob = rr * 64 + cc * 2; return st * 1024 + (ob ^ (((ob >> 9) & 1) << 5)); }
__device__ __forceinline__ void stage_rc(int b, int& R, int& C) { const int st = b / 1024, sb = b % 1024, swz = sb ^ (((sb >> 9) & 1) << 5); R = (st >> 1) * 16 + swz / 64; C = (st & 1) * 32 + (swz % 64) / 2; }
struct Unit { int pm, pn, kb; };
struct Gemm { const bf16_t* A; const bf16_t* Bt; int M, N, K, ld; };
struct StaticOrder {
    int nM, nN, nwg, G, c;
    __device__ void init(int M, int N, int G_, int c_) { nM = M / BM; nN = N / BM; nwg = nM * nN; G = G_; c = c_; }
    __device__ bool next(int i, Unit& u) const {
        const long L = (long)i * G + c; if (L >= nwg) return false;
        int wgid = (int)L; { const int q = nwg / NXCD, r = nwg % NXCD, xcd = wgid % NXCD, off = wgid / NXCD; wgid = (xcd < r ? xcd * (q + 1) : r * (q + 1) + (xcd - r) * q) + off; }
        const int nig = WGM * nN, gid = wgid / nig, fm = gid * WGM, gsz = (nM - fm) < WGM ? (nM - fm) : WGM;
        u.pm = fm + ((wgid % nig) % gsz); u.pn = (wgid % nig) / gsz; u.kb = 0; return true;
    }
};
struct SplitOrder {
    int nM, nN, nS, G, c, ksb;
    __device__ void init(int M, int N, int nS_, int kslice, int G_, int c_) { nM = M / BM; nN = N / BM; nS = nS_; G = G_; c = c_; ksb = kslice * 2; }
    __device__ bool next(int i, Unit& u) const {
        const int L = i * G + c; if (L >= nM * nN * nS) return false;
        const int sl = L / (nM * nN), rem = L - sl * (nM * nN); u.pm = rem / nN; u.pn = rem - u.pm * nN; u.kb = sl * ksb; return true;
    }
};
template <class Epi, class Sched>
__device__ __forceinline__ void gemm_phase(LAS unsigned char* lds, const Gemm g, const Sched& S, const Epi& E, const Ids I) {
    const int tid_local = make_tid(I.wv);
    const int tid = TID, wid = __builtin_amdgcn_readfirstlane(tid >> 6), lane = tid & 63, wr = wid >> 2, wc = wid & 3, fr = lane & 15, fq = lane >> 4;
    const int K = g.ld, nt = g.K / BK;
    unsigned voffA[2], voffB[2];
#pragma unroll
    for (int i = 0; i < 2; ++i) { int R, C; stage_rc(tid * 16 + i * 8192, R, C); voffA[i] = (unsigned)(R * K + C) * 2u; voffB[i] = (unsigned)(R * K + C) * 2u; }
    const size_t kstep = (size_t)(BK * 2);
    const size_t hstep = (size_t)HALF * K * 2;
    const size_t tstep = 2 * hstep;
    const unsigned ldsw = (unsigned)wid * 1024u;
    const int aoff = lds_byte(wr * 64 + fr, fq * 8), boff = lds_byte(wc * 32 + fr, fq * 8);
#define PG8_SA(b, h) (((b) * 2 + (h)) * HTB)
#define PG8_SB(b, h) ((4 + (b) * 2 + (h)) * HTB)
#define PG8_STAGE(bufoff, gbase, voff) do { _Pragma("unroll") for (int _i = 0; _i < 2; ++_i) \
        __builtin_amdgcn_global_load_lds((const unsigned*)((const char*)(gbase) + (voff)[_i]), (LAS unsigned*)(lds + (bufoff) + ldsw + _i * 8192), 16, 0, 0); } while (0)
#define PG8_LDA(dst, b, h) do { _Pragma("unroll") for (int m = 0; m < 4; ++m) _Pragma("unroll") for (int k = 0; k < 2; ++k) dst[m][k] = *(const LAS bf16x8*)(lds + PG8_SA(b, h) + aoff + m * 2048 + k * 1024); } while (0)
#define PG8_LDB(dst, b, h) do { _Pragma("unroll") for (int n = 0; n < 2; ++n) _Pragma("unroll") for (int k = 0; k < 2; ++k) dst[n][k] = *(const LAS bf16x8*)(lds + PG8_SB(b, h) + boff + n * 2048 + k * 1024); } while (0)
#define PG8_MMA(ai, bj, At, Bt) do { __builtin_amdgcn_s_setprio(1); _Pragma("unroll") for (int m = 0; m < 4; ++m) _Pragma("unroll") for (int n = 0; n < 2; ++n) _Pragma("unroll") for (int k = 0; k < 2; ++k) \
        acc[ai][bj][m][n] = __builtin_amdgcn_mfma_f32_16x16x32_bf16(Bt[n][k], At[m][k], acc[ai][bj][m][n], 0, 0, 0); __builtin_amdgcn_s_setprio(0); } while (0)
#define PG8_WAIT_V(n) asm volatile("s_waitcnt vmcnt(" #n ")" ::: "memory")
#define PG8_WAIT_L(n) asm volatile("s_waitcnt lgkmcnt(" #n ")" ::: "memory")
#define PG8_BAR __builtin_amdgcn_s_barrier()
#define PG8_SCHED __builtin_amdgcn_sched_barrier(0)
    Unit cur, nxt; int ui = 0;
    if (!S.next(0, cur)) return;
    f32x4 acc[2][2][4][2];
#pragma unroll
    for (int a = 0; a < 2; ++a)
#pragma unroll
        for (int b = 0; b < 2; ++b)
#pragma unroll
            for (int m = 0; m < 4; ++m)
#pragma unroll
                for (int n = 0; n < 2; ++n) acc[a][b][m][n] = (f32x4){0.f, 0.f, 0.f, 0.f};
    bf16x8 At[4][2], B0[2][2], B1[2][2];
    const char* cA = (const char*)g.A + (size_t)cur.pm * tstep + cur.kb; const char* cB = (const char*)g.Bt + (size_t)cur.pn * tstep + cur.kb;
    PG8_STAGE(PG8_SB(0, 0), cB, voffB); PG8_STAGE(PG8_SA(0, 0), cA, voffA); PG8_STAGE(PG8_SB(0, 1), cB + hstep, voffB); PG8_STAGE(PG8_SA(0, 1), cA + hstep, voffA);
    if (wr == 1) PG8_BAR;
    PG8_WAIT_V(4); PG8_BAR;
    PG8_STAGE(PG8_SB(1, 0), cB + kstep, voffB); PG8_STAGE(PG8_SA(1, 0), cA + kstep, voffA); PG8_STAGE(PG8_SB(1, 1), cB + hstep + kstep, voffB);
    PG8_WAIT_V(6); PG8_BAR;
    for (;;) {
        const bool has_next = S.next(ui + 1, nxt);
        const char* nA = has_next ? (const char*)g.A + (size_t)nxt.pm * tstep + nxt.kb : cA; const char* nB = has_next ? (const char*)g.Bt + (size_t)nxt.pn * tstep + nxt.kb : cB;
        for (int t = 0; t < nt; t += 2) {
            const bool last = (t == nt - 2);
            const char* a1 = cA + (size_t)(t + 1) * kstep;
            const char* a2 = last ? nA : cA + (size_t)(t + 2) * kstep; const char* b2 = last ? nB : cB + (size_t)(t + 2) * kstep;
            const char* a3 = a2 + kstep; const char* b3 = b2 + kstep;
            PG8_LDB(B0, 0, 0); PG8_SCHED; PG8_LDA(At, 0, 0); PG8_STAGE(PG8_SA(1, 1), a1 + hstep, voffA);
            PG8_WAIT_L(8); PG8_BAR; PG8_WAIT_L(0); PG8_MMA(0, 0, At, B0); PG8_BAR; PG8_SCHED;
            PG8_LDB(B1, 0, 1); PG8_STAGE(PG8_SB(0, 0), b2, voffB);
            PG8_BAR; PG8_WAIT_L(0); PG8_MMA(0, 1, At, B1); PG8_BAR;
            PG8_LDA(At, 0, 1); PG8_STAGE(PG8_SA(0, 0), a2, voffA);
            PG8_BAR; PG8_WAIT_L(0); PG8_MMA(1, 0, At, B0); PG8_BAR; PG8_SCHED;
            PG8_STAGE(PG8_SB(0, 1), b2 + hstep, voffB);
            PG8_WAIT_V(6); PG8_BAR; PG8_MMA(1, 1, At, B1); PG8_BAR;
            PG8_LDB(B0, 1, 0); PG8_SCHED; PG8_LDA(At, 1, 0); PG8_STAGE(PG8_SA(0, 1), a2 + hstep, voffA);
            PG8_WAIT_L(8); PG8_BAR; PG8_WAIT_L(0); PG8_MMA(0, 0, At, B0); PG8_BAR; PG8_SCHED;
            PG8_LDB(B1, 1, 1); PG8_STAGE(PG8_SB(1, 0), b3, voffB);
            PG8_BAR; PG8_WAIT_L(0); PG8_MMA(0, 1, At, B1); PG8_BAR;
            PG8_LDA(At, 1, 1); PG8_STAGE(PG8_SA(1, 0), a3, voffA);
            PG8_BAR; PG8_WAIT_L(0); PG8_MMA(1, 0, At, B0); PG8_BAR; PG8_SCHED;
            PG8_STAGE(PG8_SB(1, 1), b3 + hstep, voffB);
            PG8_WAIT_V(6); PG8_BAR; PG8_MMA(1, 1, At, B1); PG8_BAR;
        }
        E(acc, cur, wr, wc, fr, fq);
        if (!has_next) break;
#pragma unroll
        for (int a = 0; a < 2; ++a)
#pragma unroll
            for (int b = 0; b < 2; ++b)
#pragma unroll
                for (int m = 0; m < 4; ++m)
#pragma unroll
                    for (int n = 0; n < 2; ++n) acc[a][b][m][n] = (f32x4){0.f, 0.f, 0.f, 0.f};
        cur = nxt; cA = nA; cB = nB; ++ui;
    }
    PG8_WAIT_V(0);
    if (wr == 0) PG8_BAR;
    PG8_BAR;
#undef PG8_SA
#undef PG8_SB
#undef PG8_STAGE
#undef PG8_LDA
#undef PG8_LDB
#undef PG8_MMA
#undef PG8_WAIT_V
#undef PG8_WAIT_L
#undef PG8_BAR
#undef PG8_SCHED
}
}

struct EpiSwiGLU {
    bf16_t* act;
    __device__ __forceinline__ void operator()(const f32x4 (&acc)[2][2][4][2], const pg8::Unit& u, int wr, int wc, int fr, int fq) const {
        const int row0 = u.pm * 256 + wr * 64 + fr, col0 = u.pn * 128 + wc * 32 + 8 * fq;
#pragma unroll
        for (int ai = 0; ai < 2; ++ai)
#pragma unroll
            for (int m = 0; m < 4; ++m) { bf16_t* rowp = act + (size_t)(row0 + ai * 128 + m * 16) * FF + col0; float o[8];
#pragma unroll
                for (int n = 0; n < 2; ++n) { const f32x4 gv = acc[ai][0][m][n], uv = acc[ai][1][m][n];
#pragma unroll
                    for (int j = 0; j < 4; ++j) o[4 * n + j] = gv[j] * sigmoidf(gv[j]) * uv[j]; }
                u32x4 w; w.x = cvt_pk_bf16(o[0], o[1]); w.y = cvt_pk_bf16(o[2], o[3]); w.z = cvt_pk_bf16(o[4], o[5]); w.w = cvt_pk_bf16(o[6], o[7]); *(u32x4*)rowp = w; }
    }
};
struct EpiResid {
    float* x; const float* gate; float scale;
    __device__ __forceinline__ void operator()(const f32x4 (&acc)[2][2][4][2], const pg8::Unit& u, int wr, int wc, int fr, int fq) const {
        const int row0 = u.pm * 256 + wr * 64 + fr, col0 = u.pn * 256 + wc * 32 + 4 * fq; const float* gp = gate + (size_t)((u.pm * 256) >> 11) * 9216 + col0;
        f32x4 gv[2][2];
#pragma unroll
        for (int bj = 0; bj < 2; ++bj)
#pragma unroll
            for (int n = 0; n < 2; ++n) gv[bj][n] = *(const f32x4*)(gp + bj * 128 + n * 16) * scale;
#pragma unroll
        for (int ai = 0; ai < 2; ++ai)
#pragma unroll
            for (int m = 0; m < 4; ++m) { const int row = row0 + ai * 128 + m * 16; float* rowp = x + (size_t)row * D + col0;
#pragma unroll
                for (int bj = 0; bj < 2; ++bj)
#pragma unroll
                    for (int n = 0; n < 2; ++n) { const f32x4 xv = *(const f32x4*)(rowp + bj * 128 + n * 16);
                        *(f32x4*)(rowp + bj * 128 + n * 16) = xv + gv[bj][n] * acc[ai][bj][m][n]; }
                asm volatile("" ::: "memory"); }
    }
};
struct EpiPartial {
    float* part;
    __device__ __forceinline__ void operator()(const f32x4 (&acc)[2][2][4][2], const pg8::Unit& u, int wr, int wc, int fr, int fq) const {
        const int row0 = u.pm * 256 + wr * 64 + fr, col0 = u.pn * 256 + wc * 32 + 4 * fq; float* base = part + (size_t)(u.kb >> 9) * MTS * D;
#pragma unroll
        for (int ai = 0; ai < 2; ++ai)
#pragma unroll
            for (int m = 0; m < 4; ++m) { float* rowp = base + (size_t)(row0 + ai * 128 + m * 16) * D + col0;
#pragma unroll
                for (int bj = 0; bj < 2; ++bj)
#pragma unroll
                    for (int n = 0; n < 2; ++n) *(f32x4*)(rowp + bj * 128 + n * 16) = acc[ai][bj][m][n]; }
    }
};
struct EpiProj {
    bf16_t* o;
    __device__ __forceinline__ void operator()(const f32x4 (&acc)[2][2][4][2], const pg8::Unit& u, int wr, int wc, int fr, int fq) const {
        const int row0 = u.pm * 256 + wr * 64 + fr, col0 = u.pn * 256 + wc * 32 + 8 * fq;
#pragma unroll
        for (int ai = 0; ai < 2; ++ai)
#pragma unroll
            for (int m = 0; m < 4; ++m) { bf16_t* rowp = o + (size_t)(row0 + ai * 128 + m * 16) * INW + col0;
#pragma unroll
                for (int bj = 0; bj < 2; ++bj) { const f32x4 v0 = acc[ai][bj][m][0], v1 = acc[ai][bj][m][1];
                    u32x4 w; w.x = cvt_pk_bf16(v0[0], v0[1]); w.y = cvt_pk_bf16(v0[2], v0[3]); w.z = cvt_pk_bf16(v1[0], v1[1]); w.w = cvt_pk_bf16(v1[2], v1[3]); *(u32x4*)(rowp + bj * 128) = w; } }
    }
};
struct EpiAda {
    float* mod; const float* bias;
    __device__ __forceinline__ void operator()(const f32x4 (&acc)[2][2][4][2], const pg8::Unit& u, int wr, int wc, int fr, int fq) const {
        const int row0 = wr * 64 + fr, colg0 = u.pn * 256 + wc * 32 + 4 * fq; const int l = (u.pn >= 36) ? 1 : 0; const int col0 = colg0 - l * 9216;
#pragma unroll
        for (int ai = 0; ai < 2; ++ai)
#pragma unroll
            for (int m = 0; m < 4; ++m) { const int row = row0 + ai * 128 + m * 16;
                if (row < NMR) { float* rowp = mod + ((size_t)l * NMR + row) * 9216 + col0;
#pragma unroll
                    for (int bj = 0; bj < 2; ++bj)
#pragma unroll
                        for (int n = 0; n < 2; ++n) { const f32x4 bv = *(const f32x4*)(bias + colg0 + bj * 128 + n * 16); *(f32x4*)(rowp + bj * 128 + n * 16) = acc[ai][bj][m][n] + bv; } } }
    }
};
template <class Epi> __device__ __forceinline__ void run_gemm(LAS unsigned char* lds, const bf16_t* A, const bf16_t* Bt, int M, int N, int K, const Epi& E, const Ids I) {
    pg8::Gemm g{A, Bt, M, N, K, K}; pg8::StaticOrder S; S.init(M, N, (int)NB, (int)BID); pg8::gemm_phase<Epi, pg8::StaticOrder>(lds, g, S, E, I);
}
template <class Epi> __device__ __forceinline__ void run_gemm_splitk(LAS unsigned char* lds, const bf16_t* A, const bf16_t* Bt, int M, int N, int K, int kslice, const Epi& E, const Ids I) {
    pg8::Gemm g{A, Bt, M, N, kslice, K}; pg8::SplitOrder S; S.init(M, N, K / kslice, kslice, (int)NB, (int)BID); pg8::gemm_phase<Epi, pg8::SplitOrder>(lds, g, S, E, I);
}

__device__ __forceinline__ void conv_tile4(const float* __restrict__ src, int K, int N, bf16_t* __restrict__ dst, int mode, int u4, LAS float* T, const Ids I) {
    const int tid_local = make_tid(I.wv);
    const int tid = TID; const int tilesN = N >> 6;
    f32x4 v[4][2];
#pragma unroll
    for (int q = 0; q < 4; ++q) { const int u = u4 * 4 + q, tk = u / tilesN, tn = u - tk * tilesN;
#pragma unroll
        for (int i = 0; i < 2; ++i) { const int kk = (tid >> 4) + 32 * i, n4 = (tid & 15) * 4; v[q][i] = *(const f32x4*)(src + (size_t)(tk * 64 + kk) * N + tn * 64 + n4); } }
#pragma unroll
    for (int q = 0; q < 4; ++q)
#pragma unroll
        for (int i = 0; i < 2; ++i) { const int kk = (tid >> 4) + 32 * i, n4 = (tid & 15) * 4; LAS float* Tq = T + q * (64 * 65);
            Tq[(n4 + 0) * 65 + kk] = v[q][i][0]; Tq[(n4 + 1) * 65 + kk] = v[q][i][1]; Tq[(n4 + 2) * 65 + kk] = v[q][i][2]; Tq[(n4 + 3) * 65 + kk] = v[q][i][3]; }
    __syncthreads();
#pragma unroll
    for (int q = 0; q < 4; ++q) { const int u = u4 * 4 + q, tk = u / tilesN, tn = u - tk * tilesN;
        const int n = tid >> 3, k8 = (tid & 7) * 8; const int ng = tn * 64 + n; const int m3 = mode & 3; int dr = (m3 == 0) ? ng : (((ng >> 7) << 8) + (m3 == 2 ? 128 : 0) + (ng & 127));
        if (mode & 4) { const int c = dr & 31; dr = (dr & ~31) + 16 * ((c >> 2) & 1) + 4 * (c >> 3) + (c & 3); }
        const LAS float* tp = T + q * (64 * 65) + n * 65 + k8;
        u32x4 w; w.x = cvt_pk_bf16(tp[0], tp[1]); w.y = cvt_pk_bf16(tp[2], tp[3]); w.z = cvt_pk_bf16(tp[4], tp[5]); w.w = cvt_pk_bf16(tp[6], tp[7]);
        *(u32x4*)(dst + (size_t)dr * K + tk * 64 + k8) = w; }
    __syncthreads();
}
__device__ __forceinline__ void convert_layer(PP P, int l, LAS unsigned char* lds, const Ids I) {
    LAS float* T = (LAS float*)lds; unsigned char* ws = P->ws;
    const size_t wl = (size_t)l * 1024 * 2816;
    for (int u = BID; u < 7 * 176 + 64; u += NB) {
        const int mi = u / 176, uu = u - mi * 176;
        if (mi == 0)      conv_tile4(P->in[I_F1G] + wl, 1024, 2816, (bf16_t*)(ws + WS_WGU1), 5, uu, T, I);
        else if (mi == 1) conv_tile4(P->in[I_F1U] + wl, 1024, 2816, (bf16_t*)(ws + WS_WGU1), 6, uu, T, I);
        else if (mi == 2) conv_tile4(P->in[I_F1D] + wl, 2816, 1024, (bf16_t*)(ws + WS_WD1), 0, uu, T, I);
        else if (mi == 3) conv_tile4(P->in[I_WIN] + wl, 1024, 2816, (bf16_t*)(ws + WS_WIN), 4, uu, T, I);
        else if (mi == 4) conv_tile4(P->in[I_F2G] + wl, 1024, 2816, (bf16_t*)(ws + WS_WGU2), 5, uu, T, I);
        else if (mi == 5) conv_tile4(P->in[I_F2U] + wl, 1024, 2816, (bf16_t*)(ws + WS_WGU2), 6, uu, T, I);
        else if (mi == 6) conv_tile4(P->in[I_F2D] + wl, 2816, 1024, (bf16_t*)(ws + WS_WD2), 0, uu, T, I);
        else              conv_tile4(P->in[I_WOUT] + (size_t)l * 1024 * 1024, 1024, 1024, (bf16_t*)(ws + WS_WOUT), 0, uu, T, I);
    }
}
__device__ __forceinline__ void phase_prologue(PP P, LAS unsigned char* lds, const Ids I) {
    const int tid_local = make_tid(I.wv);
    LAS float* T = (LAS float*)lds;
    for (int u = BID; u < 2 * 576; u += NB) {
        const int l = u / 576, uu = u - l * 576;
        conv_tile4(P->in[I_WADA] + (size_t)l * 1024 * 9216, 1024, 9216, (bf16_t*)(P->ws + WS_R2) + (size_t)l * 9216 * 1024, 0, uu, T, I);
    }
    bf16_t* aada = (bf16_t*)(P->ws + WS_AADA);
    for (int idx = BID * 512 + TID; idx < 256 * 1024; idx += NB * 512) {
        const int row = idx >> 10, col = idx & 1023; float v = 0.f;
        if (row < 8) v = P->in[I_CP][row * 1024 + col]; else if (row < NMR) v = P->in[I_CS][(row - 8) * 1024 + col];
        aada[idx] = f2bf(v * sigmoidf(v));
    }
}

__device__ __forceinline__ void phase_norm(PP P, int l, int which, int nsl, const float* fgate, float fscale, const Ids I) {
    const int tid_local = make_tid(I.wv);
    const int lane = TID & 63, gw = BID * 8 + __builtin_amdgcn_readfirstlane(TID >> 6), nw = NB * 8;
    float* xb = P->out; bf16_t* hb = (bf16_t*)(P->ws + WS_HB);
    const float* gamma = which == 0 ? P->in[I_F1N] + l * 1024 : which == 1 ? P->in[I_MIXN] + l * 1024 : which == 2 ? P->in[I_F2N] + l * 1024 : P->in[I_FN];
    const float* modl = (const float*)(P->ws + WS_MOD) + (size_t)l * NMR * 9216;
    const bool from_in = (which == 0 && l == 0);
    for (int row0 = gw; row0 < MT; row0 += 2 * nw) {
        const int rows[2] = {row0, (row0 + nw < MT) ? row0 + nw : row0};
        f32x4 v[2][4]; float ss[2];
#pragma unroll
        for (int j = 0; j < 2; ++j) { const int row = rows[j];
            const float* xr = from_in ? (row < MTP ? P->in[I_XP] + (size_t)row * D : P->in[I_XS] + (size_t)(row - MTP) * D) : xb + (size_t)row * D;
#pragma unroll
            for (int i = 0; i < 4; ++i) v[j][i] = *(const f32x4*)(xr + lane * 4 + 256 * i);
            if (nsl > 0 && row >= MTP && !(j == 1 && row == row0)) {
                const float* pp = (const float*)(P->ws + WS_R2) + (size_t)(row - MTP) * D + lane * 4; const float* gp = fgate + (size_t)mod_row(row) * 9216 + lane * 4;
#pragma unroll
                for (int i = 0; i < 4; ++i) { f32x4 a = (f32x4){0.f, 0.f, 0.f, 0.f};
                    for (int sl = 0; sl < nsl; ++sl) a += *(const f32x4*)(pp + (size_t)sl * MTS * D + 256 * i);
                    v[j][i] += (*(const f32x4*)(gp + 256 * i) * fscale) * a;
                    if (which != 3) *(f32x4*)(xb + (size_t)row * D + lane * 4 + 256 * i) = v[j][i]; } } }
#pragma unroll
        for (int j = 0; j < 2; ++j) { float a = 0.f;
#pragma unroll
            for (int i = 0; i < 4; ++i) a += v[j][i][0] * v[j][i][0] + v[j][i][1] * v[j][i][1] + v[j][i][2] * v[j][i][2] + v[j][i][3] * v[j][i][3];
            ss[j] = wave_sum(a); }
#pragma unroll
        for (int j = 0; j < 2; ++j) { const int row = rows[j];
            if (j == 1 && row == row0) continue;
            const float rstd = rsqrtf(ss[j] * (1.0f / 1024.0f) + 1e-6f);
            if (which == 3) {
#pragma unroll
                for (int i = 0; i < 4; ++i) { const int col = lane * 4 + 256 * i; const f32x4 g4 = *(const f32x4*)(gamma + col); *(f32x4*)(xb + (size_t)row * D + col) = v[j][i] * rstd * g4; }
            } else {
                const float* mr = modl + (size_t)mod_row(row) * 9216 + which * 3 * 1024;
#pragma unroll
                for (int i = 0; i < 4; ++i) { const int col = lane * 4 + 256 * i; const f32x4 g4 = *(const f32x4*)(gamma + col), sh = *(const f32x4*)(mr + col), sc = *(const f32x4*)(mr + 1024 + col);
                    const f32x4 h = (v[j][i] * rstd * g4) * (sc + 1.0f) + sh; u32x2 w; w.x = cvt_pk_bf16(h[0], h[1]); w.y = cvt_pk_bf16(h[2], h[3]);
                    *(u32x2*)(hb + (size_t)row * D + col) = w;
                    if (from_in) *(f32x4*)(xb + (size_t)row * D + col) = v[j][i]; }
            }
        }
    }
}

__device__ __forceinline__ void phase_m1(PP P, int l, LAS unsigned char* lds, const Ids I) {
    const int tid_local = make_tid(I.wv);
    const int tid = TID; unsigned char* ws = P->ws;
    const bf16_t* PR = (const bf16_t*)(ws + WS_R1);
    bf16_t* arr = (bf16_t*)(ws + WS_R2); const size_t AS = (size_t)MT * 512;
#pragma unroll 1
    for (int rep13 = 0; rep13 < (PROBE == 13 ? 2 : 1); ++rep13)
    {
        LAS float* XC = (LAS float*)lds;
        LAS bf16_t* XB = (LAS bf16_t*)(XC + 64 * 68);
        LAS bf16_t* OB = XB + 64 * 72;
        const int d = tid & 63, tg = tid >> 6, lane = tid & 63, quad = lane >> 4, l15 = lane & 15, wv = __builtin_amdgcn_readfirstlane(tid >> 6), mt = wv & 3, half = wv >> 2;
        bf16x8 bfr[4][2]; float bias4[4], sp4[4];
        for (int u = BID; u < 264 * 8; u += NB) {
            const int tt = u >> 3, n = u & 7, r0 = tt * 64, chg = n * 64 + d;
            if (u == BID || (NB & 7) != 0) {
                const float* wsrc = P->in[half ? I_LWA : I_LWX] + ((size_t)l * 8 + n) * 4096;
#pragma unroll
                for (int nt = 0; nt < 4; ++nt) { const int dd = nt * 16 + l15;
#pragma unroll
                    for (int ks = 0; ks < 2; ++ks) { const float* wp = wsrc + (size_t)(ks * 32 + quad * 8) * 64 + dd; u32x4 pk;
                        pk.x = cvt_pk_bf16(wp[0], wp[64]); pk.y = cvt_pk_bf16(wp[128], wp[192]); pk.z = cvt_pk_bf16(wp[256], wp[320]); pk.w = cvt_pk_bf16(wp[384], wp[448]);
                        bfr[nt][ks] = __builtin_bit_cast(bf16x8, pk); }
                    bias4[nt] = P->in[half ? I_LBA : I_LBX][l * 512 + n * 64 + dd]; sp4[nt] = softplusf(-P->in[I_LAM][l * 512 + n * 64 + dd]); } }
            const float* cw = P->in[I_CONVW] + (size_t)l * 4 * 512; const float cwv[4] = {cw[chg], cw[512 + chg], cw[1024 + chg], cw[1536 + chg]}; const float cb = P->in[I_CONVB][l * 512 + chg];
#pragma unroll
            for (int i = 0; i < 8; ++i) { const int r = r0 + tg * 8 + i, t = t_in_seq(r); float a = cb;
#pragma unroll
                for (int j = 0; j < 4; ++j) { const int ts = t - 3 + j; float xv;
                    if (ts >= 0) xv = bf2f(PR[(size_t)(r - 3 + j) * INW + chg]);
                    else xv = (r < MTP) ? 0.f : P->in[I_SCONV][(((size_t)l * 128 + ((r - MTP) >> 2)) * 3 + (ts + 3)) * 512 + chg];
                    a += xv * cwv[j]; }
                XC[d * 68 + tg * 8 + i] = a; XB[(tg * 8 + i) * 72 + d] = f2bf(a); }
            __syncthreads();
            f32x4 acc[4];
#pragma unroll
            for (int nt = 0; nt < 4; ++nt) acc[nt] = (f32x4){0.f, 0.f, 0.f, 0.f};
#pragma unroll
            for (int ks = 0; ks < 2; ++ks) { const bf16x8 af = *(const LAS bf16x8*)(XB + (mt * 16 + l15) * 72 + ks * 32 + quad * 8);
#pragma unroll
                for (int nt = 0; nt < 4; ++nt) acc[nt] = __builtin_amdgcn_mfma_f32_16x16x32_bf16(af, bfr[nt][ks], acc[nt], 0, 0, 0); }
#pragma unroll
            for (int nt = 0; nt < 4; ++nt) { const int dd = nt * 16 + l15;
#pragma unroll
                for (int j = 0; j < 4; ++j) { const int tok = mt * 16 + quad * 4 + j; const float g = sigmoidf(acc[nt][j] + bias4[nt]);
                    if (half) OB[tok * 64 + dd] = f2bf(-8.0f * g * sp4[nt]);
                    else OB[4096 + tok * 64 + dd] = f2bf(g * XC[dd * 68 + tok]); } }
            __syncthreads();
#pragma unroll
            for (int i = 0; i < 2; ++i) { const int idx = tid + 512 * i, a = idx >> 9, rem = idx & 511, tok = rem >> 3, c8 = (rem & 7) * 8;
                *(u32x4*)(arr + (a == 0 ? A_LA : A_GX) * AS + (size_t)(r0 + tok) * 512 + n * 64 + c8) = *(const LAS u32x4*)(OB + a * 4096 + tok * 64 + c8); }
            __syncthreads();
        }
    }
    {
        LAS bf16_t* XSB = (LAS bf16_t*)lds;
        LAS bf16_t* AL = XSB + 16 * 1536;
        LAS bf16_t* OR = AL + 16 * 136;
        const int lane = tid & 63, quad = lane >> 4, l15 = lane & 15, hd = __builtin_amdgcn_readfirstlane(tid >> 6); const float* mu = P->in[I_MU] + (size_t)l * PW;
        bf16x8 bfw[4][2], bfa[4][2]; float w0v[4], a0v[4], kkv[4], kav[4];
#pragma unroll
        for (int nt = 0; nt < 4; ++nt) { const int dd = hd * 64 + nt * 16 + l15;
            w0v[nt] = P->in[I_W0][l * 512 + dd]; a0v[nt] = P->in[I_A0][l * 512 + dd]; kkv[nt] = P->in[I_KK][l * 512 + dd]; kav[nt] = P->in[I_KA][l * 512 + dd];
#pragma unroll
            for (int ks = 0; ks < 2; ++ks) { const float* wp = P->in[I_W2] + ((size_t)l * 64 + ks * 32 + quad * 8) * 512 + dd; const float* ap = P->in[I_A2] + ((size_t)l * 64 + ks * 32 + quad * 8) * 512 + dd; u32x4 pk;
                pk.x = cvt_pk_bf16(wp[0], wp[512]); pk.y = cvt_pk_bf16(wp[1024], wp[1536]); pk.z = cvt_pk_bf16(wp[2048], wp[2560]); pk.w = cvt_pk_bf16(wp[3072], wp[3584]); bfw[nt][ks] = __builtin_bit_cast(bf16x8, pk);
                pk.x = cvt_pk_bf16(ap[0], ap[512]); pk.y = cvt_pk_bf16(ap[1024], ap[1536]); pk.z = cvt_pk_bf16(ap[2048], ap[2560]); pk.w = cvt_pk_bf16(ap[3072], ap[3584]); bfa[nt][ks] = __builtin_bit_cast(bf16x8, pk); } }
        for (int u = BID; u < MT / 16; u += NB) {
            const int r0 = u * 16;
#pragma unroll
            for (int it = 0; it < 7; ++it) { const int e = tid + 512 * it;
                if (e < 16 * 208) { const int tok = e / 208, col = (e - tok * 208) * 8, r = r0 + tok, t = t_in_seq(r);
                    float cf[8], pf[8]; unpack8(*(const u32x4*)(PR + (size_t)r * INW + 1024 + col), cf);
                    if (t > 0) unpack8(*(const u32x4*)(PR + (size_t)(r - 1) * INW + 1024 + col), pf);
                    else if (r < MTP) {
#pragma unroll
                        for (int j = 0; j < 8; ++j) pf[j] = 0.f; }
                    else { const float* sp = P->in[I_SSHIFT] + ((size_t)l * 128 + ((r - MTP) >> 2)) * PW + col; const f32x4 s0 = *(const f32x4*)sp, s1 = *(const f32x4*)(sp + 4);
#pragma unroll
                        for (int j = 0; j < 4; ++j) { pf[j] = s0[j]; pf[4 + j] = s1[j]; } }
                    const f32x4 m0 = *(const f32x4*)(mu + col), m1 = *(const f32x4*)(mu + col + 4); float xs[8];
#pragma unroll
                    for (int j = 0; j < 4; ++j) { xs[j] = cf[j] + (pf[j] - cf[j]) * m0[j]; xs[4 + j] = cf[4 + j] + (pf[4 + j] - cf[4 + j]) * m1[j]; }
                    if (col >= 1536 && col < 1600) {
#pragma unroll
                        for (int j = 0; j < 8; ++j) xs[j] = tanh_f(xs[j]); }
                    u32x4 w; w.x = cvt_pk_bf16(xs[0], xs[1]); w.y = cvt_pk_bf16(xs[2], xs[3]); w.z = cvt_pk_bf16(xs[4], xs[5]); w.w = cvt_pk_bf16(xs[6], xs[7]);
                    if (col < 1536) *(LAS u32x4*)(XSB + tok * 1536 + col) = w; else *(LAS u32x4*)(AL + tok * 136 + (col - 1536)) = w; } }
            __syncthreads();
            f32x4 aw[4], aa[4];
#pragma unroll
            for (int nt = 0; nt < 4; ++nt) { aw[nt] = (f32x4){0.f, 0.f, 0.f, 0.f}; aa[nt] = (f32x4){0.f, 0.f, 0.f, 0.f}; }
#pragma unroll
            for (int ks = 0; ks < 2; ++ks) { const bf16x8 fw = *(const LAS bf16x8*)(AL + l15 * 136 + ks * 32 + quad * 8), fa = *(const LAS bf16x8*)(AL + l15 * 136 + 64 + ks * 32 + quad * 8);
#pragma unroll
                for (int nt = 0; nt < 4; ++nt) { aw[nt] = __builtin_amdgcn_mfma_f32_16x16x32_bf16(fw, bfw[nt][ks], aw[nt], 0, 0, 0); aa[nt] = __builtin_amdgcn_mfma_f32_16x16x32_bf16(fa, bfa[nt][ks], aa[nt], 0, 0, 0); } }
#pragma unroll
            for (int j = 0; j < 4; ++j) { const int tk = quad * 4 + j; const LAS bf16_t* xp = XSB + tk * 1536 + hd * 64 + l15; float xk[4], ar[4], kk[4]; float ssq = 0.f;
#pragma unroll
                for (int nt = 0; nt < 4; ++nt) { xk[nt] = bf2f(xp[512 + nt * 16]); ar[nt] = sigmoidf(a0v[nt] + aa[nt][j]); kk[nt] = xk[nt] * kkv[nt]; ssq += kk[nt] * kk[nt]; }
                const float rn = 1.0f / fmaxf(sqrtf(row16_allsum(ssq)), 1e-12f);
#pragma unroll
                for (int nt = 0; nt < 4; ++nt) { LAS bf16_t* ob = OR + tk * 512 + hd * 64 + nt * 16 + l15; const float kn = kk[nt] * rn;
                    ob[0] = xp[nt * 16];
                    ob[8192] = f2bf(0.60653066f * sigmoidf(w0v[nt] + aw[nt][j]));
                    ob[2 * 8192] = f2bf(xk[nt] * (1.0f + (ar[nt] - 1.0f) * kav[nt]));
                    ob[3 * 8192] = xp[1024 + nt * 16];
                    ob[4 * 8192] = f2bf(kn); ob[5 * 8192] = f2bf(kn * ar[nt]); } }
            __syncthreads();
#pragma unroll
            for (int i = 0; i < 2; ++i) { const int idx = tid + 512 * i, tok = idx >> 6, c8 = (idx & 63) * 8; const size_t o = (size_t)(r0 + tok) * 512 + c8; const LAS bf16_t* ob = OR + tok * 512 + c8;
                *(u32x4*)(arr + A_R * AS + o) = *(const LAS u32x4*)(ob); *(u32x4*)(arr + A_EW * AS + o) = *(const LAS u32x4*)(ob + 8192); *(u32x4*)(arr + A_KF * AS + o) = *(const LAS u32x4*)(ob + 2 * 8192);
                *(u32x4*)(arr + A_V * AS + o) = *(const LAS u32x4*)(ob + 3 * 8192); *(u32x4*)(arr + A_KK * AS + o) = *(const LAS u32x4*)(ob + 4 * 8192); *(u32x4*)(arr + A_BB * AS + o) = *(const LAS u32x4*)(ob + 5 * 8192); }
        }
        __syncthreads();
    }
    for (int idx = BID * 512 + tid; idx < NMR * 3328; idx += NB * 512) {
        const int m = idx / 3328, e = idx - m * 3328;
        if (e < 1536) { const int j = e >> 9, ch = e & 511; const int row = (m < 8) ? m * 2048 + 2045 + j : MTP + (m - 8) * 4 + 1 + j; const float v = bf2f(PR[(size_t)row * INW + ch]);
            if (m < 8) P->out[O_PCONV + (((size_t)l * 8 + m) * 3 + j) * 512 + ch] = v; else P->out[O_SCONV + (((size_t)l * 128 + (m - 8)) * 3 + j) * 512 + ch] = v; }
        else { const int col = e - 1536; const int row = (m < 8) ? m * 2048 + 2047 : MTP + (m - 8) * 4 + 3; const float v = bf2f(PR[(size_t)row * INW + 1024 + col]);
            if (m < 8) P->out[O_PSHIFT + ((size_t)l * 8 + m) * PW + col] = v; else P->out[O_SSHIFT + ((size_t)l * 128 + (m - 8)) * PW + col] = v; }
    }
}

__device__ __forceinline__ void scan_lru(PP P, int l, LAS unsigned char* lds, const Ids I) {
    const int tid = make_tid(I.wv); unsigned char* ws = P->ws;
    const bf16_t* PR = (const bf16_t*)(ws + WS_R1); const bf16_t* LA = (const bf16_t*)(ws + WS_R2) + (size_t)A_LA * MT * 512; const bf16_t* GX = (const bf16_t*)(ws + WS_R2) + (size_t)A_GX * MT * 512;
    bf16_t* ymix = (bf16_t*)(ws + WS_HB); float* out = P->out;
    for (int g = BID * 512 + tid; g < 128 * 512; g += NB * 512) {
        const int sb = g >> 9, ch = g & 511; float h = P->in[I_SH][(unsigned)(l * 128 + sb) * 512u + ch];
#pragma unroll
        for (unsigned s = 0; s < 4; ++s) { const unsigned row = (unsigned)MTP + sb * 4 + s, o = row * 512u + ch; const float la = bf2f(LA[o]), gx = bf2f(GX[o]); const float a = __expf(la), bb = sqrtf(fmaxf(1.f - a * a, 0.f)) * gx;
            h = a * h + bb; const float gb = bf2f(PR[row * (unsigned)INW + 512u + ch]); ymix[row * 1024u + ch] = f2bf(h * gelu_tanh(gb)); }
        out[O_SH + (unsigned)(l * 128 + sb) * 512u + ch] = h;
    }
}
__device__ __forceinline__ f32x4 unpack4(const u32x2 w) { return (f32x4){__uint_as_float(w[0] << 16), __uint_as_float(w[0] & 0xffff0000u), __uint_as_float(w[1] << 16), __uint_as_float(w[1] & 0xffff0000u)}; }
__device__ __forceinline__ void scan_wkv_sample(PP P, int l, const Ids I) {
    const int tid = make_tid(I.wv), wave = __builtin_amdgcn_readfirstlane(tid >> 6), lane = tid & 63, rowl = lane >> 4, kseg = lane & 15; unsigned char* ws = P->ws;
    const bf16_t* arr = (const bf16_t*)(ws + WS_R2); const unsigned AS = (unsigned)MT * 512u; bf16_t* ymix = (bf16_t*)(ws + WS_HB);
    const float* sin_ = P->in[I_SWKV]; float* out = P->out;
    const int gw = BID * 8 + wave, nw = NB * 8;
    for (int q = gw; q < 128 * 8 * 16; q += nw) {
        const int pair = q >> 4, rgp = q & 15, sb = pair >> 3, h = pair & 7, vrow = rgp * 4 + rowl;
        const unsigned so = ((unsigned)((l * 128 + sb) * 8 + h) * 64u + vrow) * 64u + kseg * 4;
        f32x4 S = *(const f32x4*)(sin_ + so);
        f32x4 r_[4], w_[4], k_[4], a_[4], b_[4]; float v_[4];
#pragma unroll
        for (int s = 0; s < 4; ++s) { const unsigned row = (unsigned)MTP + sb * 4 + s, o = row * 512u + h * 64 + kseg * 4;
            r_[s] = unpack4(*(const u32x2*)(arr + A_R * AS + o)); w_[s] = unpack4(*(const u32x2*)(arr + A_EW * AS + o)); k_[s] = unpack4(*(const u32x2*)(arr + A_KF * AS + o));
            a_[s] = unpack4(*(const u32x2*)(arr + A_KK * AS + o)); b_[s] = unpack4(*(const u32x2*)(arr + A_BB * AS + o)); v_[s] = bf2f(arr[A_V * AS + row * 512u + h * 64 + vrow]); }
#pragma unroll
        for (int s = 0; s < 4; ++s) { const unsigned row = (unsigned)MTP + sb * 4 + s;
            const float p = (S[0] * a_[s][0] + S[1] * a_[s][1]) + (S[2] * a_[s][2] + S[3] * a_[s][3]); const float sa = -row16_allsum(p);
#pragma unroll
            for (int j = 0; j < 4; ++j) S[j] = fmaf(S[j], __expf(-w_[s][j]), fmaf(sa, b_[s][j], v_[s] * k_[s][j]));
            const float y = row16_allsum((S[0] * r_[s][0] + S[1] * r_[s][1]) + (S[2] * r_[s][2] + S[3] * r_[s][3]));
            if (kseg == 0) ymix[row * 1024u + 512u + h * 64 + vrow] = f2bf(y); }
        *(f32x4*)(out + O_SWKV + so) = S;
    }
}
__device__ __forceinline__ float fma_asm(float a, float b, float c) { float d; asm("v_fma_f32 %0, %1, %2, %3" : "=v"(d) : "v"(a), "v"(b), "v"(c)); return d; }
__device__ __forceinline__ float fnma_asm(float a, float b, float c) { float d; asm("v_fma_f32 %0, -%1, %2, %3" : "=v"(d) : "v"(a), "v"(b), "v"(c)); return d; }
__device__ __forceinline__ float mul_asm(float a, float b) { float d; asm("v_mul_f32 %0, %1, %2" : "=v"(d) : "v"(a), "v"(b)); return d; }
__device__ __forceinline__ void scan_wkv_prompt(PP P, int l, LAS unsigned char* lds, const Ids I) {
    const int tid = make_tid(I.wv), wave = __builtin_amdgcn_readfirstlane(tid >> 6), lane = tid & 63, rowl = lane >> 4, kseg = lane & 15; unsigned char* ws = P->ws;
    const bf16_t* arr = (const bf16_t*)(ws + WS_R2); const unsigned AS = (unsigned)MT * 512u; bf16_t* ymix = (bf16_t*)(ws + WS_HB); float* out = P->out;
    LAS float* buf = (LAS float*)lds;
    LAS float* ybuf = buf + 2 * 32 * 336;
    LAS unsigned char* raw = lds + 90112;
#define WKV_BAR() do { asm volatile("s_waitcnt lgkmcnt(0)" ::: "memory"); __builtin_amdgcn_s_barrier(); asm volatile("" ::: "memory"); } while (0)
    for (int u = BID; u < 256; u += NB) {
        const int bh = u >> 2, rg = u & 3, b = bh >> 3, h = bh & 7; const unsigned rowbase = (unsigned)b * 2048u;
        if (wave >= 4) {
            const int lw = wave - 4, lsl = lane >> 3, part = lane & 7, ls = lw * 8 + lsl;
            const bf16_t* g5[5] = {arr + A_R * AS, arr + A_EW * AS, arr + A_KF * AS, arr + A_KK * AS, arr + A_BB * AS};
#define WKV_DMA(cc) do { const unsigned row = rowbase + (unsigned)(cc) * 32u + ls; const unsigned o = row * 512u + h * 64 + part * 8; LAS unsigned char* slot = raw + ((cc) & 1) * 21504 + lw * 1024; \
            _Pragma("unroll") for (int a = 0; a < 5; ++a) __builtin_amdgcn_global_load_lds((const unsigned*)(g5[a] + o), (LAS unsigned*)(slot + a * 4096), 16, 0, 0); \
            __builtin_amdgcn_global_load_lds((const unsigned*)(arr + A_V * AS + row * 512u + h * 64 + rg * 16 + part * 2), (LAS unsigned*)(raw + ((cc) & 1) * 21504 + 20480 + lw * 256), 4, 0, 0); } while (0)
#define WKV_CONVERT(cc) do { const LAS unsigned char* slot = raw + ((cc) & 1) * 21504 + lw * 1024 + lane * 16; LAS float* dp = buf + ((cc) & 1) * (32 * 336) + ls * 336 + part * 8; float f[8]; \
            const u32x4 vr = *(const LAS u32x4*)(slot), vw = *(const LAS u32x4*)(slot + 4096), vk = *(const LAS u32x4*)(slot + 8192), va = *(const LAS u32x4*)(slot + 12288), vb = *(const LAS u32x4*)(slot + 16384); \
            const u32x4 vvv = *(const LAS u32x4*)(raw + ((cc) & 1) * 21504 + 20480 + lw * 256 + lsl * 32 + (part & 1) * 16); \
            unpack8(vr, f); *(LAS f32x4*)(dp) = (f32x4){f[0], f[1], f[2], f[3]}; *(LAS f32x4*)(dp + 4) = (f32x4){f[4], f[5], f[6], f[7]}; \
            unpack8(vw, f); *(LAS f32x4*)(dp + 64) = (f32x4){__expf(-f[0]), __expf(-f[1]), __expf(-f[2]), __expf(-f[3])}; *(LAS f32x4*)(dp + 68) = (f32x4){__expf(-f[4]), __expf(-f[5]), __expf(-f[6]), __expf(-f[7])}; \
            unpack8(vk, f); *(LAS f32x4*)(dp + 128) = (f32x4){f[0], f[1], f[2], f[3]}; *(LAS f32x4*)(dp + 132) = (f32x4){f[4], f[5], f[6], f[7]}; \
            unpack8(va, f); *(LAS f32x4*)(dp + 192) = (f32x4){f[0], f[1], f[2], f[3]}; *(LAS f32x4*)(dp + 196) = (f32x4){f[4], f[5], f[6], f[7]}; \
            unpack8(vb, f); *(LAS f32x4*)(dp + 256) = (f32x4){f[0], f[1], f[2], f[3]}; *(LAS f32x4*)(dp + 260) = (f32x4){f[4], f[5], f[6], f[7]}; \
            if (part < 2) { unpack8(vvv, f); *(LAS f32x4*)(dp + 320) = (f32x4){f[0], f[1], f[2], f[3]}; *(LAS f32x4*)(dp + 324) = (f32x4){f[4], f[5], f[6], f[7]}; } } while (0)
#define WKV_FLUSH(cc) do { const LAS float* yb = ybuf + ((cc) & 1) * 512 + ls * 16 + part * 2; const unsigned row = rowbase + (unsigned)(cc) * 32u + ls - 1u;     \
            if ((cc) > 0 || ls > 0) *(unsigned*)(ymix + row * 1024u + 512u + h * 64 + rg * 16 + part * 2) = cvt_pk_bf16(yb[0], yb[1]); } while (0)
            WKV_DMA(0); WKV_DMA(1);
            asm volatile("s_waitcnt vmcnt(6)" ::: "memory");
            WKV_CONVERT(0);
            LAS f32x2* LAB = (LAS f32x2*)(lds + 133120);
            const bf16_t* LAp = arr + A_LA * AS; const bf16_t* GXp = arr + A_GX * AS; const bf16_t* PRp = (const bf16_t*)(ws + WS_R1);
            const int lck = (tid & 255) >> 4, lcl = tid & 15, lch = (u & 31) * 16 + lcl; const unsigned lrow0 = (unsigned)(u >> 5) * 2048u + (unsigned)lck * 128u;
            float lA = 1.f, lB = 0.f, lh = 0.f;
#pragma unroll 1
            for (int c = 0; c < 64; ++c) {
                WKV_BAR();
                asm volatile("s_waitcnt vmcnt(0)" ::: "memory");
                const unsigned lr = lrow0 + (unsigned)(c & 31) * 4u; bf16_t vla[4], vgx[4], vgb[4];
#pragma unroll
                for (int k = 0; k < 4; ++k) { vla[k] = LAp[(lr + k) * 512u + lch]; vgx[k] = GXp[(lr + k) * 512u + lch]; vgb[k] = PRp[(lr + k) * (unsigned)INW + 512u + lch]; }
                if (c > 0) WKV_FLUSH(c - 1);
                if (c + 2 < 64) WKV_DMA(c + 2);
                if (c + 1 < 64) WKV_CONVERT(c + 1);
                if (c == 32) { for (int q = 0; q < lck; ++q) { const f32x2 ab = LAB[q * 16 + lcl]; lh = ab.x * lh + ab.y; } }
#pragma unroll
                for (int k = 0; k < 4; ++k) { const float la = bf2f(vla[k]), gx = bf2f(vgx[k]); const float a = __expf(la), bb = sqrtf(fmaxf(1.f - a * a, 0.f)) * gx;
                    if (c < 32) { lB = a * lB + bb; lA *= a; }
                    else { lh = a * lh + bb; ymix[(lr + k) * 1024u + lch] = f2bf(lh * gelu_tanh(bf2f(vgb[k]))); } }
                if (c == 31) LAB[lck * 16 + lcl] = (f32x2){lA, lB};
            }
            if (lck == 15) out[O_PH + (unsigned)(l * 8 + (u >> 5)) * 512u + lch] = lh;
            WKV_BAR();
            WKV_FLUSH(63);
            WKV_BAR();
#undef WKV_DMA
#undef WKV_CONVERT
#undef WKV_FLUSH
        } else {
#define DPPA(x, ctl) "v_add_f32_dpp " x ", " x ", " x " " ctl " row_mask:0xf bank_mask:0xf bound_ctrl:1\n\t"
            float S0 = 0.f, S1 = 0.f, S2 = 0.f, S3 = 0.f; f32x4 rp = (f32x4){0.f, 0.f, 0.f, 0.f};
#if PROBE == 11 || PROBE == 12
            float dmy = 0.f, dmy2;
#endif
            __builtin_amdgcn_s_setprio(3);
#pragma unroll 1
            for (int c = 0; c < 64; ++c) {
                WKV_BAR();
                const LAS float* bp = buf + (c & 1) * (32 * 336) + kseg * 4; LAS float* yb = ybuf + (c & 1) * 512; const int vo = 320 + wave * 4 + rowl - kseg * 4;
                f32x4 r4 = *(const LAS f32x4*)(bp), w4 = *(const LAS f32x4*)(bp + 64), k4 = *(const LAS f32x4*)(bp + 128), a4 = *(const LAS f32x4*)(bp + 192), b4 = *(const LAS f32x4*)(bp + 256); float vv = bp[vo];
                f32x4 nr4 = *(const LAS f32x4*)(bp + 336), nw4 = *(const LAS f32x4*)(bp + 336 + 64), nk4 = *(const LAS f32x4*)(bp + 336 + 128), na4 = *(const LAS f32x4*)(bp + 336 + 192), nb4 = *(const LAS f32x4*)(bp + 336 + 256); float nvv = bp[336 + vo];
                float ykeep = 0.f;
#pragma unroll
                for (int s = 0; s < 32; ++s) {
                    const LAS float* np = bp + (s + 2) * 336;
                    const f32x4 mr4 = *(const LAS f32x4*)(np), mw4 = *(const LAS f32x4*)(np + 64), mk4 = *(const LAS f32x4*)(np + 128), ma4 = *(const LAS f32x4*)(np + 192), mb4 = *(const LAS f32x4*)(np + 256); const float mvv = np[vo];
                    __builtin_amdgcn_sched_barrier(0);
                    float sum, y, p1, q1, t0, t1, t2, t3;
                    asm volatile(
                        "v_mul_f32 %0, %8, %12\n\t"  "v_mul_f32 %1, %8, %16\n\t"
                        "v_fma_f32 %0, %9, %13, %0\n\t"  "v_fma_f32 %1, %9, %17, %1\n\t"
                        "v_mul_f32 %2, %10, %14\n\t"  "v_mul_f32 %3, %10, %18\n\t"
                        "v_fma_f32 %2, %11, %15, %2\n\t"  "v_fma_f32 %3, %11, %19, %3\n\t"
                        "v_add_f32 %0, %0, %2\n\t"  "v_add_f32 %1, %1, %3\n\t"
                        "v_mul_f32 %4, %20, %21\n\t"  "v_mul_f32 %5, %20, %22\n\t"
                        DPPA("%0", "quad_perm:[1,0,3,2]") DPPA("%1", "quad_perm:[1,0,3,2]")
                        "v_mul_f32 %6, %20, %23\n\t"
                        DPPA("%0", "quad_perm:[2,3,0,1]") DPPA("%1", "quad_perm:[2,3,0,1]")
                        "v_mul_f32 %7, %20, %24\n\t"
                        DPPA("%0", "row_half_mirror") DPPA("%1", "row_half_mirror")
                        "s_nop 0\n\t"
                        DPPA("%0", "row_mirror") DPPA("%1", "row_mirror")
                        : "=&v"(sum), "=&v"(y), "=&v"(p1), "=&v"(q1), "=&v"(t0), "=&v"(t1), "=&v"(t2), "=&v"(t3)
                        : "v"(S0), "v"(S1), "v"(S2), "v"(S3), "v"(a4[0]), "v"(a4[1]), "v"(a4[2]), "v"(a4[3]), "v"(rp[0]), "v"(rp[1]), "v"(rp[2]), "v"(rp[3]),
                          "v"(vv), "v"(k4[0]), "v"(k4[1]), "v"(k4[2]), "v"(k4[3]));
                    asm volatile(
                        "v_fma_f32 %4, -%8, %9, %4\n\t"  "v_fma_f32 %5, -%8, %10, %5\n\t"  "v_fma_f32 %6, -%8, %11, %6\n\t"  "v_fma_f32 %7, -%8, %12, %7\n\t"
                        "v_fma_f32 %0, %0, %13, %4\n\t"  "v_fma_f32 %1, %1, %14, %5\n\t"  "v_fma_f32 %2, %2, %15, %6\n\t"  "v_fma_f32 %3, %3, %16, %7"
                        : "+v"(S0), "+v"(S1), "+v"(S2), "+v"(S3), "+v"(t0), "+v"(t1), "+v"(t2), "+v"(t3)
                        : "v"(sum), "v"(b4[0]), "v"(b4[1]), "v"(b4[2]), "v"(b4[3]), "v"(w4[0]), "v"(w4[1]), "v"(w4[2]), "v"(w4[3]));
                    ykeep = (kseg == (s & 15)) ? y : ykeep;
                    rp = r4; r4 = nr4; w4 = nw4; k4 = nk4; a4 = na4; b4 = nb4; vv = nvv;
                    nr4 = mr4; nw4 = mw4; nk4 = mk4; na4 = ma4; nb4 = mb4; nvv = mvv;
                    asm volatile("" : "+v"(S0), "+v"(S1), "+v"(S2), "+v"(S3), "+v"(ykeep) :: "memory"); __builtin_amdgcn_sched_barrier(0);
                    if ((s & 15) == 15) yb[((s & 16) + kseg) * 16 + wave * 4 + rowl] = ykeep;
                }
            }
            __builtin_amdgcn_s_setprio(0);
            WKV_BAR();
            { const int vrow = rg * 16 + wave * 4 + rowl; *(f32x4*)(out + O_PWKV + ((unsigned)((l * 8 + b) * 8 + h) * 64u + vrow) * 64u + kseg * 4) = (f32x4){S0, S1, S2, S3};
              const float ylast = row16_allsum((S0 * rp[0] + S1 * rp[1]) + (S2 * rp[2] + S3 * rp[3]));
              if (kseg == 0) ymix[(rowbase + 2047u) * 1024u + 512u + h * 64 + vrow] = (bf16_t)(cvt_pk_bf16(ylast, 0.f) & 0xffffu); }
            WKV_BAR();
#undef DPPA
        }
    }
#undef WKV_BAR
}
__device__ __forceinline__ void phase_scan(PP P, int l, LAS unsigned char* lds, const Ids I) {
#pragma unroll 1
    for (int rep = 0; rep < (PROBE == 8 ? 2 : 1); ++rep) scan_lru(P, l, lds, I);
#pragma unroll 1
    for (int rep = 0; rep < (PROBE == 9 ? 2 : 1); ++rep) scan_wkv_sample(P, l, I);
    scan_wkv_prompt(P, l, lds, I);
}

__device__ __forceinline__ void phase_m2(PP P, int l, LAS unsigned char* lds, const Ids I) {
    const int tid_local = make_tid(I.wv);
    const int tid = TID, d = tid; unsigned char* ws = P->ws;
    const bf16_t* PR = (const bf16_t*)(ws + WS_R1); const bf16_t* arr = (const bf16_t*)(ws + WS_R2); const size_t AS = (size_t)MT * 512;
    bf16_t* ymix = (bf16_t*)(ws + WS_HB);
    LAS float* SG = (LAS float*)lds;
    LAS float* LY = SG + 1024; LAS float* LR = LY + 4096; LAS float* LK = LR + 4096; LAS float* LV = LK + 4096;
    const float* mu = P->in[I_MU] + (size_t)l * PW;
    const float lnw = P->in[I_LNW][l * 512 + d], lnb = P->in[I_LNB][l * 512 + d], rk = P->in[I_RK][l * 512 + d];
    float g2c[128];
    { const float* g2 = P->in[I_G2] + (size_t)l * 128 * 512 + d;
#pragma unroll
      for (int c = 0; c < 128; ++c) g2c[c] = g2[c * 512]; }
    for (int u = BID; u < MT / 8; u += NB) {
        const int r0 = u * 8;
#pragma unroll
        for (int i = 0; i < 2; ++i) { const int idx = tid + 512 * i, tok = idx >> 7, col = idx & 127, r = r0 + tok, t = t_in_seq(r);
            const float cur = bf2f(PR[(size_t)r * INW + 2688 + col]);
            const float prev = t > 0 ? bf2f(PR[(size_t)(r - 1) * INW + 2688 + col]) : (r < MTP ? 0.f : P->in[I_SSHIFT][((size_t)l * 128 + ((r - MTP) >> 2)) * PW + 1664 + col]);
            SG[tok * 128 + col] = sigmoidf(cur + (prev - cur) * mu[1664 + col]); }
        { const int tok = tid >> 6, c8 = (tid & 63) * 8; const size_t r = (size_t)r0 + tok; float f[8];
            unpack8(*(const u32x4*)(ymix + r * 1024 + 512 + c8), f); *(LAS f32x4*)(LY + tok * 512 + c8) = (f32x4){f[0], f[1], f[2], f[3]}; *(LAS f32x4*)(LY + tok * 512 + c8 + 4) = (f32x4){f[4], f[5], f[6], f[7]};
            unpack8(*(const u32x4*)(arr + A_R * AS + r * 512 + c8), f); *(LAS f32x4*)(LR + tok * 512 + c8) = (f32x4){f[0], f[1], f[2], f[3]}; *(LAS f32x4*)(LR + tok * 512 + c8 + 4) = (f32x4){f[4], f[5], f[6], f[7]};
            unpack8(*(const u32x4*)(arr + A_KF * AS + r * 512 + c8), f); *(LAS f32x4*)(LK + tok * 512 + c8) = (f32x4){f[0], f[1], f[2], f[3]}; *(LAS f32x4*)(LK + tok * 512 + c8 + 4) = (f32x4){f[4], f[5], f[6], f[7]};
            unpack8(*(const u32x4*)(arr + A_V * AS + r * 512 + c8), f); *(LAS f32x4*)(LV + tok * 512 + c8) = (f32x4){f[0], f[1], f[2], f[3]}; *(LAS f32x4*)(LV + tok * 512 + c8 + 4) = (f32x4){f[4], f[5], f[6], f[7]}; }
        __syncthreads();
#pragma unroll 1
        for (int i = 0; i < 8; ++i) { const size_t r = (size_t)r0 + i; const float y = LY[i * 512 + d], rr = LR[i * 512 + d], kf = LK[i * 512 + d], vv = LV[i * 512 + d];
            float g0 = 0.f, g1 = 0.f, g2_ = 0.f, g3 = 0.f;
#pragma unroll
            for (int q = 0; q < 32; ++q) { const f32x4 sg = *(const LAS f32x4*)(SG + i * 128 + q * 4);
                g0 += sg[0] * g2c[q * 4 + 0]; g1 += sg[1] * g2c[q * 4 + 1]; g2_ += sg[2] * g2c[q * 4 + 2]; g3 += sg[3] * g2c[q * 4 + 3]; }
            const float m = wave_sum(y) * (1.0f / 64.0f), dy = y - m, var = wave_sum(dy * dy) * (1.0f / 64.0f);
            const float yn = dy * rsqrtf(var + 64e-5f) * lnw + lnb;
            const float bs = wave_sum(rr * kf * rk);
            LY[i * 512 + d] = (yn + bs * vv) * ((g0 + g1) + (g2_ + g3)); }
        __syncthreads();
        { const int tok = tid >> 6, c8 = (tid & 63) * 8; const LAS float* lp = LY + tok * 512 + c8; const f32x4 a = *(const LAS f32x4*)lp, b = *(const LAS f32x4*)(lp + 4);
          u32x4 w; w.x = cvt_pk_bf16(a[0], a[1]); w.y = cvt_pk_bf16(a[2], a[3]); w.z = cvt_pk_bf16(b[0], b[1]); w.w = cvt_pk_bf16(b[2], b[3]);
          *(u32x4*)(ymix + ((size_t)r0 + tok) * 1024 + 512 + c8) = w; }
        __syncthreads();
    }
}

#define XB_TMO      128
#define XB_XCNT(j)  (256  + 64 * (j))
#define XB_XSUB(j)  (1280 + 64 * (j))
#define XB_XGEN(j)  (2304 + 64 * (j))
#define XB_TOP      3328
#define XB_TOPGEN   3392
#define XCD_BAR_WORDS 3456
#define XB_SPIN_CAP (1u << 18)
__device__ __forceinline__ unsigned xb_ld(unsigned* p)              { return __hip_atomic_load(p, __ATOMIC_RELAXED, __HIP_MEMORY_SCOPE_AGENT); }
__device__ __forceinline__ unsigned xb_add(unsigned* p, unsigned v) { return __hip_atomic_fetch_add(p, v, __ATOMIC_RELAXED, __HIP_MEMORY_SCOPE_AGENT); }
__device__ __forceinline__ unsigned xb_xcc_id() { return (unsigned)__builtin_amdgcn_s_getreg((3 << 11) | 20) & 0xFu; }
#define XB_SPIN(cond, bar) do { unsigned _sp = 0; while (cond) { __builtin_amdgcn_s_sleep(1); \
    if ((++_sp & 255u) == 0u) { if (xb_ld(&(bar)[XB_TMO])) break; if (_sp > XB_SPIN_CAP) { atomicAdd(&(bar)[XB_TMO], 1u); break; } } } } while (0)
__device__ __forceinline__ void xcd_barrier_complete(unsigned* bar, unsigned x, unsigned G, unsigned& nloc, unsigned& nx) {
    unsigned sum, cnt, mine, sp = 0u;
    for (;;) {
        sum = 0u; cnt = 0u; mine = 0u;
#pragma unroll
        for (unsigned j = 0; j < 16; ++j) { const unsigned c = xb_ld(&bar[XB_XCNT(j)]); sum += c; cnt += (c > 0u) ? 1u : 0u; mine = (j == x) ? c : mine; }
        if (sum == G) break;
        __builtin_amdgcn_s_sleep(1);
        if ((++sp & 255u) == 0u) { if (xb_ld(&bar[XB_TMO])) break; if (sp > XB_SPIN_CAP) { atomicAdd(&bar[XB_TMO], 1u); break; } }
    }
    nloc = mine > 0u ? mine : 1u; nx = cnt > 0u ? cnt : 1u;
}
__device__ __forceinline__ void xcd_barrier(unsigned* bar, volatile LAS unsigned* st, const Ids I) {
    asm volatile("s_waitcnt vmcnt(0)" ::: "memory");
    __syncthreads();
    if (make_tid(I.wv) == 0) {
        const unsigned x = xb_xcc_id();
        __builtin_amdgcn_s_waitcnt(0);
        unsigned nloc = st[0], nx = st[1];
        if (nloc == 0u) { xcd_barrier_complete(bar, x, (unsigned)I.nb, nloc, nx); st[0] = nloc; st[1] = nx; }
        const unsigned old = xb_add(&bar[XB_XSUB(x)], 1u);
        const unsigned gen = old / nloc;
        if (old + 1u == (gen + 1u) * nloc) {
            __builtin_amdgcn_fence(__ATOMIC_RELEASE, "agent");
            asm volatile("s_waitcnt vmcnt(0)" ::: "memory");
            const unsigned og = xb_add(&bar[XB_TOP], 1u);
            const unsigned tg = og / nx;
            if (og + 1u == (tg + 1u) * nx) xb_add(&bar[XB_TOPGEN], 1u);
            else XB_SPIN(xb_ld(&bar[XB_TOPGEN]) == tg, bar);
            __builtin_amdgcn_fence(__ATOMIC_ACQUIRE, "agent");
            xb_add(&bar[XB_XGEN(x)], 1u);
            asm volatile("s_waitcnt vmcnt(0)" ::: "memory");
        } else {
            XB_SPIN(xb_ld(&bar[XB_XGEN(x)]) == gen, bar);
            __builtin_amdgcn_fence(__ATOMIC_ACQUIRE, "agent");
            asm volatile("s_waitcnt vmcnt(0)" ::: "memory");
        }
    }
    __syncthreads();
}

__global__ void __launch_bounds__(512) mega(Params Pval) {
    extern __shared__ __attribute__((aligned(16))) unsigned char lds_raw[];
    LAS unsigned char* lds = (LAS unsigned char*)lds_raw;
    cg::grid_group grid = cg::this_grid();
    const int NSTEP = 2 + 2 * 12 + 1;
    const int wave_s = __builtin_amdgcn_readfirstlane((int)threadIdx.x >> 6);
    {
        volatile LAS unsigned* st0 = (volatile LAS unsigned*)(lds + LDS_MAIN);
        if (threadIdx.x == 0) { st0[0] = 0u; st0[1] = 0u; (void)xb_add(&((unsigned*)Pval.ws)[XB_XCNT(xb_xcc_id())], 1u); }
        __syncthreads();
    }
#pragma unroll 1
    for (int step = 0; step < NSTEP; ++step) {
        Ids I; I.bid = (int)blockIdx.x; I.nb = (int)gridDim.x; int wv = wave_s;
        unsigned long long pv = (unsigned long long)__builtin_amdgcn_kernarg_segment_ptr();
        asm volatile("" : "+s"(wv), "+s"(I.bid), "+s"(I.nb), "+s"(pv));
        I.bid = __builtin_amdgcn_readfirstlane(I.bid); I.nb = __builtin_amdgcn_readfirstlane(I.nb);
        I.wv = __builtin_amdgcn_readfirstlane(wv);
        PP P = (PP)(((unsigned long long)(unsigned)__builtin_amdgcn_readfirstlane((int)(pv >> 32)) << 32) | (unsigned long long)(unsigned)__builtin_amdgcn_readfirstlane((int)pv));
        unsigned char* ws = P->ws;
        const bool mid = (step >= 2 && step < NSTEP - 1);
        const int l = mid ? (step - 2) / 12 : 0, sub = mid ? (step - 2) % 12 : -1;
        int nrep = 1;
#if PROBE == 1
        if (step == 1 || sub == 1 || sub == 4 || sub == 10) nrep = 2;
#elif PROBE == 2
        if (sub == 6) nrep = 2;
#elif PROBE == 3
        if (step == 0 || sub == 0 || sub == 3 || sub == 9 || sub == 5) nrep = 2;
#elif PROBE == 4
        if (step == 0) nrep = 2;
#elif PROBE == 5
        if (sub == 5) nrep = 2;
#elif PROBE == 6
        if (sub == 3 || sub == 9) nrep = 2;
#elif PROBE == 7
        if (step == 1) { for (int e = 0; e < 20; ++e) xcd_barrier((unsigned*)ws, (volatile LAS unsigned*)(lds + LDS_MAIN), I); }
#endif
#pragma unroll 1
        for (int rep = 0; rep < nrep; ++rep) {
        if (step == 0) phase_prologue(P, lds, I);
        else if (step == 1) {
            if (I.nb > 144) { if (I.bid < 72) { EpiAda E{(float*)(ws + WS_MOD), P->in[I_BADA]}; run_gemm(lds, (const bf16_t*)(ws + WS_AADA), (const bf16_t*)(ws + WS_R2), 256, 2 * 9216, 1024, E, I); }
                              else { Ids J = I; J.bid = I.bid - 72; J.nb = I.nb - 72; convert_layer(P, 0, lds, J); } }
            else { EpiAda E{(float*)(ws + WS_MOD), P->in[I_BADA]}; run_gemm(lds, (const bf16_t*)(ws + WS_AADA), (const bf16_t*)(ws + WS_R2), 256, 2 * 9216, 1024, E, I); convert_layer(P, 0, lds, I); } }
        else if (step == NSTEP - 1) phase_norm(P, 0, 3, FF / 256, (const float*)(ws + WS_MOD) + (size_t)1 * NMR * 9216 + 8 * 1024, 0.5f, I);
        else {
            const float* modl = (const float*)(ws + WS_MOD) + (size_t)l * NMR * 9216;
            if (sub == 0 || sub == 3 || sub == 9) {
                if (sub == 0 && l == 1) convert_layer(P, 1, lds, I);
                const int nsl = (sub == 0) ? (l == 1 ? FF / 256 : 0) : (sub == 3 ? FF / 256 : 1024 / 256);
                const float* fg = (sub == 0) ? (const float*)(ws + WS_MOD) + 8 * 1024 : modl + (sub == 3 ? 2 : 5) * 1024;
                phase_norm(P, l, sub == 0 ? 0 : (sub == 3 ? 1 : 2), nsl, fg, sub == 9 ? 1.0f : 0.5f, I);
            } else if (sub == 1 || sub == 10) {
                EpiSwiGLU E{(bf16_t*)(ws + WS_R1)}; run_gemm(lds, (const bf16_t*)(ws + WS_HB), (const bf16_t*)(ws + (sub == 1 ? WS_WGU1 : WS_WGU2)), MT, 2 * FF, 1024, E, I);
            } else if (sub == 2 || sub == 8 || sub == 11) {
                const int gk = sub == 2 ? 2 : (sub == 8 ? 5 : 8);
                const float scl = sub == 8 ? 1.0f : 0.5f; const int Kd = sub == 8 ? 1024 : FF;
                EpiResid E{P->out, modl + gk * 1024, scl};
                const bf16_t* A = (const bf16_t*)(ws + (sub == 8 ? WS_HB : WS_R1)); const bf16_t* Bt = (const bf16_t*)(ws + (sub == 2 ? WS_WD1 : (sub == 8 ? WS_WOUT : WS_WD2)));
                run_gemm(lds, A, Bt, MTP, 1024, Kd, E, I);
                EpiPartial EA{(float*)(ws + WS_R2)};
                run_gemm_splitk(lds, A + (size_t)MTP * Kd, Bt, MTS, 1024, Kd, 256, EA, I);
            } else if (sub == 4) {
                EpiProj E{(bf16_t*)(ws + WS_R1)}; run_gemm(lds, (const bf16_t*)(ws + WS_HB), (const bf16_t*)(ws + WS_WIN), MT, INW, 1024, E, I);
            } else if (sub == 5) phase_m1(P, l, lds, I);
            else if (sub == 6) phase_scan(P, l, lds, I);
            else phase_m2(P, l, lds, I);
        }
        if (step == 0) grid.sync();
        else if (step != NSTEP - 1) xcd_barrier((unsigned*)ws, (volatile LAS unsigned*)(lds + LDS_MAIN), I);
        }
    }
}

extern "C" void kernel_launch(void* const* d_in, const int* in_sizes, int n_in, void* d_out, int out_size, void* d_ws, size_t ws_size, hipStream_t stream) {
    static int grid_blocks = 0;
    if (!grid_blocks) {
        if (n_in != 40 || ws_size < WS_END) { fprintf(stderr, "kernel_launch: need 40 inputs and %zu bytes of workspace; got %d, %zu\n", (size_t)WS_END, n_in, ws_size); grid_blocks = -1; return; }
        int dev = 0, cus = 0, per_cu = 0;
        hipGetDevice(&dev);
        hipDeviceGetAttribute(&cus, hipDeviceAttributeMultiprocessorCount, dev);
        hipFuncSetAttribute((const void*)mega, hipFuncAttributeMaxDynamicSharedMemorySize, LDS_BYTES);
        hipOccupancyMaxActiveBlocksPerMultiprocessor(&per_cu, (const void*)mega, 512, LDS_BYTES);
        if (per_cu < 1) { fprintf(stderr, "kernel_launch: occupancy query says %d blocks per CU\n", per_cu); grid_blocks = -1; return; }
        grid_blocks = cus;
    }
    if (grid_blocks < 0) return;
    Params p{};
    for (int i = 0; i < 40; ++i) p.in[i] = (const float*)d_in[i];
    p.out = (float*)d_out; p.ws = (unsigned char*)d_ws;
    if (hipMemsetAsync(d_ws, 0, 16384, stream) != hipSuccess) { fprintf(stderr, "kernel_launch: memset of the barrier words failed\n"); return; }
    void* args[] = {&p};
    hipError_t e = hipLaunchCooperativeKernel((const void*)mega, dim3(grid_blocks), dim3(512), args, LDS_BYTES, stream);
    if (e != hipSuccess) fprintf(stderr, "cooperative launch failed: %s (grid %d)\n", hipGetErrorString(e), grid_blocks);
}
```

```cpp
#include <hip/hip_runtime.h>
#include <hip/hip_cooperative_groups.h>
#include <cstdio>
namespace cg = cooperative_groups;

#define LAS __attribute__((address_space(3)))
typedef unsigned short bf16_t;
typedef short bf16x8 __attribute__((ext_vector_type(8)));
typedef float f32x4 __attribute__((ext_vector_type(4)));
typedef float f32x2 __attribute__((ext_vector_type(2)));
typedef unsigned u32x4 __attribute__((ext_vector_type(4)));
typedef unsigned u32x2 __attribute__((ext_vector_type(2)));

constexpr int D = 1024, MTP = 16384, MTS = 512, MT = 16896, FF = 2816, INW = 2816, PW = 1792, NMR = 136;
#ifndef PROBE
#define PROBE 0
#endif
constexpr int LDS_MAIN = 155648, LDS_BYTES = LDS_MAIN + 16;
constexpr size_t SZ_WGU = (size_t)5632 * 1024 * 2, SZ_WD = (size_t)1024 * 2816 * 2, SZ_WIN = (size_t)2816 * 1024 * 2, SZ_WOUT = (size_t)1024 * 1024 * 2;
constexpr size_t WS_WGU1 = 16384, WS_WD1 = WS_WGU1 + SZ_WGU, WS_WIN = WS_WD1 + SZ_WD, WS_WOUT = WS_WIN + SZ_WIN, WS_WGU2 = WS_WOUT + SZ_WOUT, WS_WD2 = WS_WGU2 + SZ_WGU;
constexpr size_t WS_MOD = WS_WD2 + SZ_WD, SZ_MOD = (size_t)2 * NMR * 9216 * 4;
constexpr size_t WS_AADA = WS_MOD + SZ_MOD, SZ_AADA = (size_t)256 * 1024 * 2;
constexpr size_t WS_HB = WS_AADA + SZ_AADA, SZ_HB = (size_t)MT * 1024 * 2;
constexpr size_t WS_R1 = WS_HB + SZ_HB, SZ_R1 = (size_t)MT * 2816 * 2;
constexpr size_t WS_R2 = WS_R1 + SZ_R1, SZ_ARR = (size_t)MT * 512 * 2;
constexpr size_t WS_END = WS_R2 + 8 * SZ_ARR;
enum { A_LA = 0, A_GX, A_R, A_EW, A_KF, A_V, A_KK, A_BB };
constexpr size_t O_PCONV = (size_t)MT * 1024, O_PH = O_PCONV + 24576, O_PSHIFT = O_PH + 8192, O_PWKV = O_PSHIFT + 28672, O_SCONV = O_PWKV + 524288,
                 O_SH = O_SCONV + 393216, O_SSHIFT = O_SH + 131072, O_SWKV = O_SSHIFT + 458752;
enum { I_XP = 0, I_XS, I_CP, I_CS, I_SCONV, I_SH, I_SSHIFT, I_SWKV, I_WADA, I_BADA, I_F1N, I_F1G, I_F1U, I_F1D, I_MIXN, I_WIN, I_WOUT, I_CONVW, I_CONVB, I_LWX, I_LBX,
       I_LWA, I_LBA, I_LAM, I_MU, I_W0, I_W2, I_A0, I_A2, I_G2, I_KK, I_KA, I_RK, I_LNW, I_LNB, I_F2N, I_F2G, I_F2U, I_F2D, I_FN };

struct Params { const float* in[40]; float* out; unsigned char* ws; };
typedef const __attribute__((address_space(4))) Params* PP;
struct Ids { int wv, bid, nb; };
__device__ __forceinline__ int make_tid(int wv) { int lane_v; asm volatile("v_mbcnt_lo_u32_b32 %0, -1, 0\n\tv_mbcnt_hi_u32_b32 %0, -1, %0" : "=v"(lane_v)); return wv * 64 + lane_v; }
#define TID tid_local
#define BID (I.bid)
#define NB (I.nb)

__device__ __forceinline__ float bf2f(bf16_t h) { return __uint_as_float((unsigned)h << 16); }
__device__ __forceinline__ unsigned cvt_pk_bf16(float lo, float hi) { unsigned r; asm("v_cvt_pk_bf16_f32 %0, %1, %2" : "=v"(r) : "v"(lo), "v"(hi)); return r; }
__device__ __forceinline__ bf16_t f2bf(float f) { return (bf16_t)(cvt_pk_bf16(f, 0.f) & 0xffffu); }
__device__ __forceinline__ float rcpf(float x) { return __builtin_amdgcn_rcpf(x); }
__device__ __forceinline__ float sigmoidf(float x) { return rcpf(1.0f + __expf(-x)); }
__device__ __forceinline__ float tanh_f(float x) { return 1.0f - 2.0f * rcpf(1.0f + __expf(2.0f * x)); }
__device__ __forceinline__ float gelu_tanh(float x) { const float u = 0.7978845608f * (x + 0.044715f * x * x * x); return 0.5f * x * (1.0f + tanh_f(u)); }
__device__ __forceinline__ float softplusf(float x) { return fmaxf(x, 0.f) + log1pf(__expf(-fabsf(x))); }
template <int CTRL> __device__ __forceinline__ float dpp_mov(float x) {
    return __builtin_bit_cast(float, __builtin_amdgcn_update_dpp(0, __builtin_bit_cast(int, x), CTRL, 0xF, 0xF, true));
}
__device__ __forceinline__ float row16_allsum(float x) {
    x += dpp_mov<0xB1>(x); x += dpp_mov<0x4E>(x); x += dpp_mov<0x141>(x); x += dpp_mov<0x140>(x); return x;
}
__device__ __forceinline__ float wave_sum(float x) {
    x = row16_allsum(x);
    const float a = __builtin_bit_cast(float, __builtin_amdgcn_readlane(__builtin_bit_cast(int, x), 0)), b = __builtin_bit_cast(float, __builtin_amdgcn_readlane(__builtin_bit_cast(int, x), 16)),
                c = __builtin_bit_cast(float, __builtin_amdgcn_readlane(__builtin_bit_cast(int, x), 32)), d = __builtin_bit_cast(float, __builtin_amdgcn_readlane(__builtin_bit_cast(int, x), 48));
    return (a + b) + (c + d);
}
__device__ __forceinline__ void unpack8(const u32x4 w, float (&f)[8]) {
#pragma unroll
    for (int i = 0; i < 4; ++i) { f[2 * i] = __uint_as_float(w[i] << 16); f[2 * i + 1] = __uint_as_float(w[i] & 0xffff0000u); }
}
__device__ __forceinline__ int mod_row(int r) { return r < MTP ? (r >> 11) : 8 + ((r - MTP) >> 2); }
__device__ __forceinline__ int t_in_seq(int r) { return r < MTP ? (r & 2047) : ((r - MTP) & 3); }

namespace pg8 {
constexpr int BM = 256, BK = 64, HALF = 128, HTB = HALF * BK * 2, STAGE_BYTES = 8 * HTB, NXCD = 8, WGM = 8;
__device__ __forceinline__ int lds_byte(int r, int c) { const int st = (r >> 4) * 2 + (c >> 5), rr = r & 15, cc = c & 31, ob = rr * 64 + cc * 2; return st * 1024 + (ob ^ (((ob >> 9) & 1) << 5)); }
__device__ __forceinline__ void stage_rc(int b, int& R, int& C) { const int st = b / 1024, sb = b % 1024, swz = sb ^ (((sb >> 9) & 1) << 5); R = (st >> 1) * 16 + swz / 64; C = (st & 1) * 32 + (swz % 64) / 2; }
struct Unit { int pm, pn, kb; };
struct Gemm { const bf16_t* A; const bf16_t* Bt; int M, N, K, ld; };
struct StaticOrder {
    int nM, nN, nwg, G, c;
    __device__ void init(int M, int N, int G_, int c_) { nM = M / BM; nN = N / BM; nwg = nM * nN; G = G_; c = c_; }
    __device__ bool next(int i, Unit& u) const {
        const long L = (long)i * G + c; if (L >= nwg) return false;
        int wgid = (int)L; { const int q = nwg / NXCD, r = nwg % NXCD, xcd = wgid % NXCD, off = wgid / NXCD; wgid = (xcd < r ? xcd * (q + 1) : r * (q + 1) + (xcd - r) * q) + off; }
        const int nig = WGM * nN, gid = wgid / nig, fm = gid * WGM, gsz = (nM - fm) < WGM ? (nM - fm) : WGM;
        u.pm = fm + ((wgid % nig) % gsz); u.pn = (wgid % nig) / gsz; u.kb = 0; return true;
    }
};
struct SplitOrder {
    int nM, nN, nS, G, c, ksb;
    __device__ void init(int M, int N, int nS_, int kslice, int G_, int c_) { nM = M / BM; nN = N / BM; nS = nS_; G = G_; c = c_; ksb = kslice * 2; }
    __device__ bool next(int i, Unit& u) const {
        const int L = i * G + c; if (L >= nM * nN * nS) return false;
        const int sl = L / (nM * nN), rem = L - sl * (nM * nN); u.pm = rem / nN; u.pn = rem - u.pm * nN; u.kb = sl * ksb; return true;
    }
};
template <class Epi, class Sched>
__device__ __forceinline__ void gemm_phase(LAS unsigned char* lds, const Gemm g, const Sched& S, const Epi& E, const Ids I) {
    const int tid_local = make_tid(I.wv);
    const int tid = TID, wid = __builtin_amdgcn_readfirstlane(tid >> 6), lane = tid & 63, wr = wid >> 2, wc = wid & 3, fr = lane & 15, fq = lane >> 4;
    const int K = g.ld, nt = g.K / BK;
    unsigned voffA[2], voffB[2];
#pragma unroll
    for (int i = 0; i < 2; ++i) { int R, C; stage_rc(tid * 16 + i * 8192, R, C); voffA[i] = (unsigned)(R * K + C) * 2u; voffB[i] = (unsigned)(R * K + C) * 2u; }
    const size_t kstep = (size_t)(BK * 2);
    const size_t hstep = (size_t)HALF * K * 2;
    const size_t tstep = 2 * hstep;
    const unsigned ldsw = (unsigned)wid * 1024u;
    const int aoff = lds_byte(wr * 64 + fr, fq * 8), boff = lds_byte(wc * 32 + fr, fq * 8);
#define PG8_SA(b, h) (((b) * 2 + (h)) * HTB)
#define PG8_SB(b, h) ((4 + (b) * 2 + (h)) * HTB)
#define PG8_STAGE(bufoff, gbase, voff) do { _Pragma("unroll") for (int _i = 0; _i < 2; ++_i) \
        __builtin_amdgcn_global_load_lds((const unsigned*)((const char*)(gbase) + (voff)[_i]), (LAS unsigned*)(lds + (bufoff) + ldsw + _i * 8192), 16, 0, 0); } while (0)
#define PG8_LDA(dst, b, h) do { _Pragma("unroll") for (int m = 0; m < 4; ++m) _Pragma("unroll") for (int k = 0; k < 2; ++k) dst[m][k] = *(const LAS bf16x8*)(lds + PG8_SA(b, h) + aoff + m * 2048 + k * 1024); } while (0)
#define PG8_LDB(dst, b, h) do { _Pragma("unroll") for (int n = 0; n < 2; ++n) _Pragma("unroll") for (int k = 0; k < 2; ++k) dst[n][k] = *(const LAS bf16x8*)(lds + PG8_SB(b, h) + boff + n * 2048 + k * 1024); } while (0)
#define PG8_MMA(ai, bj, At, Bt) do { __builtin_amdgcn_s_setprio(1); _Pragma("unroll") for (int m = 0; m < 4; ++m) _Pragma("unroll") for (int n = 0; n < 2; ++n) _Pragma("unroll") for (int k = 0; k < 2; ++k) \
        acc[ai][bj][m][n] = __builtin_amdgcn_mfma_f32_16x16x32_bf16(Bt[n][k], At[m][k], acc[ai][bj][m][n], 0, 0, 0); __builtin_amdgcn_s_setprio(0); } while (0)
#define PG8_WAIT_V(n) asm volatile("s_waitcnt vmcnt(" #n ")" ::: "memory")
#define PG8_WAIT_L(n) asm volatile("s_waitcnt lgkmcnt(" #n ")" ::: "memory")
#define PG8_BAR __builtin_amdgcn_s_barrier()
#define PG8_SCHED __builtin_amdgcn_sched_barrier(0)
    Unit cur, nxt; int ui = 0;
    if (!S.next(0, cur)) return;
    f32x4 acc[2][2][4][2];
#pragma unroll
    for (int a = 0; a < 2; ++a)
#pragma unroll
        for (int b = 0; b < 2; ++b)
#pragma unroll
            for (int m = 0; m < 4; ++m)
#pragma unroll
                for (int n = 0; n < 2; ++n) acc[a][b][m][n] = (f32x4){0.f, 0.f, 0.f, 0.f};
    bf16x8 At[4][2], B0[2][2], B1[2][2];
    const char* cA = (const char*)g.A + (size_t)cur.pm * tstep + cur.kb; const char* cB = (const char*)g.Bt + (size_t)cur.pn * tstep + cur.kb;
    PG8_STAGE(PG8_SB(0, 0), cB, voffB); PG8_STAGE(PG8_SA(0, 0), cA, voffA); PG8_STAGE(PG8_SB(0, 1), cB + hstep, voffB); PG8_STAGE(PG8_SA(0, 1), cA + hstep, voffA);
    if (wr == 1) PG8_BAR;
    PG8_WAIT_V(4); PG8_BAR;
    PG8_STAGE(PG8_SB(1, 0), cB + kstep, voffB); PG8_STAGE(PG8_SA(1, 0), cA + kstep, voffA); PG8_STAGE(PG8_SB(1, 1), cB + hstep + kstep, voffB);
    PG8_WAIT_V(6); PG8_BAR;
    for (;;) {
        const bool has_next = S.next(ui + 1, nxt);
        const char* nA = has_next ? (const char*)g.A + (size_t)nxt.pm * tstep + nxt.kb : cA; const char* nB = has_next ? (const char*)g.Bt + (size_t)nxt.pn * tstep + nxt.kb : cB;
        for (int t = 0; t < nt; t += 2) {
            const bool last = (t == nt - 2);
            const char* a1 = cA + (size_t)(t + 1) * kstep;
            const char* a2 = last ? nA : cA + (size_t)(t + 2) * kstep; const char* b2 = last ? nB : cB + (size_t)(t + 2) * kstep;
            const char* a3 = a2 + kstep; const char* b3 = b2 + kstep;
            PG8_LDB(B0, 0, 0); PG8_SCHED; PG8_LDA(At, 0, 0); PG8_STAGE(PG8_SA(1, 1), a1 + hstep, voffA);
            PG8_WAIT_L(8); PG8_BAR; PG8_WAIT_L(0); PG8_MMA(0, 0, At, B0); PG8_BAR; PG8_SCHED;
            PG8_LDB(B1, 0, 1); PG8_STAGE(PG8_SB(0, 0), b2, voffB);
            PG8_BAR; PG8_WAIT_L(0); PG8_MMA(0, 1, At, B1); PG8_BAR;
            PG8_LDA(At, 0, 1); PG8_STAGE(PG8_SA(0, 0), a2, voffA);
            PG8_BAR; PG8_WAIT_L(0); PG8_MMA(1, 0, At, B0); PG8_BAR; PG8_SCHED;
            PG8_STAGE(PG8_SB(0, 1), b2 + hstep, voffB);
            PG8_WAIT_V(6); PG8_BAR; PG8_MMA(1, 1, At, B1); PG8_BAR;
            PG8_LDB(B0, 1, 0); PG8_SCHED; PG8_LDA(At, 1, 0); PG8_STAGE(PG8_SA(0, 1), a2 + hstep, voffA);
            PG8_WAIT_L(8); PG8_BAR; PG8_WAIT_L(0); PG8_MMA(0, 0, At, B0); PG8_BAR; PG8_SCHED;
            PG8_LDB(B1, 1, 1); PG8_STAGE(PG8_SB(1, 0), b3, voffB);
            PG8_BAR; PG8_WAIT_L(0); PG8_MMA(0, 1, At, B1); PG8_BAR;
            PG8_LDA(At, 1, 1); PG8_STAGE(PG8_SA(1, 0), a3, voffA);
            PG8_BAR; PG8_WAIT_L(0); PG8_MMA(1, 0, At, B0); PG8_BAR; PG8_SCHED;
            PG8_STAGE(PG8_SB(1, 1), b3 + hstep, voffB);
            PG8_WAIT_V(6); PG8_BAR; PG8_MMA(1, 1, At, B1); PG8_BAR;
        }
        E(acc, cur, wr, wc, fr, fq);
        if (!has_next) break;
#pragma unroll
        for (int a = 0; a < 2; ++a)
#pragma unroll
            for (int b = 0; b < 2; ++b)
#pragma unroll
                for (int m = 0; m < 4; ++m)
#pragma unroll
                    for (int n = 0; n < 2; ++n) acc[a][b][m][n] = (f32x4){0.f, 0.f, 0.f, 0.f};
        cur = nxt; cA = nA; cB = nB; ++ui;
    }
    PG8_WAIT_V(0);
    if (wr == 0) PG8_BAR;
    PG8_BAR;
#undef PG8_SA
#undef PG8_SB
#undef PG8_STAGE
#undef PG8_LDA
#undef PG8_LDB
#undef PG8_MMA
#undef PG8_WAIT_V
#undef PG8_WAIT_L
#undef PG8_BAR
#undef PG8_SCHED
}
}

struct EpiSwiGLU {
    bf16_t* act;
    __device__ __forceinline__ void operator()(const f32x4 (&acc)[2][2][4][2], const pg8::Unit& u, int wr, int wc, int fr, int fq) const {
        const int row0 = u.pm * 256 + wr * 64 + fr, col0 = u.pn * 128 + wc * 32 + 8 * fq;
#pragma unroll
        for (int ai = 0; ai < 2; ++ai)
#pragma unroll
            for (int m = 0; m < 4; ++m) { bf16_t* rowp = act + (size_t)(row0 + ai * 128 + m * 16) * FF + col0; float o[8];
#pragma unroll
                for (int n = 0; n < 2; ++n) { const f32x4 gv = acc[ai][0][m][n], uv = acc[ai][1][m][n];
#pragma unroll
                    for (int j = 0; j < 4; ++j) o[4 * n + j] = gv[j] * sigmoidf(gv[j]) * uv[j]; }
                u32x4 w; w.x = cvt_pk_bf16(o[0], o[1]); w.y = cvt_pk_bf16(o[2], o[3]); w.z = cvt_pk_bf16(o[4], o[5]); w.w = cvt_pk_bf16(o[6], o[7]); *(u32x4*)rowp = w; }
    }
};
struct EpiResid {
    float* x; const float* gate; float scale;
    __device__ __forceinline__ void operator()(const f32x4 (&acc)[2][2][4][2], const pg8::Unit& u, int wr, int wc, int fr, int fq) const {
        const int row0 = u.pm * 256 + wr * 64 + fr, col0 = u.pn * 256 + wc * 32 + 4 * fq; const float* gp = gate + (size_t)((u.pm * 256) >> 11) * 9216 + col0;
        f32x4 gv[2][2];
#pragma unroll
        for (int bj = 0; bj < 2; ++bj)
#pragma unroll
            for (int n = 0; n < 2; ++n) gv[bj][n] = *(const f32x4*)(gp + bj * 128 + n * 16) * scale;
#pragma unroll
        for (int ai = 0; ai < 2; ++ai)
#pragma unroll
            for (int m = 0; m < 4; ++m) { const int row = row0 + ai * 128 + m * 16; float* rowp = x + (size_t)row * D + col0;
#pragma unroll
                for (int bj = 0; bj < 2; ++bj)
#pragma unroll
                    for (int n = 0; n < 2; ++n) { const f32x4 xv = *(const f32x4*)(rowp + bj * 128 + n * 16);
                        *(f32x4*)(rowp + bj * 128 + n * 16) = xv + gv[bj][n] * acc[ai][bj][m][n]; }
                asm volatile("" ::: "memory"); }
    }
};
struct EpiPartial {
    float* part;
    __device__ __forceinline__ void operator()(const f32x4 (&acc)[2][2][4][2], const pg8::Unit& u, int wr, int wc, int fr, int fq) const {
        const int row0 = u.pm * 256 + wr * 64 + fr, col0 = u.pn * 256 + wc * 32 + 4 * fq; float* base = part + (size_t)(u.kb >> 9) * MTS * D;
#pragma unroll
        for (int ai = 0; ai < 2; ++ai)
#pragma unroll
            for (int m = 0; m < 4; ++m) { float* rowp = base + (size_t)(row0 + ai * 128 + m * 16) * D + col0;
#pragma unroll
                for (int bj = 0; bj < 2; ++bj)
#pragma unroll
                    for (int n = 0; n < 2; ++n) *(f32x4*)(rowp + bj * 128 + n * 16) = acc[ai][bj][m][n]; }
    }
};
struct EpiProj {
    bf16_t* o;
    __device__ __forceinline__ void operator()(const f32x4 (&acc)[2][2][4][2], const pg8::Unit& u, int wr, int wc, int fr, int fq) const {
        const int row0 = u.pm * 256 + wr * 64 + fr, col0 = u.pn * 256 + wc * 32 + 8 * fq;
#pragma unroll
        for (int ai = 0; ai < 2; ++ai)
#pragma unroll
            for (int m = 0; m < 4; ++m) { bf16_t* rowp = o + (size_t)(row0 + ai * 128 + m * 16) * INW + col0;
#pragma unroll
                for (int bj = 0; bj < 2; ++bj) { const f32x4 v0 = acc[ai][bj][m][0], v1 = acc[ai][bj][m][1];
                    u32x4 w; w.x = cvt_pk_bf16(v0[0], v0[1]); w.y = cvt_pk_bf16(v0[2], v0[3]); w.z = cvt_pk_bf16(v1[0], v1[1]); w.w = cvt_pk_bf16(v1[2], v1[3]); *(u32x4*)(rowp + bj * 128) = w; } }
    }
};
struct EpiAda {
    float* mod; const float* bias;
    __device__ __forceinline__ void operator()(const f32x4 (&acc)[2][2][4][2], const pg8::Unit& u, int wr, int wc, int fr, int fq) const {
        const int row0 = wr * 64 + fr, colg0 = u.pn * 256 + wc * 32 + 4 * fq; const int l = (u.pn >= 36) ? 1 : 0; const int col0 = colg0 - l * 9216;
#pragma unroll
        for (int ai = 0; ai < 2; ++ai)
#pragma unroll
            for (int m = 0; m < 4; ++m) { const int row = row0 + ai * 128 + m * 16;
                if (row < NMR) { float* rowp = mod + ((size_t)l * NMR + row) * 9216 + col0;
#pragma unroll
                    for (int bj = 0; bj < 2; ++bj)
#pragma unroll
                        for (int n = 0; n < 2; ++n) { const f32x4 bv = *(const f32x4*)(bias + colg0 + bj * 128 + n * 16); *(f32x4*)(rowp + bj * 128 + n * 16) = acc[ai][bj][m][n] + bv; } } }
    }
};
template <class Epi> __device__ __forceinline__ void run_gemm(LAS unsigned char* lds, const bf16_t* A, const bf16_t* Bt, int M, int N, int K, const Epi& E, const Ids I) {
    pg8::Gemm g{A, Bt, M, N, K, K}; pg8::StaticOrder S; S.init(M, N, (int)NB, (int)BID); pg8::gemm_phase<Epi, pg8::StaticOrder>(lds, g, S, E, I);
}
template <class Epi> __device__ __forceinline__ void run_gemm_splitk(LAS unsigned char* lds, const bf16_t* A, const bf16_t* Bt, int M, int N, int K, int kslice, const Epi& E, const Ids I) {
    pg8::Gemm g{A, Bt, M, N, kslice, K}; pg8::SplitOrder S; S.init(M, N, K / kslice, kslice, (int)NB, (int)BID); pg8::gemm_phase<Epi, pg8::SplitOrder>(lds, g, S, E, I);
}

__device__ __forceinline__ void conv_tile4(const float* __restrict__ src, int K, int N, bf16_t* __restrict__ dst, int mode, int u4, LAS float* T, const Ids I) {
    const int tid_local = make_tid(I.wv);
    const int tid = TID; const int tilesN = N >> 6;
    f32x4 v[4][2];
#pragma unroll
    for (int q = 0; q < 4; ++q) { const int u = u4 * 4 + q, tk = u / tilesN, tn = u - tk * tilesN;
#pragma unroll
        for (int i = 0; i < 2; ++i) { const int kk = (tid >> 4) + 32 * i, n4 = (tid & 15) * 4; v[q][i] = *(const f32x4*)(src + (size_t)(tk * 64 + kk) * N + tn * 64 + n4); } }
#pragma unroll
    for (int q = 0; q < 4; ++q)
#pragma unroll
        for (int i = 0; i < 2; ++i) { const int kk = (tid >> 4) + 32 * i, n4 = (tid & 15) * 4; LAS float* Tq = T + q * (64 * 65);
            Tq[(n4 + 0) * 65 + kk] = v[q][i][0]; Tq[(n4 + 1) * 65 + kk] = v[q][i][1]; Tq[(n4 + 2) * 65 + kk] = v[q][i][2]; Tq[(n4 + 3) * 65 + kk] = v[q][i][3]; }
    __syncthreads();
#pragma unroll
    for (int q = 0; q < 4; ++q) { const int u = u4 * 4 + q, tk = u / tilesN, tn = u - tk * tilesN;
        const int n = tid >> 3, k8 = (tid & 7) * 8; const int ng = tn * 64 + n; const int m3 = mode & 3; int dr = (m3 == 0) ? ng : (((ng >> 7) << 8) + (m3 == 2 ? 128 : 0) + (ng & 127));
        if (mode & 4) { const int c = dr & 31; dr = (dr & ~31) + 16 * ((c >> 2) & 1) + 4 * (c >> 3) + (c & 3); }
        const LAS float* tp = T + q * (64 * 65) + n * 65 + k8;
        u32x4 w; w.x = cvt_pk_bf16(tp[0], tp[1]); w.y = cvt_pk_bf16(tp[2], tp[3]); w.z = cvt_pk_bf16(tp[4], tp[5]); w.w = cvt_pk_bf16(tp[6], tp[7]);
        *(u32x4*)(dst + (size_t)dr * K + tk * 64 + k8) = w; }
    __syncthreads();
}
__device__ __forceinline__ void convert_layer(PP P, int l, LAS unsigned char* lds, const Ids I) {
    LAS float* T = (LAS float*)lds; unsigned char* ws = P->ws;
    const size_t wl = (size_t)l * 1024 * 2816;
    for (int u = BID; u < 7 * 176 + 64; u += NB) {
        const int mi = u / 176, uu = u - mi * 176;
        if (mi == 0)      conv_tile4(P->in[I_F1G] + wl, 1024, 2816, (bf16_t*)(ws + WS_WGU1), 5, uu, T, I);
        else if (mi == 1) conv_tile4(P->in[I_F1U] + wl, 1024, 2816, (bf16_t*)(ws + WS_WGU1), 6, uu, T, I);
        else if (mi == 2) conv_tile4(P->in[I_F1D] + wl, 2816, 1024, (bf16_t*)(ws + WS_WD1), 0, uu, T, I);
        else if (mi == 3) conv_tile4(P->in[I_WIN] + wl, 1024, 2816, (bf16_t*)(ws + WS_WIN), 4, uu, T, I);
        else if (mi == 4) conv_tile4(P->in[I_F2G] + wl, 1024, 2816, (bf16_t*)(ws + WS_WGU2), 5, uu, T, I);
        else if (mi == 5) conv_tile4(P->in[I_F2U] + wl, 1024, 2816, (bf16_t*)(ws + WS_WGU2), 6, uu, T, I);
        else if (mi == 6) conv_tile4(P->in[I_F2D] + wl, 2816, 1024, (bf16_t*)(ws + WS_WD2), 0, uu, T, I);
        else              conv_tile4(P->in[I_WOUT] + (size_t)l * 1024 * 1024, 1024, 1024, (bf16_t*)(ws + WS_WOUT), 0, uu, T, I);
    }
}
__device__ __forceinline__ void phase_prologue(PP P, LAS unsigned char* lds, const Ids I) {
    const int tid_local = make_tid(I.wv);
    LAS float* T = (LAS float*)lds;
    for (int u = BID; u < 2 * 576; u += NB) {
        const int l = u / 576, uu = u - l * 576;
        conv_tile4(P->in[I_WADA] + (size_t)l * 1024 * 9216, 1024, 9216, (bf16_t*)(P->ws + WS_R2) + (size_t)l * 9216 * 1024, 0, uu, T, I);
    }
    bf16_t* aada = (bf16_t*)(P->ws + WS_AADA);
    for (int idx = BID * 512 + TID; idx < 256 * 1024; idx += NB * 512) {
        const int row = idx >> 10, col = idx & 1023; float v = 0.f;
        if (row < 8) v = P->in[I_CP][row * 1024 + col]; else if (row < NMR) v = P->in[I_CS][(row - 8) * 1024 + col];
        aada[idx] = f2bf(v * sigmoidf(v));
    }
}

__device__ __forceinline__ void phase_norm(PP P, int l, int which, int nsl, const float* fgate, float fscale, const Ids I) {
    const int tid_local = make_tid(I.wv);
    const int lane = TID & 63, gw = BID * 8 + __builtin_amdgcn_readfirstlane(TID >> 6), nw = NB * 8;
    float* xb = P->out; bf16_t* hb = (bf16_t*)(P->ws + WS_HB);
    const float* gamma = which == 0 ? P->in[I_F1N] + l * 1024 : which == 1 ? P->in[I_MIXN] + l * 1024 : which == 2 ? P->in[I_F2N] + l * 1024 : P->in[I_FN];
    const float* modl = (const float*)(P->ws + WS_MOD) + (size_t)l * NMR * 9216;
    const bool from_in = (which == 0 && l == 0);
    for (int row0 = gw; row0 < MT; row0 += 2 * nw) {
        const int rows[2] = {row0, (row0 + nw < MT) ? row0 + nw : row0};
        f32x4 v[2][4]; float ss[2];
#pragma unroll
        for (int j = 0; j < 2; ++j) { const int row = rows[j];
            const float* xr = from_in ? (row < MTP ? P->in[I_XP] + (size_t)row * D : P->in[I_XS] + (size_t)(row - MTP) * D) : xb + (size_t)row * D;
#pragma unroll
            for (int i = 0; i < 4; ++i) v[j][i] = *(const f32x4*)(xr + lane * 4 + 256 * i);
            if (nsl > 0 && row >= MTP && !(j == 1 && row == row0)) {
                const float* pp = (const float*)(P->ws + WS_R2) + (size_t)(row - MTP) * D + lane * 4; const float* gp = fgate + (size_t)mod_row(row) * 9216 + lane * 4;
#pragma unroll
                for (int i = 0; i < 4; ++i) { f32x4 a = (f32x4){0.f, 0.f, 0.f, 0.f};
                    for (int sl = 0; sl < nsl; ++sl) a += *(const f32x4*)(pp + (size_t)sl * MTS * D + 256 * i);
                    v[j][i] += (*(const f32x4*)(gp + 256 * i) * fscale) * a;
                    if (which != 3) *(f32x4*)(xb + (size_t)row * D + lane * 4 + 256 * i) = v[j][i]; } } }
#pragma unroll
        for (int j = 0; j < 2; ++j) { float a = 0.f;
#pragma unroll
            for (int i = 0; i < 4; ++i) a += v[j][i][0] * v[j][i][0] + v[j][i][1] * v[j][i][1] + v[j][i][2] * v[j][i][2] + v[j][i][3] * v[j][i][3];
            ss[j] = wave_sum(a); }
#pragma unroll
        for (int j = 0; j < 2; ++j) { const int row = rows[j];
            if (j == 1 && row == row0) continue;
            const float rstd = rsqrtf(ss[j] * (1.0f / 1024.0f) + 1e-6f);
            if (which == 3) {
#pragma unroll
                for (int i = 0; i < 4; ++i) { const int col = lane * 4 + 256 * i; const f32x4 g4 = *(const f32x4*)(gamma + col); *(f32x4*)(xb + (size_t)row * D + col) = v[j][i] * rstd * g4; }
            } else {
                const float* mr = modl + (size_t)mod_row(row) * 9216 + which * 3 * 1024;
#pragma unroll
                for (int i = 0; i < 4; ++i) { const int col = lane * 4 + 256 * i; const f32x4 g4 = *(const f32x4*)(gamma + col), sh = *(const f32x4*)(mr + col), sc = *(const f32x4*)(mr + 1024 + col);
                    const f32x4 h = (v[j][i] * rstd * g4) * (sc + 1.0f) + sh; u32x2 w; w.x = cvt_pk_bf16(h[0], h[1]); w.y = cvt_pk_bf16(h[2], h[3]);
                    *(u32x2*)(hb + (size_t)row * D + col) = w;
                    if (from_in) *(f32x4*)(xb + (size_t)row * D + col) = v[j][i]; }
            }
        }
    }
}

__device__ __forceinline__ void phase_m1(PP P, int l, LAS unsigned char* lds, const Ids I) {
    const int tid_local = make_tid(I.wv);
    const int tid = TID; unsigned char* ws = P->ws;
    const bf16_t* PR = (const bf16_t*)(ws + WS_R1);
    bf16_t* arr = (bf16_t*)(ws + WS_R2); const size_t AS = (size_t)MT * 512;
#pragma unroll 1
    for (int rep13 = 0; rep13 < (PROBE == 13 ? 2 : 1); ++rep13)
    {
        LAS float* XC = (LAS float*)lds;
        LAS bf16_t* XB = (LAS bf16_t*)(XC + 64 * 68);
        LAS bf16_t* OB = XB + 64 * 72;
        const int d = tid & 63, tg = tid >> 6, lane = tid & 63, quad = lane >> 4, l15 = lane & 15, wv = __builtin_amdgcn_readfirstlane(tid >> 6), mt = wv & 3, half = wv >> 2;
        bf16x8 bfr[4][2]; float bias4[4], sp4[4];
        for (int u = BID; u < 264 * 8; u += NB) {
            const int tt = u >> 3, n = u & 7, r0 = tt * 64, chg = n * 64 + d;
            if (u == BID || (NB & 7) != 0) {
                const float* wsrc = P->in[half ? I_LWA : I_LWX] + ((size_t)l * 8 + n) * 4096;
#pragma unroll
                for (int nt = 0; nt < 4; ++nt) { const int dd = nt * 16 + l15;
#pragma unroll
                    for (int ks = 0; ks < 2; ++ks) { const float* wp = wsrc + (size_t)(ks * 32 + quad * 8) * 64 + dd; u32x4 pk;
                        pk.x = cvt_pk_bf16(wp[0], wp[64]); pk.y = cvt_pk_bf16(wp[128], wp[192]); pk.z = cvt_pk_bf16(wp[256], wp[320]); pk.w = cvt_pk_bf16(wp[384], wp[448]);
                        bfr[nt][ks] = __builtin_bit_cast(bf16x8, pk); }
                    bias4[nt] = P->in[half ? I_LBA : I_LBX][l * 512 + n * 64 + dd]; sp4[nt] = softplusf(-P->in[I_LAM][l * 512 + n * 64 + dd]); } }
            const float* cw = P->in[I_CONVW] + (size_t)l * 4 * 512; const float cwv[4] = {cw[chg], cw[512 + chg], cw[1024 + chg], cw[1536 + chg]}; const float cb = P->in[I_CONVB][l * 512 + chg];
#pragma unroll
            for (int i = 0; i < 8; ++i) { const int r = r0 + tg * 8 + i, t = t_in_seq(r); float a = cb;
#pragma unroll
                for (int j = 0; j < 4; ++j) { const int ts = t - 3 + j; float xv;
                    if (ts >= 0) xv = bf2f(PR[(size_t)(r - 3 + j) * INW + chg]);
                    else xv = (r < MTP) ? 0.f : P->in[I_SCONV][(((size_t)l * 128 + ((r - MTP) >> 2)) * 3 + (ts + 3)) * 512 + chg];
                    a += xv * cwv[j]; }
                XC[d * 68 + tg * 8 + i] = a; XB[(tg * 8 + i) * 72 + d] = f2bf(a); }
            __syncthreads();
            f32x4 acc[4];
#pragma unroll
            for (int nt = 0; nt < 4; ++nt) acc[nt] = (f32x4){0.f, 0.f, 0.f, 0.f};
#pragma unroll
            for (int ks = 0; ks < 2; ++ks) { const bf16x8 af = *(const LAS bf16x8*)(XB + (mt * 16 + l15) * 72 + ks * 32 + quad * 8);
#pragma unroll
                for (int nt = 0; nt < 4; ++nt) acc[nt] = __builtin_amdgcn_mfma_f32_16x16x32_bf16(af, bfr[nt][ks], acc[nt], 0, 0, 0); }
#pragma unroll
            for (int nt = 0; nt < 4; ++nt) { const int dd = nt * 16 + l15;
#pragma unroll
                for (int j = 0; j < 4; ++j) { const int tok = mt * 16 + quad * 4 + j; const float g = sigmoidf(acc[nt][j] + bias4[nt]);
                    if (half) OB[tok * 64 + dd] = f2bf(-8.0f * g * sp4[nt]);
                    else OB[4096 + tok * 64 + dd] = f2bf(g * XC[dd * 68 + tok]); } }
            __syncthreads();
#pragma unroll
            for (int i = 0; i < 2; ++i) { const int idx = tid + 512 * i, a = idx >> 9, rem = idx & 511, tok = rem >> 3, c8 = (rem & 7) * 8;
                *(u32x4*)(arr + (a == 0 ? A_LA : A_GX) * AS + (size_t)(r0 + tok) * 512 + n * 64 + c8) = *(const LAS u32x4*)(OB + a * 4096 + tok * 64 + c8); }
            __syncthreads();
        }
    }
    {
        LAS bf16_t* XSB = (LAS bf16_t*)lds;
        LAS bf16_t* AL = XSB + 16 * 1536;
        LAS bf16_t* OR = AL + 16 * 136;
        const int lane = tid & 63, quad = lane >> 4, l15 = lane & 15, hd = __builtin_amdgcn_readfirstlane(tid >> 6); const float* mu = P->in[I_MU] + (size_t)l * PW;
        bf16x8 bfw[4][2], bfa[4][2]; float w0v[4], a0v[4], kkv[4], kav[4];
#pragma unroll
        for (int nt = 0; nt < 4; ++nt) { const int dd = hd * 64 + nt * 16 + l15;
            w0v[nt] = P->in[I_W0][l * 512 + dd]; a0v[nt] = P->in[I_A0][l * 512 + dd]; kkv[nt] = P->in[I_KK][l * 512 + dd]; kav[nt] = P->in[I_KA][l * 512 + dd];
#pragma unroll
            for (int ks = 0; ks < 2; ++ks) { const float* wp = P->in[I_W2] + ((size_t)l * 64 + ks * 32 + quad * 8) * 512 + dd; const float* ap = P->in[I_A2] + ((size_t)l * 64 + ks * 32 + quad * 8) * 512 + dd; u32x4 pk;
                pk.x = cvt_pk_bf16(wp[0], wp[512]); pk.y = cvt_pk_bf16(wp[1024], wp[1536]); pk.z = cvt_pk_bf16(wp[2048], wp[2560]); pk.w = cvt_pk_bf16(wp[3072], wp[3584]); bfw[nt][ks] = __builtin_bit_cast(bf16x8, pk);
                pk.x = cvt_pk_bf16(ap[0], ap[512]); pk.y = cvt_pk_bf16(ap[1024], ap[1536]); pk.z = cvt_pk_bf16(ap[2048], ap[2560]); pk.w = cvt_pk_bf16(ap[3072], ap[3584]); bfa[nt][ks] = __builtin_bit_cast(bf16x8, pk); } }
        for (int u = BID; u < MT / 16; u += NB) {
            const int r0 = u * 16;
#pragma unroll
            for (int it = 0; it < 7; ++it) { const int e = tid + 512 * it;
                if (e < 16 * 208) { const int tok = e / 208, col = (e - tok * 208) * 8, r = r0 + tok, t = t_in_seq(r);
                    float cf[8], pf[8]; unpack8(*(const u32x4*)(PR + (size_t)r * INW + 1024 + col), cf);
                    if (t > 0) unpack8(*(const u32x4*)(PR + (size_t)(r - 1) * INW + 1024 + col), pf);
                    else if (r < MTP) {
#pragma unroll
                        for (int j = 0; j < 8; ++j) pf[j] = 0.f; }
                    else { const float* sp = P->in[I_SSHIFT] + ((size_t)l * 128 + ((r - MTP) >> 2)) * PW + col; const f32x4 s0 = *(const f32x4*)sp, s1 = *(const f32x4*)(sp + 4);
#pragma unroll
                        for (int j = 0; j < 4; ++j) { pf[j] = s0[j]; pf[4 + j] = s1[j]; } }
                    const f32x4 m0 = *(const f32x4*)(mu + col), m1 = *(const f32x4*)(mu + col + 4); float xs[8];
#pragma unroll
                    for (int j = 0; j < 4; ++j) { xs[j] = cf[j] + (pf[j] - cf[j]) * m0[j]; xs[4 + j] = cf[4 + j] + (pf[4 + j] - cf[4 + j]) * m1[j]; }
                    if (col >= 1536 && col < 1600) {
#pragma unroll
                        for (int j = 0; j < 8; ++j) xs[j] = tanh_f(xs[j]); }
                    u32x4 w; w.x = cvt_pk_bf16(xs[0], xs[1]); w.y = cvt_pk_bf16(xs[2], xs[3]); w.z = cvt_pk_bf16(xs[4], xs[5]); w.w = cvt_pk_bf16(xs[6], xs[7]);
                    if (col < 1536) *(LAS u32x4*)(XSB + tok * 1536 + col) = w; else *(LAS u32x4*)(AL + tok * 136 + (col - 1536)) = w; } }
            __syncthreads();
            f32x4 aw[4], aa[4];
#pragma unroll
            for (int nt = 0; nt < 4; ++nt) { aw[nt] = (f32x4){0.f, 0.f, 0.f, 0.f}; aa[nt] = (f32x4){0.f, 0.f, 0.f, 0.f}; }
#pragma unroll
            for (int ks = 0; ks < 2; ++ks) { const bf16x8 fw = *(const LAS bf16x8*)(AL + l15 * 136 + ks * 32 + quad * 8), fa = *(const LAS bf16x8*)(AL + l15 * 136 + 64 + ks * 32 + quad * 8);
#pragma unroll
                for (int nt = 0; nt < 4; ++nt) { aw[nt] = __builtin_amdgcn_mfma_f32_16x16x32_bf16(fw, bfw[nt][ks], aw[nt], 0, 0, 0); aa[nt] = __builtin_amdgcn_mfma_f32_16x16x32_bf16(fa, bfa[nt][ks], aa[nt], 0, 0, 0); } }
#pragma unroll
            for (int j = 0; j < 4; ++j) { const int tk = quad * 4 + j; const LAS bf16_t* xp = XSB + tk * 1536 + hd * 64 + l15; float xk[4], ar[4], kk[4]; float ssq = 0.f;
#pragma unroll
                for (int nt = 0; nt < 4; ++nt) { xk[nt] = bf2f(xp[512 + nt * 16]); ar[nt] = sigmoidf(a0v[nt] + aa[nt][j]); kk[nt] = xk[nt] * kkv[nt]; ssq += kk[nt] * kk[nt]; }
                const float rn = 1.0f / fmaxf(sqrtf(row16_allsum(ssq)), 1e-12f);
#pragma unroll
                for (int nt = 0; nt < 4; ++nt) { LAS bf16_t* ob = OR + tk * 512 + hd * 64 + nt * 16 + l15; const float kn = kk[nt] * rn;
                    ob[0] = xp[nt * 16];
                    ob[8192] = f2bf(0.60653066f * sigmoidf(w0v[nt] + aw[nt][j]));
                    ob[2 * 8192] = f2bf(xk[nt] * (1.0f + (ar[nt] - 1.0f) * kav[nt]));
                    ob[3 * 8192] = xp[1024 + nt * 16];
                    ob[4 * 8192] = f2bf(kn); ob[5 * 8192] = f2bf(kn * ar[nt]); } }
            __syncthreads();
#pragma unroll
            for (int i = 0; i < 2; ++i) { const int idx = tid + 512 * i, tok = idx >> 6, c8 = (idx & 63) * 8; const size_t o = (size_t)(r0 + tok) * 512 + c8; const LAS bf16_t* ob = OR + tok * 512 + c8;
                *(u32x4*)(arr + A_R * AS + o) = *(const LAS u32x4*)(ob); *(u32x4*)(arr + A_EW * AS + o) = *(const LAS u32x4*)(ob + 8192); *(u32x4*)(arr + A_KF * AS + o) = *(const LAS u32x4*)(ob + 2 * 8192);
                *(u32x4*)(arr + A_V * AS + o) = *(const LAS u32x4*)(ob + 3 * 8192); *(u32x4*)(arr + A_KK * AS + o) = *(const LAS u32x4*)(ob + 4 * 8192); *(u32x4*)(arr + A_BB * AS + o) = *(const LAS u32x4*)(ob + 5 * 8192); }
        }
        __syncthreads();
    }
    for (int idx = BID * 512 + tid; idx < NMR * 3328; idx += NB * 512) {
        const int m = idx / 3328, e = idx - m * 3328;
        if (e < 1536) { const int j = e >> 9, ch = e & 511; const int row = (m < 8) ? m * 2048 + 2045 + j : MTP + (m - 8) * 4 + 1 + j; const float v = bf2f(PR[(size_t)row * INW + ch]);
            if (m < 8) P->out[O_PCONV + (((size_t)l * 8 + m) * 3 + j) * 512 + ch] = v; else P->out[O_SCONV + (((size_t)l * 128 + (m - 8)) * 3 + j) * 512 + ch] = v; }
        else { const int col = e - 1536; const int row = (m < 8) ? m * 2048 + 2047 : MTP + (m - 8) * 4 + 3; const float v = bf2f(PR[(size_t)row * INW + 1024 + col]);
            if (m < 8) P->out[O_PSHIFT + ((size_t)l * 8 + m) * PW + col] = v; else P->out[O_SSHIFT + ((size_t)l * 128 + (m - 8)) * PW + col] = v; }
    }
}

__device__ __forceinline__ void scan_lru(PP P, int l, LAS unsigned char* lds, const Ids I) {
    const int tid = make_tid(I.wv); unsigned char* ws = P->ws;
    const bf16_t* PR = (const bf16_t*)(ws + WS_R1); const bf16_t* LA = (const bf16_t*)(ws + WS_R2) + (size_t)A_LA * MT * 512; const bf16_t* GX = (const bf16_t*)(ws + WS_R2) + (size_t)A_GX * MT * 512;
    bf16_t* ymix = (bf16_t*)(ws + WS_HB); float* out = P->out;
    for (int g = BID * 512 + tid; g < 128 * 512; g += NB * 512) {
        const int sb = g >> 9, ch = g & 511; float h = P->in[I_SH][(unsigned)(l * 128 + sb) * 512u + ch];
#pragma unroll
        for (unsigned s = 0; s < 4; ++s) { const unsigned row = (unsigned)MTP + sb * 4 + s, o = row * 512u + ch; const float la = bf2f(LA[o]), gx = bf2f(GX[o]); const float a = __expf(la), bb = sqrtf(fmaxf(1.f - a * a, 0.f)) * gx;
            h = a * h + bb; const float gb = bf2f(PR[row * (unsigned)INW + 512u + ch]); ymix[row * 1024u + ch] = f2bf(h * gelu_tanh(gb)); }
        out[O_SH + (unsigned)(l * 128 + sb) * 512u + ch] = h;
    }
}
__device__ __forceinline__ f32x4 unpack4(const u32x2 w) { return (f32x4){__uint_as_float(w[0] << 16), __uint_as_float(w[0] & 0xffff0000u), __uint_as_float(w[1] << 16), __uint_as_float(w[1] & 0xffff0000u)}; }
__device__ __forceinline__ void scan_wkv_sample(PP P, int l, const Ids I) {
    const int tid = make_tid(I.wv), wave = __builtin_amdgcn_readfirstlane(tid >> 6), lane = tid & 63, rowl = lane >> 4, kseg = lane & 15; unsigned char* ws = P->ws;
    const bf16_t* arr = (const bf16_t*)(ws + WS_R2); const unsigned AS = (unsigned)MT * 512u; bf16_t* ymix = (bf16_t*)(ws + WS_HB);
    const float* sin_ = P->in[I_SWKV]; float* out = P->out;
    const int gw = BID * 8 + wave, nw = NB * 8;
    for (int q = gw; q < 128 * 8 * 16; q += nw) {
        const int pair = q >> 4, rgp = q & 15, sb = pair >> 3, h = pair & 7, vrow = rgp * 4 + rowl;
        const unsigned so = ((unsigned)((l * 128 + sb) * 8 + h) * 64u + vrow) * 64u + kseg * 4;
        f32x4 S = *(const f32x4*)(sin_ + so);
        f32x4 r_[4], w_[4], k_[4], a_[4], b_[4]; float v_[4];
#pragma unroll
        for (int s = 0; s < 4; ++s) { const unsigned row = (unsigned)MTP + sb * 4 + s, o = row * 512u + h * 64 + kseg * 4;
            r_[s] = unpack4(*(const u32x2*)(arr + A_R * AS + o)); w_[s] = unpack4(*(const u32x2*)(arr + A_EW * AS + o)); k_[s] = unpack4(*(const u32x2*)(arr + A_KF * AS + o));
            a_[s] = unpack4(*(const u32x2*)(arr + A_KK * AS + o)); b_[s] = unpack4(*(const u32x2*)(arr + A_BB * AS + o)); v_[s] = bf2f(arr[A_V * AS + row * 512u + h * 64 + vrow]); }
#pragma unroll
        for (int s = 0; s < 4; ++s) { const unsigned row = (unsigned)MTP + sb * 4 + s;
            const float p = (S[0] * a_[s][0] + S[1] * a_[s][1]) + (S[2] * a_[s][2] + S[3] * a_[s][3]); const float sa = -row16_allsum(p);
#pragma unroll
            for (int j = 0; j < 4; ++j) S[j] = fmaf(S[j], __expf(-w_[s][j]), fmaf(sa, b_[s][j], v_[s] * k_[s][j]));
            const float y = row16_allsum((S[0] * r_[s][0] + S[1] * r_[s][1]) + (S[2] * r_[s][2] + S[3] * r_[s][3]));
            if (kseg == 0) ymix[row * 1024u + 512u + h * 64 + vrow] = f2bf(y); }
        *(f32x4*)(out + O_SWKV + so) = S;
    }
}
__device__ __forceinline__ float fma_asm(float a, float b, float c) { float d; asm("v_fma_f32 %0, %1, %2, %3" : "=v"(d) : "v"(a), "v"(b), "v"(c)); return d; }
__device__ __forceinline__ float fnma_asm(float a, float b, float c) { float d; asm("v_fma_f32 %0, -%1, %2, %3" : "=v"(d) : "v"(a), "v"(b), "v"(c)); return d; }
__device__ __forceinline__ float mul_asm(float a, float b) { float d; asm("v_mul_f32 %0, %1, %2" : "=v"(d) : "v"(a), "v"(b)); return d; }
__device__ __forceinline__ void scan_wkv_prompt(PP P, int l, LAS unsigned char* lds, const Ids I) {
    const int tid = make_tid(I.wv), wave = __builtin_amdgcn_readfirstlane(tid >> 6), lane = tid & 63, rowl = lane >> 4, kseg = lane & 15; unsigned char* ws = P->ws;
    const bf16_t* arr = (const bf16_t*)(ws + WS_R2); const unsigned AS = (unsigned)MT * 512u; bf16_t* ymix = (bf16_t*)(ws + WS_HB); float* out = P->out;
    LAS float* buf = (LAS float*)lds;
    LAS float* ybuf = buf + 2 * 32 * 336;
    LAS unsigned char* raw = lds + 90112;
#define WKV_BAR() do { asm volatile("s_waitcnt lgkmcnt(0)" ::: "memory"); __builtin_amdgcn_s_barrier(); asm volatile("" ::: "memory"); } while (0)
    for (int u = BID; u < 256; u += NB) {
        const int bh = u >> 2, rg = u & 3, b = bh >> 3, h = bh & 7; const unsigned rowbase = (unsigned)b * 2048u;
        if (wave >= 4) {
            const int lw = wave - 4, lsl = lane >> 3, part = lane & 7, ls = lw * 8 + lsl;
            const bf16_t* g5[5] = {arr + A_R * AS, arr + A_EW * AS, arr + A_KF * AS, arr + A_KK * AS, arr + A_BB * AS};
#define WKV_DMA(cc) do { const unsigned row = rowbase + (unsigned)(cc) * 32u + ls; const unsigned o = row * 512u + h * 64 + part * 8; LAS unsigned char* slot = raw + ((cc) & 1) * 21504 + lw * 1024; \
            _Pragma("unroll") for (int a = 0; a < 5; ++a) __builtin_amdgcn_global_load_lds((const unsigned*)(g5[a] + o), (LAS unsigned*)(slot + a * 4096), 16, 0, 0); \
            __builtin_amdgcn_global_load_lds((const unsigned*)(arr + A_V * AS + row * 512u + h * 64 + rg * 16 + part * 2), (LAS unsigned*)(raw + ((cc) & 1) * 21504 + 20480 + lw * 256), 4, 0, 0); } while (0)
#define WKV_CONVERT(cc) do { const LAS unsigned char* slot = raw + ((cc) & 1) * 21504 + lw * 1024 + lane * 16; LAS float* dp = buf + ((cc) & 1) * (32 * 336) + ls * 336 + part * 8; float f[8]; \
            const u32x4 vr = *(const LAS u32x4*)(slot), vw = *(const LAS u32x4*)(slot + 4096), vk = *(const LAS u32x4*)(slot + 8192), va = *(const LAS u32x4*)(slot + 12288), vb = *(const LAS u32x4*)(slot + 16384); \
            const u32x4 vvv = *(const LAS u32x4*)(raw + ((cc) & 1) * 21504 + 20480 + lw * 256 + lsl * 32 + (part & 1) * 16); \
            unpack8(vr, f); *(LAS f32x4*)(dp) = (f32x4){f[0], f[1], f[2], f[3]}; *(LAS f32x4*)(dp + 4) = (f32x4){f[4], f[5], f[6], f[7]}; \
            unpack8(vw, f); *(LAS f32x4*)(dp + 64) = (f32x4){__expf(-f[0]), __expf(-f[1]), __expf(-f[2]), __expf(-f[3])}; *(LAS f32x4*)(dp + 68) = (f32x4){__expf(-f[4]), __expf(-f[5]), __expf(-f[6]), __expf(-f[7])}; \
            unpack8(vk, f); *(LAS f32x4*)(dp + 128) = (f32x4){f[0], f[1], f[2], f[3]}; *(LAS f32x4*)(dp + 132) = (f32x4){f[4], f[5], f[6], f[7]}; \
            unpack8(va, f); *(LAS f32x4*)(dp + 192) = (f32x4){f[0], f[1], f[2], f[3]}; *(LAS f32x4*)(dp + 196) = (f32x4){f[4], f[5], f[6], f[7]}; \
            unpack8(vb, f); *(LAS f32x4*)(dp + 256) = (f32x4){f[0], f[1], f[2], f[3]}; *(LAS f32x4*)(dp + 260) = (f32x4){f[4], f[5], f[6], f[7]}; \
            if (part < 2) { unpack8(vvv, f); *(LAS f32x4*)(dp + 320) = (f32x4){f[0], f[1], f[2], f[3]}; *(LAS f32x4*)(dp + 324) = (f32x4){f[4], f[5], f[6], f[7]}; } } while (0)
#define WKV_FLUSH(cc) do { const LAS float* yb = ybuf + ((cc) & 1) * 512 + ls * 16 + part * 2; const unsigned row = rowbase + (unsigned)(cc) * 32u + ls - 1u;     \
            if ((cc) > 0 || ls > 0) *(unsigned*)(ymix + row * 1024u + 512u + h * 64 + rg * 16 + part * 2) = cvt_pk_bf16(yb[0], yb[1]); } while (0)
            WKV_DMA(0); WKV_DMA(1);
            asm volatile("s_waitcnt vmcnt(6)" ::: "memory");
            WKV_CONVERT(0);
            LAS f32x2* LAB = (LAS f32x2*)(lds + 133120);
            const bf16_t* LAp = arr + A_LA * AS; const bf16_t* GXp = arr + A_GX * AS; const bf16_t* PRp = (const bf16_t*)(ws + WS_R1);
            const int lck = (tid & 255) >> 4, lcl = tid & 15, lch = (u & 31) * 16 + lcl; const unsigned lrow0 = (unsigned)(u >> 5) * 2048u + (unsigned)lck * 128u;
            float lA = 1.f, lB = 0.f, lh = 0.f;
#pragma unroll 1
            for (int c = 0; c < 64; ++c) {
                WKV_BAR();
                asm volatile("s_waitcnt vmcnt(0)" ::: "memory");
                const unsigned lr = lrow0 + (unsigned)(c & 31) * 4u; bf16_t vla[4], vgx[4], vgb[4];
#pragma unroll
                for (int k = 0; k < 4; ++k) { vla[k] = LAp[(lr + k) * 512u + lch]; vgx[k] = GXp[(lr + k) * 512u + lch]; vgb[k] = PRp[(lr + k) * (unsigned)INW + 512u + lch]; }
                if (c > 0) WKV_FLUSH(c - 1);
                if (c + 2 < 64) WKV_DMA(c + 2);
                if (c + 1 < 64) WKV_CONVERT(c + 1);
                if (c == 32) { for (int q = 0; q < lck; ++q) { const f32x2 ab = LAB[q * 16 + lcl]; lh = ab.x * lh + ab.y; } }
#pragma unroll
                for (int k = 0; k < 4; ++k) { const float la = bf2f(vla[k]), gx = bf2f(vgx[k]); const float a = __expf(la), bb = sqrtf(fmaxf(1.f - a * a, 0.f)) * gx;
                    if (c < 32) { lB = a * lB + bb; lA *= a; }
                    else { lh = a * lh + bb; ymix[(lr + k) * 1024u + lch] = f2bf(lh * gelu_tanh(bf2f(vgb[k]))); } }
                if (c == 31) LAB[lck * 16 + lcl] = (f32x2){lA, lB};
            }
            if (lck == 15) out[O_PH + (unsigned)(l * 8 + (u >> 5)) * 512u + lch] = lh;
            WKV_BAR();
            WKV_FLUSH(63);
            WKV_BAR();
#undef WKV_DMA
#undef WKV_CONVERT
#undef WKV_FLUSH
        } else {
#define DPPA(x, ctl) "v_add_f32_dpp " x ", " x ", " x " " ctl " row_mask:0xf bank_mask:0xf bound_ctrl:1\n\t"
            float S0 = 0.f, S1 = 0.f, S2 = 0.f, S3 = 0.f; f32x4 rp = (f32x4){0.f, 0.f, 0.f, 0.f};
#if PROBE == 11 || PROBE == 12
            float dmy = 0.f, dmy2;
#endif
            __builtin_amdgcn_s_setprio(3);
#pragma unroll 1
            for (int c = 0; c < 64; ++c) {
                WKV_BAR();
                const LAS float* bp = buf + (c & 1) * (32 * 336) + kseg * 4; LAS float* yb = ybuf + (c & 1) * 512; const int vo = 320 + wave * 4 + rowl - kseg * 4;
#define WKV_LDS6(R, W, K, A, B, V, pre, OFF) asm volatile(pre "ds_read_b128 %0, %6 offset:%8\n\tds_read_b128 %1, %6 offset:%9\n\tds_read_b128 %2, %6 offset:%10\n\tds_read_b128 %3, %6 offset:%11\n\tds_read_b128 %4, %6 offset:%12\n\tds_read_b32 %5, %7 offset:%8" \
                    : "=&v"(R), "=&v"(W), "=&v"(K), "=&v"(A), "=&v"(B), "=&v"(V) : "v"(ap), "v"(apv), "i"(OFF), "i"((OFF) + 256), "i"((OFF) + 512), "i"((OFF) + 768), "i"((OFF) + 1024))
                const unsigned ap = (unsigned)(size_t)bp, apv = (unsigned)(size_t)(bp + vo);
                f32x4 r4, w4, k4, a4, b4, nr4, nw4, nk4, na4, nb4; float vv, nvv;
                WKV_LDS6(r4, w4, k4, a4, b4, vv, "", 0);
                WKV_LDS6(nr4, nw4, nk4, na4, nb4, nvv, "", 1344);
                float ykeep = 0.f;
#pragma unroll
                for (int s = 0; s < 32; ++s) {
                    f32x4 mr4 = r4, mw4 = w4, mk4 = k4, ma4 = a4, mb4 = b4; float mvv = vv;
                    if (s < 30) { WKV_LDS6(mr4, mw4, mk4, ma4, mb4, mvv, "s_waitcnt lgkmcnt(6)\n\t", (s + 2) * 1344); }
                    else if (s == 30) asm volatile("s_waitcnt lgkmcnt(6)" ::: "memory");
                    else asm volatile("s_waitcnt lgkmcnt(0)" ::: "memory");
                    __builtin_amdgcn_sched_barrier(0);
                    float sum, y, p1, q1, t0, t1, t2, t3;
                    asm volatile(
                        "v_mul_f32 %0, %8, %12\n\t"  "v_mul_f32 %1, %8, %16\n\t"
                        "v_fma_f32 %0, %9, %13, %0\n\t"  "v_fma_f32 %1, %9, %17, %1\n\t"
                        "v_mul_f32 %2, %10, %14\n\t"  "v_mul_f32 %3, %10, %18\n\t"
                        "v_fma_f32 %2, %11, %15, %2\n\t"  "v_fma_f32 %3, %11, %19, %3\n\t"
                        "v_add_f32 %0, %0, %2\n\t"  "v_add_f32 %1, %1, %3\n\t"
                        "v_mul_f32 %4, %20, %21\n\t"  "v_mul_f32 %5, %20, %22\n\t"
                        DPPA("%0", "quad_perm:[1,0,3,2]") DPPA("%1", "quad_perm:[1,0,3,2]")
                        "v_mul_f32 %6, %20, %23\n\t"
                        DPPA("%0", "quad_perm:[2,3,0,1]") DPPA("%1", "quad_perm:[2,3,0,1]")
                        "v_mul_f32 %7, %20, %24\n\t"
                        DPPA("%0", "row_half_mirror") DPPA("%1", "row_half_mirror")
                        "s_nop 0\n\t"
                        DPPA("%0", "row_mirror") DPPA("%1", "row_mirror")
                        : "=&v"(sum), "=&v"(y), "=&v"(p1), "=&v"(q1), "=&v"(t0), "=&v"(t1), "=&v"(t2), "=&v"(t3)
                        : "v"(S0), "v"(S1), "v"(S2), "v"(S3), "v"(a4[0]), "v"(a4[1]), "v"(a4[2]), "v"(a4[3]), "v"(rp[0]), "v"(rp[1]), "v"(rp[2]), "v"(rp[3]),
                          "v"(vv), "v"(k4[0]), "v"(k4[1]), "v"(k4[2]), "v"(k4[3]));
                    asm volatile(
                        "v_fma_f32 %4, -%8, %9, %4\n\t"  "v_fma_f32 %5, -%8, %10, %5\n\t"  "v_fma_f32 %6, -%8, %11, %6\n\t"  "v_fma_f32 %7, -%8, %12, %7\n\t"
                        "v_fma_f32 %0, %0, %13, %4\n\t"  "v_fma_f32 %1, %1, %14, %5\n\t"  "v_fma_f32 %2, %2, %15, %6\n\t"  "v_fma_f32 %3, %3, %16, %7"
                        : "+v"(S0), "+v"(S1), "+v"(S2), "+v"(S3), "+v"(t0), "+v"(t1), "+v"(t2), "+v"(t3)
                        : "v"(sum), "v"(b4[0]), "v"(b4[1]), "v"(b4[2]), "v"(b4[3]), "v"(w4[0]), "v"(w4[1]), "v"(w4[2]), "v"(w4[3]));
#if PROBE == 11
                    asm volatile(DPPA("%0", "quad_perm:[1,0,3,2]") "v_mov_b32 %1, %0\n\t" DPPA("%0", "quad_perm:[2,3,0,1]") "v_mov_b32 %1, %0\n\t" DPPA("%0", "row_half_mirror") "v_mov_b32 %1, %0\n\t" DPPA("%0", "row_mirror") "v_mov_b32 %1, %0\n\t"
                                 DPPA("%0", "quad_perm:[1,0,3,2]") "v_mov_b32 %1, %0\n\t" DPPA("%0", "quad_perm:[2,3,0,1]") "v_mov_b32 %1, %0\n\t" DPPA("%0", "row_half_mirror") "v_mov_b32 %1, %0\n\t" DPPA("%0", "row_mirror") "v_mov_b32 %1, %0" : "+v"(dmy), "=&v"(dmy2));
#elif PROBE == 12
                    asm volatile("v_add_f32 %0, %0, %0\n\tv_mov_b32 %1, %0\n\tv_add_f32 %0, %0, %0\n\tv_mov_b32 %1, %0\n\tv_add_f32 %0, %0, %0\n\tv_mov_b32 %1, %0\n\tv_add_f32 %0, %0, %0\n\tv_mov_b32 %1, %0\n\t"
                                 "v_add_f32 %0, %0, %0\n\tv_mov_b32 %1, %0\n\tv_add_f32 %0, %0, %0\n\tv_mov_b32 %1, %0\n\tv_add_f32 %0, %0, %0\n\tv_mov_b32 %1, %0\n\tv_add_f32 %0, %0, %0\n\tv_mov_b32 %1, %0" : "+v"(dmy), "=&v"(dmy2));
#endif
                    ykeep = (kseg == (s & 15)) ? y : ykeep;
                    rp = r4; r4 = nr4; w4 = nw4; k4 = nk4; a4 = na4; b4 = nb4; vv = nvv;
                    nr4 = mr4; nw4 = mw4; nk4 = mk4; na4 = ma4; nb4 = mb4; nvv = mvv;
                    __builtin_amdgcn_sched_barrier(0);
                    if ((s & 15) == 15) yb[((s & 16) + kseg) * 16 + wave * 4 + rowl] = ykeep;
                }
            }
            __builtin_amdgcn_s_setprio(0);
            WKV_BAR();
            { const int vrow = rg * 16 + wave * 4 + rowl; *(f32x4*)(out + O_PWKV + ((unsigned)((l * 8 + b) * 8 + h) * 64u + vrow) * 64u + kseg * 4) = (f32x4){S0, S1, S2, S3};
              const float ylast = row16_allsum((S0 * rp[0] + S1 * rp[1]) + (S2 * rp[2] + S3 * rp[3]));
              if (kseg == 0) ymix[(rowbase + 2047u) * 1024u + 512u + h * 64 + vrow] = (bf16_t)(cvt_pk_bf16(ylast, 0.f) & 0xffffu); }
            WKV_BAR();
#undef DPPA
        }
    }
#undef WKV_BAR
}
__device__ __forceinline__ void phase_scan(PP P, int l, LAS unsigned char* lds, const Ids I) {
#pragma unroll 1
    for (int rep = 0; rep < (PROBE == 8 ? 2 : 1); ++rep) scan_lru(P, l, lds, I);
#pragma unroll 1
    for (int rep = 0; rep < (PROBE == 9 ? 2 : 1); ++rep) scan_wkv_sample(P, l, I);
    scan_wkv_prompt(P, l, lds, I);
}

__device__ __forceinline__ void phase_m2(PP P, int l, LAS unsigned char* lds, const Ids I) {
    const int tid_local = make_tid(I.wv);
    const int tid = TID, d = tid; unsigned char* ws = P->ws;
    const bf16_t* PR = (const bf16_t*)(ws + WS_R1); const bf16_t* arr = (const bf16_t*)(ws + WS_R2); const size_t AS = (size_t)MT * 512;
    bf16_t* ymix = (bf16_t*)(ws + WS_HB);
    LAS float* SG = (LAS float*)lds;
    LAS float* LY = SG + 1024; LAS float* LR = LY + 4096; LAS float* LK = LR + 4096; LAS float* LV = LK + 4096;
    const float* mu = P->in[I_MU] + (size_t)l * PW;
    const float lnw = P->in[I_LNW][l * 512 + d], lnb = P->in[I_LNB][l * 512 + d], rk = P->in[I_RK][l * 512 + d];
    float g2c[128];
    { const float* g2 = P->in[I_G2] + (size_t)l * 128 * 512 + d;
#pragma unroll
      for (int c = 0; c < 128; ++c) g2c[c] = g2[c * 512]; }
    for (int u = BID; u < MT / 8; u += NB) {
        const int r0 = u * 8;
#pragma unroll
        for (int i = 0; i < 2; ++i) { const int idx = tid + 512 * i, tok = idx >> 7, col = idx & 127, r = r0 + tok, t = t_in_seq(r);
            const float cur = bf2f(PR[(size_t)r * INW + 2688 + col]);
            const float prev = t > 0 ? bf2f(PR[(size_t)(r - 1) * INW + 2688 + col]) : (r < MTP ? 0.f : P->in[I_SSHIFT][((size_t)l * 128 + ((r - MTP) >> 2)) * PW + 1664 + col]);
            SG[tok * 128 + col] = sigmoidf(cur + (prev - cur) * mu[1664 + col]); }
        { const int tok = tid >> 6, c8 = (tid & 63) * 8; const size_t r = (size_t)r0 + tok; float f[8];
            unpack8(*(const u32x4*)(ymix + r * 1024 + 512 + c8), f); *(LAS f32x4*)(LY + tok * 512 + c8) = (f32x4){f[0], f[1], f[2], f[3]}; *(LAS f32x4*)(LY + tok * 512 + c8 + 4) = (f32x4){f[4], f[5], f[6], f[7]};
            unpack8(*(const u32x4*)(arr + A_R * AS + r * 512 + c8), f); *(LAS f32x4*)(LR + tok * 512 + c8) = (f32x4){f[0], f[1], f[2], f[3]}; *(LAS f32x4*)(LR + tok * 512 + c8 + 4) = (f32x4){f[4], f[5], f[6], f[7]};
            unpack8(*(const u32x4*)(arr + A_KF * AS + r * 512 + c8), f); *(LAS f32x4*)(LK + tok * 512 + c8) = (f32x4){f[0], f[1], f[2], f[3]}; *(LAS f32x4*)(LK + tok * 512 + c8 + 4) = (f32x4){f[4], f[5], f[6], f[7]};
            unpack8(*(const u32x4*)(arr + A_V * AS + r * 512 + c8), f); *(LAS f32x4*)(LV + tok * 512 + c8) = (f32x4){f[0], f[1], f[2], f[3]}; *(LAS f32x4*)(LV + tok * 512 + c8 + 4) = (f32x4){f[4], f[5], f[6], f[7]}; }
        __syncthreads();
#pragma unroll 1
        for (int i = 0; i < 8; ++i) { const size_t r = (size_t)r0 + i; const float y = LY[i * 512 + d], rr = LR[i * 512 + d], kf = LK[i * 512 + d], vv = LV[i * 512 + d];
            float g0 = 0.f, g1 = 0.f, g2_ = 0.f, g3 = 0.f;
#pragma unroll
            for (int q = 0; q < 32; ++q) { const f32x4 sg = *(const LAS f32x4*)(SG + i * 128 + q * 4);
                g0 += sg[0] * g2c[q * 4 + 0]; g1 += sg[1] * g2c[q * 4 + 1]; g2_ += sg[2] * g2c[q * 4 + 2]; g3 += sg[3] * g2c[q * 4 + 3]; }
            const float m = wave_sum(y) * (1.0f / 64.0f), dy = y - m, var = wave_sum(dy * dy) * (1.0f / 64.0f);
            const float yn = dy * rsqrtf(var + 64e-5f) * lnw + lnb;
            const float bs = wave_sum(rr * kf * rk);
            LY[i * 512 + d] = (yn + bs * vv) * ((g0 + g1) + (g2_ + g3)); }
        __syncthreads();
        { const int tok = tid >> 6, c8 = (tid & 63) * 8; const LAS float* lp = LY + tok * 512 + c8; const f32x4 a = *(const LAS f32x4*)lp, b = *(const LAS f32x4*)(lp + 4);
          u32x4 w; w.x = cvt_pk_bf16(a[0], a[1]); w.y = cvt_pk_bf16(a[2], a[3]); w.z = cvt_pk_bf16(b[0], b[1]); w.w = cvt_pk_bf16(b[2], b[3]);
          *(u32x4*)(ymix + ((size_t)r0 + tok) * 1024 + 512 + c8) = w; }
        __syncthreads();
    }
}

#define XB_TMO      128
#define XB_XCNT(j)  (256  + 64 * (j))
#define XB_XSUB(j)  (1280 + 64 * (j))
#define XB_XGEN(j)  (2304 + 64 * (j))
#define XB_TOP      3328
#define XB_TOPGEN   3392
#define XCD_BAR_WORDS 3456
#define XB_SPIN_CAP (1u << 18)
__device__ __forceinline__ unsigned xb_ld(unsigned* p)              { return __hip_atomic_load(p, __ATOMIC_RELAXED, __HIP_MEMORY_SCOPE_AGENT); }
__device__ __forceinline__ unsigned xb_add(unsigned* p, unsigned v) { return __hip_atomic_fetch_add(p, v, __ATOMIC_RELAXED, __HIP_MEMORY_SCOPE_AGENT); }
__device__ __forceinline__ unsigned xb_xcc_id() { return (unsigned)__builtin_amdgcn_s_getreg((3 << 11) | 20) & 0xFu; }
#define XB_SPIN(cond, bar) do { unsigned _sp = 0; while (cond) { __builtin_amdgcn_s_sleep(1); \
    if ((++_sp & 255u) == 0u) { if (xb_ld(&(bar)[XB_TMO])) break; if (_sp > XB_SPIN_CAP) { atomicAdd(&(bar)[XB_TMO], 1u); break; } } } } while (0)
__device__ __forceinline__ void xcd_barrier_complete(unsigned* bar, unsigned x, unsigned G, unsigned& nloc, unsigned& nx) {
    unsigned sum, cnt, mine, sp = 0u;
    for (;;) {
        sum = 0u; cnt = 0u; mine = 0u;
#pragma unroll
        for (unsigned j = 0; j < 16; ++j) { const unsigned c = xb_ld(&bar[XB_XCNT(j)]); sum += c; cnt += (c > 0u) ? 1u : 0u; mine = (j == x) ? c : mine; }
        if (sum == G) break;
        __builtin_amdgcn_s_sleep(1);
        if ((++sp & 255u) == 0u) { if (xb_ld(&bar[XB_TMO])) break; if (sp > XB_SPIN_CAP) { atomicAdd(&bar[XB_TMO], 1u); break; } }
    }
    nloc = mine > 0u ? mine : 1u; nx = cnt > 0u ? cnt : 1u;
}
__device__ __forceinline__ void xcd_barrier(unsigned* bar, volatile LAS unsigned* st, const Ids I) {
    asm volatile("s_waitcnt vmcnt(0)" ::: "memory");
    __syncthreads();
    if (make_tid(I.wv) == 0) {
        const unsigned x = xb_xcc_id();
        __builtin_amdgcn_s_waitcnt(0);
        unsigned nloc = st[0], nx = st[1];
        if (nloc == 0u) { xcd_barrier_complete(bar, x, (unsigned)I.nb, nloc, nx); st[0] = nloc; st[1] = nx; }
        const unsigned old = xb_add(&bar[XB_XSUB(x)], 1u);
        const unsigned gen = old / nloc;
        if (old + 1u == (gen + 1u) * nloc) {
            __builtin_amdgcn_fence(__ATOMIC_RELEASE, "agent");
            asm volatile("s_waitcnt vmcnt(0)" ::: "memory");
            const unsigned og = xb_add(&bar[XB_TOP], 1u);
            const unsigned tg = og / nx;
            if (og + 1u == (tg + 1u) * nx) xb_add(&bar[XB_TOPGEN], 1u);
            else XB_SPIN(xb_ld(&bar[XB_TOPGEN]) == tg, bar);
            __builtin_amdgcn_fence(__ATOMIC_ACQUIRE, "agent");
            xb_add(&bar[XB_XGEN(x)], 1u);
            asm volatile("s_waitcnt vmcnt(0)" ::: "memory");
        } else {
            XB_SPIN(xb_ld(&bar[XB_XGEN(x)]) == gen, bar);
            __builtin_amdgcn_fence(__ATOMIC_ACQUIRE, "agent");
            asm volatile("s_waitcnt vmcnt(0)" ::: "memory");
        }
    }
    __syncthreads();
}

__global__ void __launch_bounds__(512) mega(Params Pval) {
    extern __shared__ __attribute__((aligned(16))) unsigned char lds_raw[];
    LAS unsigned char* lds = (LAS unsigned char*)lds_raw;
    cg::grid_group grid = cg::this_grid();
    const int NSTEP = 2 + 2 * 12 + 1;
    const int wave_s = __builtin_amdgcn_readfirstlane((int)threadIdx.x >> 6);
    {
        volatile LAS unsigned* st0 = (volatile LAS unsigned*)(lds + LDS_MAIN);
        if (threadIdx.x == 0) { st0[0] = 0u; st0[1] = 0u; (void)xb_add(&((unsigned*)Pval.ws)[XB_XCNT(xb_xcc_id())], 1u); }
        __syncthreads();
    }
#pragma unroll 1
    for (int step = 0; step < NSTEP; ++step) {
        Ids I; I.bid = (int)blockIdx.x; I.nb = (int)gridDim.x; int wv = wave_s;
        unsigned long long pv = (unsigned long long)__builtin_amdgcn_kernarg_segment_ptr();
        asm volatile("" : "+s"(wv), "+s"(I.bid), "+s"(I.nb), "+s"(pv));
        I.bid = __builtin_amdgcn_readfirstlane(I.bid); I.nb = __builtin_amdgcn_readfirstlane(I.nb);
        I.wv = __builtin_amdgcn_readfirstlane(wv);
        PP P = (PP)(((unsigned long long)(unsigned)__builtin_amdgcn_readfirstlane((int)(pv >> 32)) << 32) | (unsigned long long)(unsigned)__builtin_amdgcn_readfirstlane((int)pv));
        unsigned char* ws = P->ws;
        const bool mid = (step >= 2 && step < NSTEP - 1);
        const int l = mid ? (step - 2) / 12 : 0, sub = mid ? (step - 2) % 12 : -1;
        int nrep = 1;
#if PROBE == 1
        if (step == 1 || sub == 1 || sub == 4 || sub == 10) nrep = 2;
#elif PROBE == 2
        if (sub == 6) nrep = 2;
#elif PROBE == 3
        if (step == 0 || sub == 0 || sub == 3 || sub == 9 || sub == 5) nrep = 2;
#elif PROBE == 4
        if (step == 0) nrep = 2;
#elif PROBE == 5
        if (sub == 5) nrep = 2;
#elif PROBE == 6
        if (sub == 3 || sub == 9) nrep = 2;
#elif PROBE == 7
        if (step == 1) { for (int e = 0; e < 20; ++e) xcd_barrier((unsigned*)ws, (volatile LAS unsigned*)(lds + LDS_MAIN), I); }
#endif
#pragma unroll 1
        for (int rep = 0; rep < nrep; ++rep) {
        if (step == 0) phase_prologue(P, lds, I);
        else if (step == 1) {
            if (I.nb > 144) { if (I.bid < 72) { EpiAda E{(float*)(ws + WS_MOD), P->in[I_BADA]}; run_gemm(lds, (const bf16_t*)(ws + WS_AADA), (const bf16_t*)(ws + WS_R2), 256, 2 * 9216, 1024, E, I); }
                              else { Ids J = I; J.bid = I.bid - 72; J.nb = I.nb - 72; convert_layer(P, 0, lds, J); } }
            else { EpiAda E{(float*)(ws + WS_MOD), P->in[I_BADA]}; run_gemm(lds, (const bf16_t*)(ws + WS_AADA), (const bf16_t*)(ws + WS_R2), 256, 2 * 9216, 1024, E, I); convert_layer(P, 0, lds, I); } }
        else if (step == NSTEP - 1) phase_norm(P, 0, 3, FF / 256, (const float*)(ws + WS_MOD) + (size_t)1 * NMR * 9216 + 8 * 1024, 0.5f, I);
        else {
            const float* modl = (const float*)(ws + WS_MOD) + (size_t)l * NMR * 9216;
            if (sub == 0 || sub == 3 || sub == 9) {
                if (sub == 0 && l == 1) convert_layer(P, 1, lds, I);
                const int nsl = (sub == 0) ? (l == 1 ? FF / 256 : 0) : (sub == 3 ? FF / 256 : 1024 / 256);
                const float* fg = (sub == 0) ? (const float*)(ws + WS_MOD) + 8 * 1024 : modl + (sub == 3 ? 2 : 5) * 1024;
                phase_norm(P, l, sub == 0 ? 0 : (sub == 3 ? 1 : 2), nsl, fg, sub == 9 ? 1.0f : 0.5f, I);
            } else if (sub == 1 || sub == 10) {
                EpiSwiGLU E{(bf16_t*)(ws + WS_R1)}; run_gemm(lds, (const bf16_t*)(ws + WS_HB), (const bf16_t*)(ws + (sub == 1 ? WS_WGU1 : WS_WGU2)), MT, 2 * FF, 1024, E, I);
            } else if (sub == 2 || sub == 8 || sub == 11) {
                const int gk = sub == 2 ? 2 : (sub == 8 ? 5 : 8);
                const float scl = sub == 8 ? 1.0f : 0.5f; const int Kd = sub == 8 ? 1024 : FF;
                EpiResid E{P->out, modl + gk * 1024, scl};
                const bf16_t* A = (const bf16_t*)(ws + (sub == 8 ? WS_HB : WS_R1)); const bf16_t* Bt = (const bf16_t*)(ws + (sub == 2 ? WS_WD1 : (sub == 8 ? WS_WOUT : WS_WD2)));
                run_gemm(lds, A, Bt, MTP, 1024, Kd, E, I);
                EpiPartial EA{(float*)(ws + WS_R2)};
                run_gemm_splitk(lds, A + (size_t)MTP * Kd, Bt, MTS, 1024, Kd, 256, EA, I);
            } else if (sub == 4) {
                EpiProj E{(bf16_t*)(ws + WS_R1)}; run_gemm(lds, (const bf16_t*)(ws + WS_HB), (const bf16_t*)(ws + WS_WIN), MT, INW, 1024, E, I);
            } else if (sub == 5) phase_m1(P, l, lds, I);
            else if (sub == 6) phase_scan(P, l, lds, I);
            else phase_m2(P, l, lds, I);
        }
        if (step == 0) grid.sync();
        else if (step != NSTEP - 1) xcd_barrier((unsigned*)ws, (volatile LAS unsigned*)(lds + LDS_MAIN), I);
        }
    }
}

extern "C" void kernel_launch(void* const* d_in, const int* in_sizes, int n_in, void* d_out, int out_size, void* d_ws, size_t ws_size, hipStream_t stream) {
    static int grid_blocks = 0;
    if (!grid_blocks) {
        if (n_in != 40 || ws_size < WS_END) { fprintf(stderr, "kernel_launch: need 40 inputs and %zu bytes of workspace; got %d, %zu\n", (size_t)WS_END, n_in, ws_size); grid_blocks = -1; return; }
        int dev = 0, cus = 0, per_cu = 0;
        hipGetDevice(&dev);
        hipDeviceGetAttribute(&cus, hipDeviceAttributeMultiprocessorCount, dev);
        hipFuncSetAttribute((const void*)mega, hipFuncAttributeMaxDynamicSharedMemorySize, LDS_BYTES);
        hipOccupancyMaxActiveBlocksPerMultiprocessor(&per_cu, (const void*)mega, 512, LDS_BYTES);
        if (per_cu < 1) { fprintf(stderr, "kernel_launch: occupancy query says %d blocks per CU\n", per_cu); grid_blocks = -1; return; }
        grid_blocks = cus;
    }
    if (grid_blocks < 0) return;
    Params p{};
    for (int i = 0; i < 40; ++i) p.in[i] = (const float*)d_in[i];
    p.out = (float*)d_out; p.ws = (unsigned char*)d_ws;
    if (hipMemsetAsync(d_ws, 0, 16384, stream) != hipSuccess) { fprintf(stderr, "kernel_launch: memset of the barrier words failed\n"); return; }
    void* args[] = {&p};
    hipError_t e = hipLaunchCooperativeKernel((const void*)mega, dim3(grid_blocks), dim3(512), args, LDS_BYTES, stream);
    if (e != hipSuccess) fprintf(stderr, "cooperative launch failed: %s (grid %d)\n", hipGetErrorString(e), grid_blocks);
}
```

```cpp
#include <hip/hip_runtime.h>
#include <hip/hip_cooperative_groups.h>
#include <cstdio>
namespace cg = cooperative_groups;

#define LAS __attribute__((address_space(3)))
typedef unsigned short bf16_t;
typedef short bf16x8 __attribute__((ext_vector_type(8)));
typedef float f32x4 __attribute__((ext_vector_type(4)));
typedef float f32x2 __attribute__((ext_vector_type(2)));
typedef unsigned u32x4 __attribute__((ext_vector_type(4)));
typedef unsigned u32x2 __attribute__((ext_vector_type(2)));

constexpr int D = 1024, MTP = 16384, MTS = 512, MT = 16896, FF = 2816, INW = 2816, PW = 1792, NMR = 136;
#ifndef PROBE
#define PROBE 0
#endif
constexpr int LDS_MAIN = 155648, LDS_BYTES = LDS_MAIN + 16;
constexpr size_t SZ_WGU = (size_t)5632 * 1024 * 2, SZ_WD = (size_t)1024 * 2816 * 2, SZ_WIN = (size_t)2816 * 1024 * 2, SZ_WOUT = (size_t)1024 * 1024 * 2;
constexpr size_t WS_WGU1 = 16384, WS_WD1 = WS_WGU1 + SZ_WGU, WS_WIN = WS_WD1 + SZ_WD, WS_WOUT = WS_WIN + SZ_WIN, WS_WGU2 = WS_WOUT + SZ_WOUT, WS_WD2 = WS_WGU2 + SZ_WGU;
constexpr size_t WS_MOD = WS_WD2 + SZ_WD, SZ_MOD = (size_t)2 * NMR * 9216 * 4;
constexpr size_t WS_AADA = WS_MOD + SZ_MOD, SZ_AADA = (size_t)256 * 1024 * 2;
constexpr size_t WS_HB = WS_AADA + SZ_AADA, SZ_HB = (size_t)MT * 1024 * 2;
constexpr size_t WS_R1 = WS_HB + SZ_HB, SZ_R1 = (size_t)MT * 2816 * 2;
constexpr size_t WS_R2 = WS_R1 + SZ_R1, SZ_ARR = (size_t)MT * 512 * 2;
constexpr size_t WS_END = WS_R2 + 8 * SZ_ARR;
enum { A_LA = 0, A_GX, A_R, A_EW, A_KF, A_V, A_KK, A_BB };
constexpr size_t O_PCONV = (size_t)MT * 1024, O_PH = O_PCONV + 24576, O_PSHIFT = O_PH + 8192, O_PWKV = O_PSHIFT + 28672, O_SCONV = O_PWKV + 524288,
                 O_SH = O_SCONV + 393216, O_SSHIFT = O_SH + 131072, O_SWKV = O_SSHIFT + 458752;
enum { I_XP = 0, I_XS, I_CP, I_CS, I_SCONV, I_SH, I_SSHIFT, I_SWKV, I_WADA, I_BADA, I_F1N, I_F1G, I_F1U, I_F1D, I_MIXN, I_WIN, I_WOUT, I_CONVW, I_CONVB, I_LWX, I_LBX,
       I_LWA, I_LBA, I_LAM, I_MU, I_W0, I_W2, I_A0, I_A2, I_G2, I_KK, I_KA, I_RK, I_LNW, I_LNB, I_F2N, I_F2G, I_F2U, I_F2D, I_FN };

struct Params { const float* in[40]; float* out; unsigned char* ws; };
typedef const __attribute__((address_space(4))) Params* PP;
struct Ids { int wv, bid, nb; };
__device__ __forceinline__ int make_tid(int wv) { int lane_v; asm volatile("v_mbcnt_lo_u32_b32 %0, -1, 0\n\tv_mbcnt_hi_u32_b32 %0, -1, %0" : "=v"(lane_v)); return wv * 64 + lane_v; }
#define TID tid_local
#define BID (I.bid)
#define NB (I.nb)

__device__ __forceinline__ float bf2f(bf16_t h) { return __uint_as_float((unsigned)h << 16); }
__device__ __forceinline__ unsigned cvt_pk_bf16(float lo, float hi) { unsigned r; asm("v_cvt_pk_bf16_f32 %0, %1, %2" : "=v"(r) : "v"(lo), "v"(hi)); return r; }
__device__ __forceinline__ bf16_t f2bf(float f) { return (bf16_t)(cvt_pk_bf16(f, 0.f) & 0xffffu); }
__device__ __forceinline__ float rcpf(float x) { return __builtin_amdgcn_rcpf(x); }
__device__ __forceinline__ float sigmoidf(float x) { return rcpf(1.0f + __expf(-x)); }
__device__ __forceinline__ float tanh_f(float x) { return 1.0f - 2.0f * rcpf(1.0f + __expf(2.0f * x)); }
__device__ __forceinline__ float gelu_tanh(float x) { const float u = 0.7978845608f * (x + 0.044715f * x * x * x); return 0.5f * x * (1.0f + tanh_f(u)); }
__device__ __forceinline__ float softplusf(float x) { return fmaxf(x, 0.f) + log1pf(__expf(-fabsf(x))); }
template <int CTRL> __device__ __forceinline__ float dpp_mov(float x) {
    return __builtin_bit_cast(float, __builtin_amdgcn_update_dpp(0, __builtin_bit_cast(int, x), CTRL, 0xF, 0xF, true));
}
__device__ __forceinline__ float row16_allsum(float x) {
    x += dpp_mov<0xB1>(x); x += dpp_mov<0x4E>(x); x += dpp_mov<0x141>(x); x += dpp_mov<0x140>(x); return x;
}
__device__ __forceinline__ float wave_sum(float x) {
    x = row16_allsum(x);
    const float a = __builtin_bit_cast(float, __builtin_amdgcn_readlane(__builtin_bit_cast(int, x), 0)), b = __builtin_bit_cast(float, __builtin_amdgcn_readlane(__builtin_bit_cast(int, x), 16)),
                c = __builtin_bit_cast(float, __builtin_amdgcn_readlane(__builtin_bit_cast(int, x), 32)), d = __builtin_bit_cast(float, __builtin_amdgcn_readlane(__builtin_bit_cast(int, x), 48));
    return (a + b) + (c + d);
}
__device__ __forceinline__ void unpack8(const u32x4 w, float (&f)[8]) {
#pragma unroll
    for (int i = 0; i < 4; ++i) { f[2 * i] = __uint_as_float(w[i] << 16); f[2 * i + 1] = __uint_as_float(w[i] & 0xffff0000u); }
}
__device__ __forceinline__ int mod_row(int r) { return r < MTP ? (r >> 11) : 8 + ((r - MTP) >> 2); }
__device__ __forceinline__ int t_in_seq(int r) { return r < MTP ? (r & 2047) : ((r - MTP) & 3); }

namespace pg8 {
constexpr int BM = 256, BK = 64, HALF = 128, HTB = HALF * BK * 2, STAGE_BYTES = 8 * HTB, NXCD = 8, WGM = 8;
__device__ __forceinline__ int lds_byte(int r, int c) { const int st = (r >> 4) * 2 + (c >> 5), rr = r & 15, cc = c & 31, ob = rr * 64 + cc * 2; return st * 1024 + (ob ^ (((ob >> 9) & 1) << 5)); }
__device__ __forceinline__ void stage_rc(int b, int& R, int& C) { const int st = b / 1024, sb = b % 1024, swz = sb ^ (((sb >> 9) & 1) << 5); R = (st >> 1) * 16 + swz / 64; C = (st & 1) * 32 + (swz % 64) / 2; }
struct Unit { int pm, pn, kb; };
struct Gemm { const bf16_t* A; const bf16_t* Bt; int M, N, K, ld; };
struct StaticOrder {
    int nM, nN, nwg, G, c;
    __device__ void init(int M, int N, int G_, int c_) { nM = M / BM; nN = N / BM; nwg = nM * nN; G = G_; c = c_; }
    __device__ bool next(int i, Unit& u) const {
        const long L = (long)i * G + c; if (L >= nwg) return false;
        int wgid = (int)L; { const int q = nwg / NXCD, r = nwg % NXCD, xcd = wgid % NXCD, off = wgid / NXCD; wgid = (xcd < r ? xcd * (q + 1) : r * (q + 1) + (xcd - r) * q) + off; }
        const int nig = WGM * nN, gid = wgid / nig, fm = gid * WGM, gsz = (nM - fm) < WGM ? (nM - fm) : WGM;
        u.pm = fm + ((wgid % nig) % gsz); u.pn = (wgid % nig) / gsz; u.kb = 0; return true;
    }
};
struct SplitOrder {
    int nM, nN, nS, G, c, ksb;
    __device__ void init(int M, int N, int nS_, int kslice, int G_, int c_) { nM = M / BM; nN = N / BM; nS = nS_; G = G_; c = c_; ksb = kslice * 2; }
    __device__ bool next(int i, Unit& u) const {
        const int L = i * G + c; if (L >= nM * nN * nS) return false;
        const int sl = L / (nM * nN), rem = L - sl * (nM * nN); u.pm = rem / nN; u.pn = rem - u.pm * nN; u.kb = sl * ksb; return true;
    }
};
template <class Epi, class Sched>
__device__ __forceinline__ void gemm_phase(LAS unsigned char* lds, const Gemm g, const Sched& S, const Epi& E, const Ids I) {
    const int tid_local = make_tid(I.wv);
    const int tid = TID, wid = __builtin_amdgcn_readfirstlane(tid >> 6), lane = tid & 63, wr = wid >> 2, wc = wid & 3, fr = lane & 15, fq = lane >> 4;
    const int K = g.ld, nt = g.K / BK;
    unsigned voffA[2], voffB[2];
#pragma unroll
    for (int i = 0; i < 2; ++i) { int R, C; stage_rc(tid * 16 + i * 8192, R, C); voffA[i] = (unsigned)(R * K + C) * 2u; voffB[i] = (unsigned)(R * K + C) * 2u; }
    const size_t kstep = (size_t)(BK * 2);
    const size_t hstep = (size_t)HALF * K * 2;
    const size_t tstep = 2 * hstep;
    const unsigned ldsw = (unsigned)wid * 1024u;
    const int aoff = lds_byte(wr * 64 + fr, fq * 8), boff = lds_byte(wc * 32 + fr, fq * 8);
#define PG8_SA(b, h) (((b) * 2 + (h)) * HTB)
#define PG8_SB(b, h) ((4 + (b) * 2 + (h)) * HTB)
#define PG8_STAGE(bufoff, gbase, voff) do { _Pragma("unroll") for (int _i = 0; _i < 2; ++_i) \
        __builtin_amdgcn_global_load_lds((const unsigned*)((const char*)(gbase) + (voff)[_i]), (LAS unsigned*)(lds + (bufoff) + ldsw + _i * 8192), 16, 0, 0); } while (0)
#define PG8_LDA(dst, b, h) do { _Pragma("unroll") for (int m = 0; m < 4; ++m) _Pragma("unroll") for (int k = 0; k < 2; ++k) dst[m][k] = *(const LAS bf16x8*)(lds + PG8_SA(b, h) + aoff + m * 2048 + k * 1024); } while (0)
#define PG8_LDB(dst, b, h) do { _Pragma("unroll") for (int n = 0; n < 2; ++n) _Pragma("unroll") for (int k = 0; k < 2; ++k) dst[n][k] = *(const LAS bf16x8*)(lds + PG8_SB(b, h) + boff + n * 2048 + k * 1024); } while (0)
#define PG8_MMA(ai, bj, At, Bt) do { __builtin_amdgcn_s_setprio(1); _Pragma("unroll") for (int m = 0; m < 4; ++m) _Pragma("unroll") for (int n = 0; n < 2; ++n) _Pragma("unroll") for (int k = 0; k < 2; ++k) \
        acc[ai][bj][m][n] = __builtin_amdgcn_mfma_f32_16x16x32_bf16(Bt[n][k], At[m][k], acc[ai][bj][m][n], 0, 0, 0); __builtin_amdgcn_s_setprio(0); } while (0)
#define PG8_WAIT_V(n) asm volatile("s_waitcnt vmcnt(" #n ")" ::: "memory")
#define PG8_WAIT_L(n) asm volatile("s_waitcnt lgkmcnt(" #n ")" ::: "memory")
#define PG8_BAR __builtin_amdgcn_s_barrier()
#define PG8_SCHED __builtin_amdgcn_sched_barrier(0)
    Unit cur, nxt; int ui = 0;
    if (!S.next(0, cur)) return;
    f32x4 acc[2][2][4][2];
#pragma unroll
    for (int a = 0; a < 2; ++a)
#pragma unroll
        for (int b = 0; b < 2; ++b)
#pragma unroll
            for (int m = 0; m < 4; ++m)
#pragma unroll
                for (int n = 0; n < 2; ++n) acc[a][b][m][n] = (f32x4){0.f, 0.f, 0.f, 0.f};
    bf16x8 At[4][2], B0[2][2], B1[2][2];
    const char* cA = (const char*)g.A + (size_t)cur.pm * tstep + cur.kb; const char* cB = (const char*)g.Bt + (size_t)cur.pn * tstep + cur.kb;
    PG8_STAGE(PG8_SB(0, 0), cB, voffB); PG8_STAGE(PG8_SA(0, 0), cA, voffA); PG8_STAGE(PG8_SB(0, 1), cB + hstep, voffB); PG8_STAGE(PG8_SA(0, 1), cA + hstep, voffA);
    if (wr == 1) PG8_BAR;
    PG8_WAIT_V(4); PG8_BAR;
    PG8_STAGE(PG8_SB(1, 0), cB + kstep, voffB); PG8_STAGE(PG8_SA(1, 0), cA + kstep, voffA); PG8_STAGE(PG8_SB(1, 1), cB + hstep + kstep, voffB);
    PG8_WAIT_V(6); PG8_BAR;
    for (;;) {
        const bool has_next = S.next(ui + 1, nxt);
        const char* nA = has_next ? (const char*)g.A + (size_t)nxt.pm * tstep + nxt.kb : cA; const char* nB = has_next ? (const char*)g.Bt + (size_t)nxt.pn * tstep + nxt.kb : cB;
        for (int t = 0; t < nt; t += 2) {
            const bool last = (t == nt - 2);
            const char* a1 = cA + (size_t)(t + 1) * kstep;
            const char* a2 = last ? nA : cA + (size_t)(t + 2) * kstep; const char* b2 = last ? nB : cB + (size_t)(t + 2) * kstep;
            const char* a3 = a2 + kstep; const char* b3 = b2 + kstep;
            PG8_LDB(B0, 0, 0); PG8_SCHED; PG8_LDA(At, 0, 0); PG8_STAGE(PG8_SA(1, 1), a1 + hstep, voffA);
            PG8_WAIT_L(8); PG8_BAR; PG8_WAIT_L(0); PG8_MMA(0, 0, At, B0); PG8_BAR; PG8_SCHED;
            PG8_LDB(B1, 0, 1); PG8_STAGE(PG8_SB(0, 0), b2, voffB);
            PG8_BAR; PG8_WAIT_L(0); PG8_MMA(0, 1, At, B1); PG8_BAR;
            PG8_LDA(At, 0, 1); PG8_STAGE(PG8_SA(0, 0), a2, voffA);
            PG8_BAR; PG8_WAIT_L(0); PG8_MMA(1, 0, At, B0); PG8_BAR; PG8_SCHED;
            PG8_STAGE(PG8_SB(0, 1), b2 + hstep, voffB);
            PG8_WAIT_V(6); PG8_BAR; PG8_MMA(1, 1, At, B1); PG8_BAR;
            PG8_LDB(B0, 1, 0); PG8_SCHED; PG8_LDA(At, 1, 0); PG8_STAGE(PG8_SA(0, 1), a2 + hstep, voffA);
            PG8_WAIT_L(8); PG8_BAR; PG8_WAIT_L(0); PG8_MMA(0, 0, At, B0); PG8_BAR; PG8_SCHED;
            PG8_LDB(B1, 1, 1); PG8_STAGE(PG8_SB(1, 0), b3, voffB);
            PG8_BAR; PG8_WAIT_L(0); PG8_MMA(0, 1, At, B1); PG8_BAR;
            PG8_LDA(At, 1, 1); PG8_STAGE(PG8_SA(1, 0), a3, voffA);
            PG8_BAR; PG8_WAIT_L(0); PG8_MMA(1, 0, At, B0); PG8_BAR; PG8_SCHED;
            PG8_STAGE(PG8_SB(1, 1), b3 + hstep, voffB);
            PG8_WAIT_V(6); PG8_BAR; PG8_MMA(1, 1, At, B1); PG8_BAR;
        }
        E(acc, cur, wr, wc, fr, fq);
        if (!has_next) break;
#pragma unroll
        for (int a = 0; a < 2; ++a)
#pragma unroll
            for (int b = 0; b < 2; ++b)
#pragma unroll
                for (int m = 0; m < 4; ++m)
#pragma unroll
                    for (int n = 0; n < 2; ++n) acc[a][b][m][n] = (f32x4){0.f, 0.f, 0.f, 0.f};
        cur = nxt; cA = nA; cB = nB; ++ui;
    }
    PG8_WAIT_V(0);
    if (wr == 0) PG8_BAR;
    PG8_BAR;
#undef PG8_SA
#undef PG8_SB
#undef PG8_STAGE
#undef PG8_LDA
#undef PG8_LDB
#undef PG8_MMA
#undef PG8_WAIT_V
#undef PG8_WAIT_L
#undef PG8_BAR
#undef PG8_SCHED
}
}

struct EpiSwiGLU {
    bf16_t* act;
    __device__ __forceinline__ void operator()(const f32x4 (&acc)[2][2][4][2], const pg8::Unit& u, int wr, int wc, int fr, int fq) const {
        const int row0 = u.pm * 256 + wr * 64 + fr, col0 = u.pn * 128 + wc * 32 + 8 * fq;
#pragma unroll
        for (int ai = 0; ai < 2; ++ai)
#pragma unroll
            for (int m = 0; m < 4; ++m) { bf16_t* rowp = act + (size_t)(row0 + ai * 128 + m * 16) * FF + col0; float o[8];
#pragma unroll
                for (int n = 0; n < 2; ++n) { const f32x4 gv = acc[ai][0][m][n], uv = acc[ai][1][m][n];
#pragma unroll
                    for (int j = 0; j < 4; ++j) o[4 * n + j] = gv[j] * sigmoidf(gv[j]) * uv[j]; }
                u32x4 w; w.x = cvt_pk_bf16(o[0], o[1]); w.y = cvt_pk_bf16(o[2], o[3]); w.z = cvt_pk_bf16(o[4], o[5]); w.w = cvt_pk_bf16(o[6], o[7]); *(u32x4*)rowp = w; }
    }
};
struct EpiResid {
    float* x; const float* gate; float scale;
    __device__ __forceinline__ void operator()(const f32x4 (&acc)[2][2][4][2], const pg8::Unit& u, int wr, int wc, int fr, int fq) const {
        const int row0 = u.pm * 256 + wr * 64 + fr, col0 = u.pn * 256 + wc * 32 + 4 * fq; const float* gp = gate + (size_t)((u.pm * 256) >> 11) * 9216 + col0;
        f32x4 gv[2][2];
#pragma unroll
        for (int bj = 0; bj < 2; ++bj)
#pragma unroll
            for (int n = 0; n < 2; ++n) gv[bj][n] = *(const f32x4*)(gp + bj * 128 + n * 16) * scale;
#pragma unroll
        for (int ai = 0; ai < 2; ++ai)
#pragma unroll
            for (int m = 0; m < 4; ++m) { const int row = row0 + ai * 128 + m * 16; float* rowp = x + (size_t)row * D + col0;
#pragma unroll
                for (int bj = 0; bj < 2; ++bj)
#pragma unroll
                    for (int n = 0; n < 2; ++n) { const f32x4 xv = *(const f32x4*)(rowp + bj * 128 + n * 16);
                        *(f32x4*)(rowp + bj * 128 + n * 16) = xv + gv[bj][n] * acc[ai][bj][m][n]; }
                asm volatile("" ::: "memory"); }
    }
};
struct EpiPartial {
    float* part;
    __device__ __forceinline__ void operator()(const f32x4 (&acc)[2][2][4][2], const pg8::Unit& u, int wr, int wc, int fr, int fq) const {
        const int row0 = u.pm * 256 + wr * 64 + fr, col0 = u.pn * 256 + wc * 32 + 4 * fq; float* base = part + (size_t)(u.kb >> 9) * MTS * D;
#pragma unroll
        for (int ai = 0; ai < 2; ++ai)
#pragma unroll
            for (int m = 0; m < 4; ++m) { float* rowp = base + (size_t)(row0 + ai * 128 + m * 16) * D + col0;
#pragma unroll
                for (int bj = 0; bj < 2; ++bj)
#pragma unroll
                    for (int n = 0; n < 2; ++n) *(f32x4*)(rowp + bj * 128 + n * 16) = acc[ai][bj][m][n]; }
    }
};
struct EpiProj {
    bf16_t* o;
    __device__ __forceinline__ void operator()(const f32x4 (&acc)[2][2][4][2], const pg8::Unit& u, int wr, int wc, int fr, int fq) const {
        const int row0 = u.pm * 256 + wr * 64 + fr, col0 = u.pn * 256 + wc * 32 + 8 * fq;
#pragma unroll
        for (int ai = 0; ai < 2; ++ai)
#pragma unroll
            for (int m = 0; m < 4; ++m) { bf16_t* rowp = o + (size_t)(row0 + ai * 128 + m * 16) * INW + col0;
#pragma unroll
                for (int bj = 0; bj < 2; ++bj) { const f32x4 v0 = acc[ai][bj][m][0], v1 = acc[ai][bj][m][1];
                    u32x4 w; w.x = cvt_pk_bf16(v0[0], v0[1]); w.y = cvt_pk_bf16(v0[2], v0[3]); w.z = cvt_pk_bf16(v1[0], v1[1]); w.w = cvt_pk_bf16(v1[2], v1[3]); *(u32x4*)(rowp + bj * 128) = w; } }
    }
};
struct EpiAda {
    float* mod; const float* bias;
    __device__ __forceinline__ void operator()(const f32x4 (&acc)[2][2][4][2], const pg8::Unit& u, int wr, int wc, int fr, int fq) const {
        const int row0 = wr * 64 + fr, colg0 = u.pn * 256 + wc * 32 + 4 * fq; const int l = (u.pn >= 36) ? 1 : 0; const int col0 = colg0 - l * 9216;
#pragma unroll
        for (int ai = 0; ai < 2; ++ai)
#pragma unroll
            for (int m = 0; m < 4; ++m) { const int row = row0 + ai * 128 + m * 16;
                if (row < NMR) { float* rowp = mod + ((size_t)l * NMR + row) * 9216 + col0;
#pragma unroll
                    for (int bj = 0; bj < 2; ++bj)
#pragma unroll
                        for (int n = 0; n < 2; ++n) { const f32x4 bv = *(const f32x4*)(bias + colg0 + bj * 128 + n * 16); *(f32x4*)(rowp + bj * 128 + n * 16) = acc[ai][bj][m][n] + bv; } } }
    }
};
template <class Epi> __device__ __forceinline__ void run_gemm(LAS unsigned char* lds, const bf16_t* A, const bf16_t* Bt, int M, int N, int K, const Epi& E, const Ids I) {
    pg8::Gemm g{A, Bt, M, N, K, K}; pg8::StaticOrder S; S.init(M, N, (int)NB, (int)BID); pg8::gemm_phase<Epi, pg8::StaticOrder>(lds, g, S, E, I);
}
template <class Epi> __device__ __forceinline__ void run_gemm_splitk(LAS unsigned char* lds, const bf16_t* A, const bf16_t* Bt, int M, int N, int K, int kslice, const Epi& E, const Ids I) {
    pg8::Gemm g{A, Bt, M, N, kslice, K}; pg8::SplitOrder S; S.init(M, N, K / kslice, kslice, (int)NB, (int)BID); pg8::gemm_phase<Epi, pg8::SplitOrder>(lds, g, S, E, I);
}

__device__ __forceinline__ void conv_tile4(const float* __restrict__ src, int K, int N, bf16_t* __restrict__ dst, int mode, int u4, LAS float* T, const Ids I) {
    const int tid_local = make_tid(I.wv);
    const int tid = TID; const int tilesN = N >> 6;
    f32x4 v[4][2];
#pragma unroll
    for (int q = 0; q < 4; ++q) { const int u = u4 * 4 + q, tk = u / tilesN, tn = u - tk * tilesN;
#pragma unroll
        for (int i = 0; i < 2; ++i) { const int kk = (tid >> 4) + 32 * i, n4 = (tid & 15) * 4; v[q][i] = *(const f32x4*)(src + (size_t)(tk * 64 + kk) * N + tn * 64 + n4); } }
#pragma unroll
    for (int q = 0; q < 4; ++q)
#pragma unroll
        for (int i = 0; i < 2; ++i) { const int kk = (tid >> 4) + 32 * i, n4 = (tid & 15) * 4; LAS float* Tq = T + q * (64 * 65);
            Tq[(n4 + 0) * 65 + kk] = v[q][i][0]; Tq[(n4 + 1) * 65 + kk] = v[q][i][1]; Tq[(n4 + 2) * 65 + kk] = v[q][i][2]; Tq[(n4 + 3) * 65 + kk] = v[q][i][3]; }
    __syncthreads();
#pragma unroll
    for (int q = 0; q < 4; ++q) { const int u = u4 * 4 + q, tk = u / tilesN, tn = u - tk * tilesN;
        const int n = tid >> 3, k8 = (tid & 7) * 8; const int ng = tn * 64 + n; const int m3 = mode & 3; int dr = (m3 == 0) ? ng : (((ng >> 7) << 8) + (m3 == 2 ? 128 : 0) + (ng & 127));
        if (mode & 4) { const int c = dr & 31; dr = (dr & ~31) + 16 * ((c >> 2) & 1) + 4 * (c >> 3) + (c & 3); }
        const LAS float* tp = T + q * (64 * 65) + n * 65 + k8;
        u32x4 w; w.x = cvt_pk_bf16(tp[0], tp[1]); w.y = cvt_pk_bf16(tp[2], tp[3]); w.z = cvt_pk_bf16(tp[4], tp[5]); w.w = cvt_pk_bf16(tp[6], tp[7]);
        *(u32x4*)(dst + (size_t)dr * K + tk * 64 + k8) = w; }
    __syncthreads();
}
__device__ __forceinline__ void convert_layer(PP P, int l, LAS unsigned char* lds, const Ids I) {
    LAS float* T = (LAS float*)lds; unsigned char* ws = P->ws;
    const size_t wl = (size_t)l * 1024 * 2816;
    for (int u = BID; u < 7 * 176 + 64; u += NB) {
        const int mi = u / 176, uu = u - mi * 176;
        if (mi == 0)      conv_tile4(P->in[I_F1G] + wl, 1024, 2816, (bf16_t*)(ws + WS_WGU1), 5, uu, T, I);
        else if (mi == 1) conv_tile4(P->in[I_F1U] + wl, 1024, 2816, (bf16_t*)(ws + WS_WGU1), 6, uu, T, I);
        else if (mi == 2) conv_tile4(P->in[I_F1D] + wl, 2816, 1024, (bf16_t*)(ws + WS_WD1), 0, uu, T, I);
        else if (mi == 3) conv_tile4(P->in[I_WIN] + wl, 1024, 2816, (bf16_t*)(ws + WS_WIN), 4, uu, T, I);
        else if (mi == 4) conv_tile4(P->in[I_F2G] + wl, 1024, 2816, (bf16_t*)(ws + WS_WGU2), 5, uu, T, I);
        else if (mi == 5) conv_tile4(P->in[I_F2U] + wl, 1024, 2816, (bf16_t*)(ws + WS_WGU2), 6, uu, T, I);
        else if (mi == 6) conv_tile4(P->in[I_F2D] + wl, 2816, 1024, (bf16_t*)(ws + WS_WD2), 0, uu, T, I);
        else              conv_tile4(P->in[I_WOUT] + (size_t)l * 1024 * 1024, 1024, 1024, (bf16_t*)(ws + WS_WOUT), 0, uu, T, I);
    }
}
__device__ __forceinline__ void phase_prologue(PP P, LAS unsigned char* lds, const Ids I) {
    const int tid_local = make_tid(I.wv);
    LAS float* T = (LAS float*)lds;
    for (int u = BID; u < 2 * 576; u += NB) {
        const int l = u / 576, uu = u - l * 576;
        conv_tile4(P->in[I_WADA] + (size_t)l * 1024 * 9216, 1024, 9216, (bf16_t*)(P->ws + WS_R2) + (size_t)l * 9216 * 1024, 0, uu, T, I);
    }
    bf16_t* aada = (bf16_t*)(P->ws + WS_AADA);
    for (int idx = BID * 512 + TID; idx < 256 * 1024; idx += NB * 512) {
        const int row = idx >> 10, col = idx & 1023; float v = 0.f;
        if (row < 8) v = P->in[I_CP][row * 1024 + col]; else if (row < NMR) v = P->in[I_CS][(row - 8) * 1024 + col];
        aada[idx] = f2bf(v * sigmoidf(v));
    }
}

__device__ __forceinline__ void phase_norm(PP P, int l, int which, int nsl, const float* fgate, float fscale, const Ids I) {
    const int tid_local = make_tid(I.wv);
    const int lane = TID & 63, gw = BID * 8 + __builtin_amdgcn_readfirstlane(TID >> 6), nw = NB * 8;
    float* xb = P->out; bf16_t* hb = (bf16_t*)(P->ws + WS_HB);
    const float* gamma = which == 0 ? P->in[I_F1N] + l * 1024 : which == 1 ? P->in[I_MIXN] + l * 1024 : which == 2 ? P->in[I_F2N] + l * 1024 : P->in[I_FN];
    const float* modl = (const float*)(P->ws + WS_MOD) + (size_t)l * NMR * 9216;
    const bool from_in = (which == 0 && l == 0);
    for (int row0 = gw; row0 < MT; row0 += 2 * nw) {
        const int rows[2] = {row0, (row0 + nw < MT) ? row0 + nw : row0};
        f32x4 v[2][4]; float ss[2];
#pragma unroll
        for (int j = 0; j < 2; ++j) { const int row = rows[j];
            const float* xr = from_in ? (row < MTP ? P->in[I_XP] + (size_t)row * D : P->in[I_XS] + (size_t)(row - MTP) * D) : xb + (size_t)row * D;
#pragma unroll
            for (int i = 0; i < 4; ++i) v[j][i] = *(const f32x4*)(xr + lane * 4 + 256 * i);
            if (nsl > 0 && row >= MTP && !(j == 1 && row == row0)) {
                const float* pp = (const float*)(P->ws + WS_R2) + (size_t)(row - MTP) * D + lane * 4; const float* gp = fgate + (size_t)mod_row(row) * 9216 + lane * 4;
#pragma unroll
                for (int i = 0; i < 4; ++i) { f32x4 a = (f32x4){0.f, 0.f, 0.f, 0.f};
                    for (int sl = 0; sl < nsl; ++sl) a += *(const f32x4*)(pp + (size_t)sl * MTS * D + 256 * i);
                    v[j][i] += (*(const f32x4*)(gp + 256 * i) * fscale) * a;
                    if (which != 3) *(f32x4*)(xb + (size_t)row * D + lane * 4 + 256 * i) = v[j][i]; } } }
#pragma unroll
        for (int j = 0; j < 2; ++j) { float a = 0.f;
#pragma unroll
            for (int i = 0; i < 4; ++i) a += v[j][i][0] * v[j][i][0] + v[j][i][1] * v[j][i][1] + v[j][i][2] * v[j][i][2] + v[j][i][3] * v[j][i][3];
            ss[j] = wave_sum(a); }
#pragma unroll
        for (int j = 0; j < 2; ++j) { const int row = rows[j];
            if (j == 1 && row == row0) continue;
            const float rstd = rsqrtf(ss[j] * (1.0f / 1024.0f) + 1e-6f);
            if (which == 3) {
#pragma unroll
                for (int i = 0; i < 4; ++i) { const int col = lane * 4 + 256 * i; const f32x4 g4 = *(const f32x4*)(gamma + col); *(f32x4*)(xb + (size_t)row * D + col) = v[j][i] * rstd * g4; }
            } else {
                const float* mr = modl + (size_t)mod_row(row) * 9216 + which * 3 * 1024;
#pragma unroll
                for (int i = 0; i < 4; ++i) { const int col = lane * 4 + 256 * i; const f32x4 g4 = *(const f32x4*)(gamma + col), sh = *(const f32x4*)(mr + col), sc = *(const f32x4*)(mr + 1024 + col);
                    const f32x4 h = (v[j][i] * rstd * g4) * (sc + 1.0f) + sh; u32x2 w; w.x = cvt_pk_bf16(h[0], h[1]); w.y = cvt_pk_bf16(h[2], h[3]);
                    *(u32x2*)(hb + (size_t)row * D + col) = w;
                    if (from_in) *(f32x4*)(xb + (size_t)row * D + col) = v[j][i]; }
            }
        }
    }
}

__device__ __forceinline__ void phase_m1(PP P, int l, LAS unsigned char* lds, const Ids I) {
    const int tid_local = make_tid(I.wv);
    const int tid = TID; unsigned char* ws = P->ws;
    const bf16_t* PR = (const bf16_t*)(ws + WS_R1);
    bf16_t* arr = (bf16_t*)(ws + WS_R2); const size_t AS = (size_t)MT * 512;
#pragma unroll 1
    for (int rep13 = 0; rep13 < (PROBE == 13 ? 2 : 1); ++rep13)
    {
        LAS float* XC = (LAS float*)lds;
        LAS bf16_t* XB = (LAS bf16_t*)(XC + 64 * 68);
        LAS bf16_t* OB = XB + 64 * 72;
        const int d = tid & 63, tg = tid >> 6, lane = tid & 63, quad = lane >> 4, l15 = lane & 15, wv = __builtin_amdgcn_readfirstlane(tid >> 6), mt = wv & 3, half = wv >> 2;
        bf16x8 bfr[4][2]; float bias4[4], sp4[4];
        for (int u = BID; u < 264 * 8; u += NB) {
            const int tt = u >> 3, n = u & 7, r0 = tt * 64, chg = n * 64 + d;
            if (u == BID || (NB & 7) != 0) {
                const float* wsrc = P->in[half ? I_LWA : I_LWX] + ((size_t)l * 8 + n) * 4096;
#pragma unroll
                for (int nt = 0; nt < 4; ++nt) { const int dd = nt * 16 + l15;
#pragma unroll
                    for (int ks = 0; ks < 2; ++ks) { const float* wp = wsrc + (size_t)(ks * 32 + quad * 8) * 64 + dd; u32x4 pk;
                        pk.x = cvt_pk_bf16(wp[0], wp[64]); pk.y = cvt_pk_bf16(wp[128], wp[192]); pk.z = cvt_pk_bf16(wp[256], wp[320]); pk.w = cvt_pk_bf16(wp[384], wp[448]);
                        bfr[nt][ks] = __builtin_bit_cast(bf16x8, pk); }
                    bias4[nt] = P->in[half ? I_LBA : I_LBX][l * 512 + n * 64 + dd]; sp4[nt] = softplusf(-P->in[I_LAM][l * 512 + n * 64 + dd]); } }
            const float* cw = P->in[I_CONVW] + (size_t)l * 4 * 512; const float cwv[4] = {cw[chg], cw[512 + chg], cw[1024 + chg], cw[1536 + chg]}; const float cb = P->in[I_CONVB][l * 512 + chg];
#pragma unroll
            for (int i = 0; i < 8; ++i) { const int r = r0 + tg * 8 + i, t = t_in_seq(r); float a = cb;
#pragma unroll
                for (int j = 0; j < 4; ++j) { const int ts = t - 3 + j; float xv;
                    if (ts >= 0) xv = bf2f(PR[(size_t)(r - 3 + j) * INW + chg]);
                    else xv = (r < MTP) ? 0.f : P->in[I_SCONV][(((size_t)l * 128 + ((r - MTP) >> 2)) * 3 + (ts + 3)) * 512 + chg];
                    a += xv * cwv[j]; }
                XC[d * 68 + tg * 8 + i] = a; XB[(tg * 8 + i) * 72 + d] = f2bf(a); }
            __syncthreads();
            f32x4 acc[4];
#pragma unroll
            for (int nt = 0; nt < 4; ++nt) acc[nt] = (f32x4){0.f, 0.f, 0.f, 0.f};
#pragma unroll
            for (int ks = 0; ks < 2; ++ks) { const bf16x8 af = *(const LAS bf16x8*)(XB + (mt * 16 + l15) * 72 + ks * 32 + quad * 8);
#pragma unroll
                for (int nt = 0; nt < 4; ++nt) acc[nt] = __builtin_amdgcn_mfma_f32_16x16x32_bf16(af, bfr[nt][ks], acc[nt], 0, 0, 0); }
#pragma unroll
            for (int nt = 0; nt < 4; ++nt) { const int dd = nt * 16 + l15;
#pragma unroll
                for (int j = 0; j < 4; ++j) { const int tok = mt * 16 + quad * 4 + j; const float g = sigmoidf(acc[nt][j] + bias4[nt]);
                    if (half) OB[tok * 64 + dd] = f2bf(-8.0f * g * sp4[nt]);
                    else OB[4096 + tok * 64 + dd] = f2bf(g * XC[dd * 68 + tok]); } }
            __syncthreads();
#pragma unroll
            for (int i = 0; i < 2; ++i) { const int idx = tid + 512 * i, a = idx >> 9, rem = idx & 511, tok = rem >> 3, c8 = (rem & 7) * 8;
                *(u32x4*)(arr + (a == 0 ? A_LA : A_GX) * AS + (size_t)(r0 + tok) * 512 + n * 64 + c8) = *(const LAS u32x4*)(OB + a * 4096 + tok * 64 + c8); }
            __syncthreads();
        }
    }
    {
        LAS bf16_t* XSB = (LAS bf16_t*)lds;
        LAS bf16_t* AL = XSB + 16 * 1536;
        LAS bf16_t* OR = AL + 16 * 136;
        const int lane = tid & 63, quad = lane >> 4, l15 = lane & 15, hd = __builtin_amdgcn_readfirstlane(tid >> 6); const float* mu = P->in[I_MU] + (size_t)l * PW;
        bf16x8 bfw[4][2], bfa[4][2]; float w0v[4], a0v[4], kkv[4], kav[4];
#pragma unroll
        for (int nt = 0; nt < 4; ++nt) { const int dd = hd * 64 + nt * 16 + l15;
            w0v[nt] = P->in[I_W0][l * 512 + dd]; a0v[nt] = P->in[I_A0][l * 512 + dd]; kkv[nt] = P->in[I_KK][l * 512 + dd]; kav[nt] = P->in[I_KA][l * 512 + dd];
#pragma unroll
            for (int ks = 0; ks < 2; ++ks) { const float* wp = P->in[I_W2] + ((size_t)l * 64 + ks * 32 + quad * 8) * 512 + dd; const float* ap = P->in[I_A2] + ((size_t)l * 64 + ks * 32 + quad * 8) * 512 + dd; u32x4 pk;
                pk.x = cvt_pk_bf16(wp[0], wp[512]); pk.y = cvt_pk_bf16(wp[1024], wp[1536]); pk.z = cvt_pk_bf16(wp[2048], wp[2560]); pk.w = cvt_pk_bf16(wp[3072], wp[3584]); bfw[nt][ks] = __builtin_bit_cast(bf16x8, pk);
                pk.x = cvt_pk_bf16(ap[0], ap[512]); pk.y = cvt_pk_bf16(ap[1024], ap[1536]); pk.z = cvt_pk_bf16(ap[2048], ap[2560]); pk.w = cvt_pk_bf16(ap[3072], ap[3584]); bfa[nt][ks] = __builtin_bit_cast(bf16x8, pk); } }
        for (int u = BID; u < MT / 16; u += NB) {
            const int r0 = u * 16;
#pragma unroll
            for (int it = 0; it < 7; ++it) { const int e = tid + 512 * it;
                if (e < 16 * 208) { const int tok = e / 208, col = (e - tok * 208) * 8, r = r0 + tok, t = t_in_seq(r);
                    float cf[8], pf[8]; unpack8(*(const u32x4*)(PR + (size_t)r * INW + 1024 + col), cf);
                    if (t > 0) unpack8(*(const u32x4*)(PR + (size_t)(r - 1) * INW + 1024 + col), pf);
                    else if (r < MTP) {
#pragma unroll
                        for (int j = 0; j < 8; ++j) pf[j] = 0.f; }
                    else { const float* sp = P->in[I_SSHIFT] + ((size_t)l * 128 + ((r - MTP) >> 2)) * PW + col; const f32x4 s0 = *(const f32x4*)sp, s1 = *(const f32x4*)(sp + 4);
#pragma unroll
                        for (int j = 0; j < 4; ++j) { pf[j] = s0[j]; pf[4 + j] = s1[j]; } }
                    const f32x4 m0 = *(const f32x4*)(mu + col), m1 = *(const f32x4*)(mu + col + 4); float xs[8];
#pragma unroll
                    for (int j = 0; j < 4; ++j) { xs[j] = cf[j] + (pf[j] - cf[j]) * m0[j]; xs[4 + j] = cf[4 + j] + (pf[4 + j] - cf[4 + j]) * m1[j]; }
                    if (col >= 1536 && col < 1600) {
#pragma unroll
                        for (int j = 0; j < 8; ++j) xs[j] = tanh_f(xs[j]); }
                    u32x4 w; w.x = cvt_pk_bf16(xs[0], xs[1]); w.y = cvt_pk_bf16(xs[2], xs[3]); w.z = cvt_pk_bf16(xs[4], xs[5]); w.w = cvt_pk_bf16(xs[6], xs[7]);
                    if (col < 1536) *(LAS u32x4*)(XSB + tok * 1536 + col) = w; else *(LAS u32x4*)(AL + tok * 136 + (col - 1536)) = w; } }
            __syncthreads();
            f32x4 aw[4], aa[4];
#pragma unroll
            for (int nt = 0; nt < 4; ++nt) { aw[nt] = (f32x4){0.f, 0.f, 0.f, 0.f}; aa[nt] = (f32x4){0.f, 0.f, 0.f, 0.f}; }
#pragma unroll
            for (int ks = 0; ks < 2; ++ks) { const bf16x8 fw = *(const LAS bf16x8*)(AL + l15 * 136 + ks * 32 + quad * 8), fa = *(const LAS bf16x8*)(AL + l15 * 136 + 64 + ks * 32 + quad * 8);
#pragma unroll
                for (int nt = 0; nt < 4; ++nt) { aw[nt] = __builtin_amdgcn_mfma_f32_16x16x32_bf16(fw, bfw[nt][ks], aw[nt], 0, 0, 0); aa[nt] = __builtin_amdgcn_mfma_f32_16x16x32_bf16(fa, bfa[nt][ks], aa[nt], 0, 0, 0); } }
#pragma unroll
            for (int j = 0; j < 4; ++j) { const int tk = quad * 4 + j; const LAS bf16_t* xp = XSB + tk * 1536 + hd * 64 + l15; float xk[4], ar[4], kk[4]; float ssq = 0.f;
#pragma unroll
                for (int nt = 0; nt < 4; ++nt) { xk[nt] = bf2f(xp[512 + nt * 16]); ar[nt] = sigmoidf(a0v[nt] + aa[nt][j]); kk[nt] = xk[nt] * kkv[nt]; ssq += kk[nt] * kk[nt]; }
                const float rn = 1.0f / fmaxf(sqrtf(row16_allsum(ssq)), 1e-12f);
#pragma unroll
                for (int nt = 0; nt < 4; ++nt) { LAS bf16_t* ob = OR + tk * 512 + hd * 64 + nt * 16 + l15; const float kn = kk[nt] * rn;
                    ob[0] = xp[nt * 16];
                    ob[8192] = f2bf(0.60653066f * sigmoidf(w0v[nt] + aw[nt][j]));
                    ob[2 * 8192] = f2bf(xk[nt] * (1.0f + (ar[nt] - 1.0f) * kav[nt]));
                    ob[3 * 8192] = xp[1024 + nt * 16];
                    ob[4 * 8192] = f2bf(kn); ob[5 * 8192] = f2bf(kn * ar[nt]); } }
            __syncthreads();
#pragma unroll
            for (int i = 0; i < 2; ++i) { const int idx = tid + 512 * i, tok = idx >> 6, c8 = (idx & 63) * 8; const size_t o = (size_t)(r0 + tok) * 512 + c8; const LAS bf16_t* ob = OR + tok * 512 + c8;
                *(u32x4*)(arr + A_R * AS + o) = *(const LAS u32x4*)(ob); *(u32x4*)(arr + A_EW * AS + o) = *(const LAS u32x4*)(ob + 8192); *(u32x4*)(arr + A_KF * AS + o) = *(const LAS u32x4*)(ob + 2 * 8192);
                *(u32x4*)(arr + A_V * AS + o) = *(const LAS u32x4*)(ob + 3 * 8192); *(u32x4*)(arr + A_KK * AS + o) = *(const LAS u32x4*)(ob + 4 * 8192); *(u32x4*)(arr + A_BB * AS + o) = *(const LAS u32x4*)(ob + 5 * 8192); }
        }
        __syncthreads();
    }
    for (int idx = BID * 512 + tid; idx < NMR * 3328; idx += NB * 512) {
        const int m = idx / 3328, e = idx - m * 3328;
        if (e < 1536) { const int j = e >> 9, ch = e & 511; const int row = (m < 8) ? m * 2048 + 2045 + j : MTP + (m - 8) * 4 + 1 + j; const float v = bf2f(PR[(size_t)row * INW + ch]);
            if (m < 8) P->out[O_PCONV + (((size_t)l * 8 + m) * 3 + j) * 512 + ch] = v; else P->out[O_SCONV + (((size_t)l * 128 + (m - 8)) * 3 + j) * 512 + ch] = v; }
        else { const int col = e - 1536; const int row = (m < 8) ? m * 2048 + 2047 : MTP + (m - 8) * 4 + 3; const float v = bf2f(PR[(size_t)row * INW + 1024 + col]);
            if (m < 8) P->out[O_PSHIFT + ((size_t)l * 8 + m) * PW + col] = v; else P->out[O_SSHIFT + ((size_t)l * 128 + (m - 8)) * PW + col] = v; }
    }
}

__device__ __forceinline__ void scan_lru(PP P, int l, LAS unsigned char* lds, const Ids I) {
    const int tid = make_tid(I.wv); unsigned char* ws = P->ws;
    const bf16_t* PR = (const bf16_t*)(ws + WS_R1); const bf16_t* LA = (const bf16_t*)(ws + WS_R2) + (size_t)A_LA * MT * 512; const bf16_t* GX = (const bf16_t*)(ws + WS_R2) + (size_t)A_GX * MT * 512;
    bf16_t* ymix = (bf16_t*)(ws + WS_HB); float* out = P->out;
    for (int g = BID * 512 + tid; g < 128 * 512; g += NB * 512) {
        const int sb = g >> 9, ch = g & 511; float h = P->in[I_SH][(unsigned)(l * 128 + sb) * 512u + ch];
#pragma unroll
        for (unsigned s = 0; s < 4; ++s) { const unsigned row = (unsigned)MTP + sb * 4 + s, o = row * 512u + ch; const float la = bf2f(LA[o]), gx = bf2f(GX[o]); const float a = __expf(la), bb = sqrtf(fmaxf(1.f - a * a, 0.f)) * gx;
            h = a * h + bb; const float gb = bf2f(PR[row * (unsigned)INW + 512u + ch]); ymix[row * 1024u + ch] = f2bf(h * gelu_tanh(gb)); }
        out[O_SH + (unsigned)(l * 128 + sb) * 512u + ch] = h;
    }
}
__device__ __forceinline__ f32x4 unpack4(const u32x2 w) { return (f32x4){__uint_as_float(w[0] << 16), __uint_as_float(w[0] & 0xffff0000u), __uint_as_float(w[1] << 16), __uint_as_float(w[1] & 0xffff0000u)}; }
__device__ __forceinline__ void scan_wkv_sample(PP P, int l, const Ids I) {
    const int tid = make_tid(I.wv), wave = __builtin_amdgcn_readfirstlane(tid >> 6), lane = tid & 63, rowl = lane >> 4, kseg = lane & 15; unsigned char* ws = P->ws;
    const bf16_t* arr = (const bf16_t*)(ws + WS_R2); const unsigned AS = (unsigned)MT * 512u; bf16_t* ymix = (bf16_t*)(ws + WS_HB);
    const float* sin_ = P->in[I_SWKV]; float* out = P->out;
    const int gw = BID * 8 + wave, nw = NB * 8;
    for (int q = gw; q < 128 * 8 * 16; q += nw) {
        const int pair = q >> 4, rgp = q & 15, sb = pair >> 3, h = pair & 7, vrow = rgp * 4 + rowl;
        const unsigned so = ((unsigned)((l * 128 + sb) * 8 + h) * 64u + vrow) * 64u + kseg * 4;
        f32x4 S = *(const f32x4*)(sin_ + so);
        f32x4 r_[4], w_[4], k_[4], a_[4], b_[4]; float v_[4];
#pragma unroll
        for (int s = 0; s < 4; ++s) { const unsigned row = (unsigned)MTP + sb * 4 + s, o = row * 512u + h * 64 + kseg * 4;
            r_[s] = unpack4(*(const u32x2*)(arr + A_R * AS + o)); w_[s] = unpack4(*(const u32x2*)(arr + A_EW * AS + o)); k_[s] = unpack4(*(const u32x2*)(arr + A_KF * AS + o));
            a_[s] = unpack4(*(const u32x2*)(arr + A_KK * AS + o)); b_[s] = unpack4(*(const u32x2*)(arr + A_BB * AS + o)); v_[s] = bf2f(arr[A_V * AS + row * 512u + h * 64 + vrow]); }
#pragma unroll
        for (int s = 0; s < 4; ++s) { const unsigned row = (unsigned)MTP + sb * 4 + s;
            const float p = (S[0] * a_[s][0] + S[1] * a_[s][1]) + (S[2] * a_[s][2] + S[3] * a_[s][3]); const float sa = -row16_allsum(p);
#pragma unroll
            for (int j = 0; j < 4; ++j) S[j] = fmaf(S[j], __expf(-w_[s][j]), fmaf(sa, b_[s][j], v_[s] * k_[s][j]));
            const float y = row16_allsum((S[0] * r_[s][0] + S[1] * r_[s][1]) + (S[2] * r_[s][2] + S[3] * r_[s][3]));
            if (kseg == 0) ymix[row * 1024u + 512u + h * 64 + vrow] = f2bf(y); }
        *(f32x4*)(out + O_SWKV + so) = S;
    }
}
__device__ __forceinline__ float fma_asm(float a, float b, float c) { float d; asm("v_fma_f32 %0, %1, %2, %3" : "=v"(d) : "v"(a), "v"(b), "v"(c)); return d; }
__device__ __forceinline__ float fnma_asm(float a, float b, float c) { float d; asm("v_fma_f32 %0, -%1, %2, %3" : "=v"(d) : "v"(a), "v"(b), "v"(c)); return d; }
__device__ __forceinline__ float mul_asm(float a, float b) { float d; asm("v_mul_f32 %0, %1, %2" : "=v"(d) : "v"(a), "v"(b)); return d; }
__device__ __forceinline__ void scan_wkv_prompt(PP P, int l, LAS unsigned char* lds, const Ids I) {
    const int tid = make_tid(I.wv), wave = __builtin_amdgcn_readfirstlane(tid >> 6), lane = tid & 63, rowl = lane >> 4, kseg = lane & 15; unsigned char* ws = P->ws;
    const bf16_t* arr = (const bf16_t*)(ws + WS_R2); const unsigned AS = (unsigned)MT * 512u; bf16_t* ymix = (bf16_t*)(ws + WS_HB); float* out = P->out;
    LAS float* buf = (LAS float*)lds;
    LAS float* ybuf = buf + 2 * 32 * 336;
    LAS unsigned char* raw = lds + 90112;
#define WKV_BAR() do { asm volatile("s_waitcnt lgkmcnt(0)" ::: "memory"); __builtin_amdgcn_s_barrier(); asm volatile("" ::: "memory"); } while (0)
    for (int u = BID; u < 256; u += NB) {
        const int bh = u >> 2, rg = u & 3, b = bh >> 3, h = bh & 7; const unsigned rowbase = (unsigned)b * 2048u;
        if (wave >= 4) {
            const int lw = wave - 4, lsl = lane >> 3, part = lane & 7, ls = lw * 8 + lsl;
            const bf16_t* g5[5] = {arr + A_R * AS, arr + A_EW * AS, arr + A_KF * AS, arr + A_KK * AS, arr + A_BB * AS};
#define WKV_DMA(cc) do { const unsigned row = rowbase + (unsigned)(cc) * 32u + ls; const unsigned o = row * 512u + h * 64 + part * 8; LAS unsigned char* slot = raw + ((cc) & 1) * 21504 + lw * 1024; \
            _Pragma("unroll") for (int a = 0; a < 5; ++a) __builtin_amdgcn_global_load_lds((const unsigned*)(g5[a] + o), (LAS unsigned*)(slot + a * 4096), 16, 0, 0); \
            __builtin_amdgcn_global_load_lds((const unsigned*)(arr + A_V * AS + row * 512u + h * 64 + rg * 16 + part * 2), (LAS unsigned*)(raw + ((cc) & 1) * 21504 + 20480 + lw * 256), 4, 0, 0); } while (0)
#define WKV_CONVERT(cc) do { const LAS unsigned char* slot = raw + ((cc) & 1) * 21504 + lw * 1024 + lane * 16; LAS float* dp = buf + ((cc) & 1) * (32 * 336) + ls * 336 + part * 8; float f[8]; \
            const u32x4 vr = *(const LAS u32x4*)(slot), vw = *(const LAS u32x4*)(slot + 4096), vk = *(const LAS u32x4*)(slot + 8192), va = *(const LAS u32x4*)(slot + 12288), vb = *(const LAS u32x4*)(slot + 16384); \
            const u32x4 vvv = *(const LAS u32x4*)(raw + ((cc) & 1) * 21504 + 20480 + lw * 256 + lsl * 32 + (part & 1) * 16); \
            unpack8(vr, f); *(LAS f32x4*)(dp) = (f32x4){f[0], f[1], f[2], f[3]}; *(LAS f32x4*)(dp + 4) = (f32x4){f[4], f[5], f[6], f[7]}; \
            unpack8(vw, f); *(LAS f32x4*)(dp + 64) = (f32x4){__expf(-f[0]), __expf(-f[1]), __expf(-f[2]), __expf(-f[3])}; *(LAS f32x4*)(dp + 68) = (f32x4){__expf(-f[4]), __expf(-f[5]), __expf(-f[6]), __expf(-f[7])}; \
            unpack8(vk, f); *(LAS f32x4*)(dp + 128) = (f32x4){f[0], f[1], f[2], f[3]}; *(LAS f32x4*)(dp + 132) = (f32x4){f[4], f[5], f[6], f[7]}; \
            unpack8(va, f); *(LAS f32x4*)(dp + 192) = (f32x4){f[0], f[1], f[2], f[3]}; *(LAS f32x4*)(dp + 196) = (f32x4){f[4], f[5], f[6], f[7]}; \
            unpack8(vb, f); *(LAS f32x4*)(dp + 256) = (f32x4){f[0], f[1], f[2], f[3]}; *(LAS f32x4*)(dp + 260) = (f32x4){f[4], f[5], f[6], f[7]}; \
            if (part < 2) { unpack8(vvv, f); *(LAS f32x4*)(dp + 320) = (f32x4){f[0], f[1], f[2], f[3]}; *(LAS f32x4*)(dp + 324) = (f32x4){f[4], f[5], f[6], f[7]}; } } while (0)
#define WKV_FLUSH(cc) do { const LAS float* yb = ybuf + ((cc) & 1) * 512 + ls * 16 + part * 2; const unsigned row = rowbase + (unsigned)(cc) * 32u + ls - 1u;     \
            if ((cc) > 0 || ls > 0) *(unsigned*)(ymix + row * 1024u + 512u + h * 64 + rg * 16 + part * 2) = cvt_pk_bf16(yb[0], yb[1]); } while (0)
            WKV_DMA(0); WKV_DMA(1);
            asm volatile("s_waitcnt vmcnt(6)" ::: "memory");
            WKV_CONVERT(0);
            LAS f32x2* LAB = (LAS f32x2*)(lds + 133120);
            const bf16_t* LAp = arr + A_LA * AS; const bf16_t* GXp = arr + A_GX * AS; const bf16_t* PRp = (const bf16_t*)(ws + WS_R1);
            const int lck = (tid & 255) >> 4, lcl = tid & 15, lch = (u & 31) * 16 + lcl; const unsigned lrow0 = (unsigned)(u >> 5) * 2048u + (unsigned)lck * 128u;
            float lA = 1.f, lB = 0.f, lh = 0.f;
#pragma unroll 1
            for (int c = 0; c < 64; ++c) {
                WKV_BAR();
                asm volatile("s_waitcnt vmcnt(0)" ::: "memory");
                const unsigned lr = lrow0 + (unsigned)(c & 31) * 4u; bf16_t vla[4], vgx[4], vgb[4];
#pragma unroll
                for (int k = 0; k < 4; ++k) { vla[k] = LAp[(lr + k) * 512u + lch]; vgx[k] = GXp[(lr + k) * 512u + lch]; vgb[k] = PRp[(lr + k) * (unsigned)INW + 512u + lch]; }
                if (c > 0) WKV_FLUSH(c - 1);
                if (c + 2 < 64) WKV_DMA(c + 2);
                if (c + 1 < 64) WKV_CONVERT(c + 1);
                if (c == 32) { for (int q = 0; q < lck; ++q) { const f32x2 ab = LAB[q * 16 + lcl]; lh = ab.x * lh + ab.y; } }
#pragma unroll
                for (int k = 0; k < 4; ++k) { const float la = bf2f(vla[k]), gx = bf2f(vgx[k]); const float a = __expf(la), bb = sqrtf(fmaxf(1.f - a * a, 0.f)) * gx;
                    if (c < 32) { lB = a * lB + bb; lA *= a; }
                    else { lh = a * lh + bb; ymix[(lr + k) * 1024u + lch] = f2bf(lh * gelu_tanh(bf2f(vgb[k]))); } }
                if (c == 31) LAB[lck * 16 + lcl] = (f32x2){lA, lB};
            }
            if (lck == 15) out[O_PH + (unsigned)(l * 8 + (u >> 5)) * 512u + lch] = lh;
            WKV_BAR();
            WKV_FLUSH(63);
            WKV_BAR();
#undef WKV_DMA
#undef WKV_CONVERT
#undef WKV_FLUSH
        } else {
#define DPPA(x, ctl) "v_add_f32_dpp " x ", " x ", " x " " ctl " row_mask:0xf bank_mask:0xf bound_ctrl:1\n\t"
            float S0 = 0.f, S1 = 0.f, S2 = 0.f, S3 = 0.f; f32x4 rp = (f32x4){0.f, 0.f, 0.f, 0.f};
#if PROBE == 11 || PROBE == 12
            float dmy = 0.f, dmy2;
#endif
            __builtin_amdgcn_s_setprio(3);
#pragma unroll 1
            for (int c = 0; c < 64; ++c) {
                WKV_BAR();
                const LAS float* bp = buf + (c & 1) * (32 * 336) + kseg * 4; LAS float* yb = ybuf + (c & 1) * 512; const int vo = 320 + wave * 4 + rowl - kseg * 4;
#define WKV_LDS6(R, W, K, A, B, V, pre, OFF) asm volatile(pre "ds_read_b128 %0, %6 offset:%8\n\tds_read_b128 %1, %6 offset:%9\n\tds_read_b128 %2, %6 offset:%10\n\tds_read_b128 %3, %6 offset:%11\n\tds_read_b128 %4, %6 offset:%12\n\tds_read_b32 %5, %7 offset:%8" \
                    : "=&v"(R), "=&v"(W), "=&v"(K), "=&v"(A), "=&v"(B), "=&v"(V) : "v"(ap), "v"(apv), "i"(OFF), "i"((OFF) + 256), "i"((OFF) + 512), "i"((OFF) + 768), "i"((OFF) + 1024))
                const unsigned ap = (unsigned)(size_t)bp, apv = (unsigned)(size_t)(bp + vo);
                f32x4 r4, w4, k4, a4, b4, nr4, nw4, nk4, na4, nb4; float vv, nvv;
                WKV_LDS6(r4, w4, k4, a4, b4, vv, "", 0);
                WKV_LDS6(nr4, nw4, nk4, na4, nb4, nvv, "", 1344);
                float ykeep = 0.f;
#pragma unroll
                for (int s = 0; s < 32; ++s) {
                    f32x4 mr4 = r4, mw4 = w4, mk4 = k4, ma4 = a4, mb4 = b4; float mvv = vv;
                    if (s < 30) { WKV_LDS6(mr4, mw4, mk4, ma4, mb4, mvv, "s_waitcnt lgkmcnt(6)\n\t", (s + 2) * 1344); }
                    else if (s == 30) asm volatile("s_waitcnt lgkmcnt(6)" ::: "memory");
                    else asm volatile("s_waitcnt lgkmcnt(0)" ::: "memory");
                    __builtin_amdgcn_sched_barrier(0);
                    float sum, y, p1, q1, t0, t1, t2, t3;
                    asm volatile(
                        "v_mul_f32 %0, %8, %12\n\t"  "v_mul_f32 %1, %8, %16\n\t"
                        "v_fma_f32 %0, %9, %13, %0\n\t"  "v_fma_f32 %1, %9, %17, %1\n\t"
                        "v_mul_f32 %2, %10, %14\n\t"  "v_mul_f32 %3, %10, %18\n\t"
                        "v_fma_f32 %2, %11, %15, %2\n\t"  "v_fma_f32 %3, %11, %19, %3\n\t"
                        "v_add_f32 %0, %0, %2\n\t"  "v_add_f32 %1, %1, %3\n\t"
                        "v_mul_f32 %4, %20, %21\n\t"  "v_mul_f32 %5, %20, %22\n\t"
                        DPPA("%0", "quad_perm:[1,0,3,2]") DPPA("%1", "quad_perm:[1,0,3,2]")
                        "v_mul_f32 %6, %20, %23\n\t"
                        DPPA("%0", "quad_perm:[2,3,0,1]") DPPA("%1", "quad_perm:[2,3,0,1]")
                        "v_mul_f32 %7, %20, %24\n\t"
                        DPPA("%0", "row_half_mirror") DPPA("%1", "row_half_mirror")
                        "s_nop 0\n\t"
                        DPPA("%0", "row_mirror") DPPA("%1", "row_mirror")
                        : "=&v"(sum), "=&v"(y), "=&v"(p1), "=&v"(q1), "=&v"(t0), "=&v"(t1), "=&v"(t2), "=&v"(t3)
                        : "v"(S0), "v"(S1), "v"(S2), "v"(S3), "v"(a4[0]), "v"(a4[1]), "v"(a4[2]), "v"(a4[3]), "v"(rp[0]), "v"(rp[1]), "v"(rp[2]), "v"(rp[3]),
                          "v"(vv), "v"(k4[0]), "v"(k4[1]), "v"(k4[2]), "v"(k4[3]));
                    asm volatile(
                        "v_fma_f32 %4, -%8, %9, %4\n\t"  "v_fma_f32 %5, -%8, %10, %5\n\t"  "v_fma_f32 %6, -%8, %11, %6\n\t"  "v_fma_f32 %7, -%8, %12, %7\n\t"
                        "v_fma_f32 %0, %0, %13, %4\n\t"  "v_fma_f32 %1, %1, %14, %5\n\t"  "v_fma_f32 %2, %2, %15, %6\n\t"  "v_fma_f32 %3, %3, %16, %7"
                        : "+v"(S0), "+v"(S1), "+v"(S2), "+v"(S3), "+v"(t0), "+v"(t1), "+v"(t2), "+v"(t3)
                        : "v"(sum), "v"(b4[0]), "v"(b4[1]), "v"(b4[2]), "v"(b4[3]), "v"(w4[0]), "v"(w4[1]), "v"(w4[2]), "v"(w4[3]));
#if PROBE == 11
                    asm volatile(DPPA("%0", "quad_perm:[1,0,3,2]") "v_mov_b32 %1, %0\n\t" DPPA("%0", "quad_perm:[2,3,0,1]") "v_mov_b32 %1, %0\n\t" DPPA("%0", "row_half_mirror") "v_mov_b32 %1, %0\n\t" DPPA("%0", "row_mirror") "v_mov_b32 %1, %0\n\t"
                                 DPPA("%0", "quad_perm:[1,0,3,2]") "v_mov_b32 %1, %0\n\t" DPPA("%0", "quad_perm:[2,3,0,1]") "v_mov_b32 %1, %0\n\t" DPPA("%0", "row_half_mirror") "v_mov_b32 %1, %0\n\t" DPPA("%0", "row_mirror") "v_mov_b32 %1, %0" : "+v"(dmy), "=&v"(dmy2));
#elif PROBE == 12
                    asm volatile("v_add_f32 %0, %0, %0\n\tv_mov_b32 %1, %0\n\tv_add_f32 %0, %0, %0\n\tv_mov_b32 %1, %0\n\tv_add_f32 %0, %0, %0\n\tv_mov_b32 %1, %0\n\tv_add_f32 %0, %0, %0\n\tv_mov_b32 %1, %0\n\t"
                                 "v_add_f32 %0, %0, %0\n\tv_mov_b32 %1, %0\n\tv_add_f32 %0, %0, %0\n\tv_mov_b32 %1, %0\n\tv_add_f32 %0, %0, %0\n\tv_mov_b32 %1, %0\n\tv_add_f32 %0, %0, %0\n\tv_mov_b32 %1, %0" : "+v"(dmy), "=&v"(dmy2));
#endif
                    ykeep = (kseg == (s & 15)) ? y : ykeep;
                    rp = r4; r4 = nr4; w4 = nw4; k4 = nk4; a4 = na4; b4 = nb4; vv = nvv;
                    nr4 = mr4; nw4 = mw4; nk4 = mk4; na4 = ma4; nb4 = mb4; nvv = mvv;
                    __builtin_amdgcn_sched_barrier(0);
                    if ((s & 15) == 15) yb[((s & 16) + kseg) * 16 + wave * 4 + rowl] = ykeep;
                }
            }
            __builtin_amdgcn_s_setprio(0);
            WKV_BAR();
            { const int vrow = rg * 16 + wave * 4 + rowl; *(f32x4*)(out + O_PWKV + ((unsigned)((l * 8 + b) * 8 + h) * 64u + vrow) * 64u + kseg * 4) = (f32x4){S0, S1, S2, S3};
              const float ylast = row16_allsum((S0 * rp[0] + S1 * rp[1]) + (S2 * rp[2] + S3 * rp[3]));
              if (kseg == 0) ymix[(rowbase + 2047u) * 1024u + 512u + h * 64 + vrow] = (bf16_t)(cvt_pk_bf16(ylast, 0.f) & 0xffffu); }
            WKV_BAR();
#undef DPPA
        }
    }
#undef WKV_BAR
}
__device__ __forceinline__ void phase_scan(PP P, int l, LAS unsigned char* lds, const Ids I) {
#pragma unroll 1
    for (int rep = 0; rep < (PROBE == 8 ? 2 : 1); ++rep) scan_lru(P, l, lds, I);
#pragma unroll 1
    for (int rep = 0; rep < (PROBE == 9 ? 2 : 1); ++rep) scan_wkv_sample(P, l, I);
    scan_wkv_prompt(P, l, lds, I);
}

__device__ __forceinline__ void split_pk(float a, float b, unsigned& hi, unsigned& lo) {
    hi = cvt_pk_bf16(a, b); lo = cvt_pk_bf16(a - __uint_as_float(hi << 16), b - __uint_as_float(hi & 0xffff0000u));
}
__device__ __forceinline__ void phase_m2(PP P, int l, LAS unsigned char* lds, const Ids I) {
    const int tid_local = make_tid(I.wv);
    const int tid = TID, d = tid; unsigned char* ws = P->ws;
    const bf16_t* PR = (const bf16_t*)(ws + WS_R1); const bf16_t* arr = (const bf16_t*)(ws + WS_R2); const size_t AS = (size_t)MT * 512;
    bf16_t* ymix = (bf16_t*)(ws + WS_HB);
    LAS bf16_t* SGH = (LAS bf16_t*)lds; LAS bf16_t* SGL = SGH + 16 * 136;
    LAS float* LY = (LAS float*)(SGL + 16 * 136); LAS float* LR = LY + 4096; LAS float* LK = LR + 4096; LAS float* LV = LK + 4096; LAS float* G = LV + 4096;
    const float* mu = P->in[I_MU] + (size_t)l * PW;
    const float lnw = P->in[I_LNW][l * 512 + d], lnb = P->in[I_LNB][l * 512 + d], rk = P->in[I_RK][l * 512 + d];
    const int lane = tid & 63, quad = lane >> 4, l15 = lane & 15, hd = __builtin_amdgcn_readfirstlane(tid >> 6);
    bf16x8 bfh[4][4], bfl[4][4];
#pragma unroll
    for (int nt = 0; nt < 4; ++nt) { const int dd = hd * 64 + nt * 16 + l15;
#pragma unroll
        for (int ks = 0; ks < 4; ++ks) { const float* gp = P->in[I_G2] + ((size_t)l * 128 + ks * 32 + quad * 8) * 512 + dd; unsigned h0, h1, h2, h3, l0, l1, l2, l3;
            split_pk(gp[0], gp[512], h0, l0); split_pk(gp[1024], gp[1536], h1, l1); split_pk(gp[2048], gp[2560], h2, l2); split_pk(gp[3072], gp[3584], h3, l3);
            bfh[nt][ks] = __builtin_bit_cast(bf16x8, (u32x4){h0, h1, h2, h3}); bfl[nt][ks] = __builtin_bit_cast(bf16x8, (u32x4){l0, l1, l2, l3}); } }
    for (int u = BID; u < MT / 8; u += NB) {
        const int r0 = u * 8;
#pragma unroll
        for (int i = 0; i < 2; ++i) { const int idx = tid + 512 * i, tok = idx >> 7, col = idx & 127, r = r0 + tok, t = t_in_seq(r);
            const float cur = bf2f(PR[(size_t)r * INW + 2688 + col]);
            const float prev = t > 0 ? bf2f(PR[(size_t)(r - 1) * INW + 2688 + col]) : (r < MTP ? 0.f : P->in[I_SSHIFT][((size_t)l * 128 + ((r - MTP) >> 2)) * PW + 1664 + col]);
            const float sg = sigmoidf(cur + (prev - cur) * mu[1664 + col]); const bf16_t h = f2bf(sg);
            SGH[tok * 136 + col] = h; SGL[tok * 136 + col] = f2bf(sg - bf2f(h)); SGH[(8 + tok) * 136 + col] = (bf16_t)0; SGL[(8 + tok) * 136 + col] = (bf16_t)0; }
        { const int tok = tid >> 6, c8 = (tid & 63) * 8; const size_t r = (size_t)r0 + tok; float f[8];
            unpack8(*(const u32x4*)(ymix + r * 1024 + 512 + c8), f); *(LAS f32x4*)(LY + tok * 512 + c8) = (f32x4){f[0], f[1], f[2], f[3]}; *(LAS f32x4*)(LY + tok * 512 + c8 + 4) = (f32x4){f[4], f[5], f[6], f[7]};
            unpack8(*(const u32x4*)(arr + A_R * AS + r * 512 + c8), f); *(LAS f32x4*)(LR + tok * 512 + c8) = (f32x4){f[0], f[1], f[2], f[3]}; *(LAS f32x4*)(LR + tok * 512 + c8 + 4) = (f32x4){f[4], f[5], f[6], f[7]};
            unpack8(*(const u32x4*)(arr + A_KF * AS + r * 512 + c8), f); *(LAS f32x4*)(LK + tok * 512 + c8) = (f32x4){f[0], f[1], f[2], f[3]}; *(LAS f32x4*)(LK + tok * 512 + c8 + 4) = (f32x4){f[4], f[5], f[6], f[7]};
            unpack8(*(const u32x4*)(arr + A_V * AS + r * 512 + c8), f); *(LAS f32x4*)(LV + tok * 512 + c8) = (f32x4){f[0], f[1], f[2], f[3]}; *(LAS f32x4*)(LV + tok * 512 + c8 + 4) = (f32x4){f[4], f[5], f[6], f[7]}; }
        __syncthreads();
        { f32x4 ag[4];
#pragma unroll
          for (int nt = 0; nt < 4; ++nt) ag[nt] = (f32x4){0.f, 0.f, 0.f, 0.f};
#pragma unroll
          for (int ks = 0; ks < 4; ++ks) { const bf16x8 fh = *(const LAS bf16x8*)(SGH + l15 * 136 + ks * 32 + quad * 8), fl = *(const LAS bf16x8*)(SGL + l15 * 136 + ks * 32 + quad * 8);
#pragma unroll
              for (int nt = 0; nt < 4; ++nt) { ag[nt] = __builtin_amdgcn_mfma_f32_16x16x32_bf16(fl, bfh[nt][ks], ag[nt], 0, 0, 0); ag[nt] = __builtin_amdgcn_mfma_f32_16x16x32_bf16(fh, bfl[nt][ks], ag[nt], 0, 0, 0);
                  ag[nt] = __builtin_amdgcn_mfma_f32_16x16x32_bf16(fh, bfh[nt][ks], ag[nt], 0, 0, 0); } }
          if (quad < 2) {
#pragma unroll
              for (int nt = 0; nt < 4; ++nt)
#pragma unroll
                  for (int j = 0; j < 4; ++j) G[(quad * 4 + j) * 512 + hd * 64 + nt * 16 + l15] = ag[nt][j]; } }
        __syncthreads();
#pragma unroll 1
        for (int i = 0; i < 8; ++i) { const float y = LY[i * 512 + d], rr = LR[i * 512 + d], kf = LK[i * 512 + d], vv = LV[i * 512 + d], g = G[i * 512 + d];
            const float m = wave_sum(y) * (1.0f / 64.0f), dy = y - m, var = wave_sum(dy * dy) * (1.0f / 64.0f);
            const float yn = dy * rsqrtf(var + 64e-5f) * lnw + lnb;
            const float bs = wave_sum(rr * kf * rk);
            LY[i * 512 + d] = (yn + bs * vv) * g; }
        __syncthreads();
        { const int tok = tid >> 6, c8 = (tid & 63) * 8; const LAS float* lp = LY + tok * 512 + c8; const f32x4 a = *(const LAS f32x4*)lp, b = *(const LAS f32x4*)(lp + 4);
          u32x4 w; w.x = cvt_pk_bf16(a[0], a[1]); w.y = cvt_pk_bf16(a[2], a[3]); w.z = cvt_pk_bf16(b[0], b[1]); w.w = cvt_pk_bf16(b[2], b[3]);
          *(u32x4*)(ymix + ((size_t)r0 + tok) * 1024 + 512 + c8) = w; }
        __syncthreads();
    }
}

#define XB_TMO      128
#define XB_XCNT(j)  (256  + 64 * (j))
#define XB_XSUB(j)  (1280 + 64 * (j))
#define XB_XGEN(j)  (2304 + 64 * (j))
#define XB_TOP      3328
#define XB_TOPGEN   3392
#define XCD_BAR_WORDS 3456
#define XB_SPIN_CAP (1u << 18)
__device__ __forceinline__ unsigned xb_ld(unsigned* p)              { return __hip_atomic_load(p, __ATOMIC_RELAXED, __HIP_MEMORY_SCOPE_AGENT); }
__device__ __forceinline__ unsigned xb_add(unsigned* p, unsigned v) { return __hip_atomic_fetch_add(p, v, __ATOMIC_RELAXED, __HIP_MEMORY_SCOPE_AGENT); }
__device__ __forceinline__ unsigned xb_xcc_id() { return (unsigned)__builtin_amdgcn_s_getreg((3 << 11) | 20) & 0xFu; }
#define XB_SPIN(cond, bar) do { unsigned _sp = 0; while (cond) { __builtin_amdgcn_s_sleep(1); \
    if ((++_sp & 255u) == 0u) { if (xb_ld(&(bar)[XB_TMO])) break; if (_sp > XB_SPIN_CAP) { atomicAdd(&(bar)[XB_TMO], 1u); break; } } } } while (0)
__device__ __forceinline__ void xcd_barrier_complete(unsigned* bar, unsigned x, unsigned G, unsigned& nloc, unsigned& nx) {
    unsigned sum, cnt, mine, sp = 0u;
    for (;;) {
        sum = 0u; cnt = 0u; mine = 0u;
#pragma unroll
        for (unsigned j = 0; j < 16; ++j) { const unsigned c = xb_ld(&bar[XB_XCNT(j)]); sum += c; cnt += (c > 0u) ? 1u : 0u; mine = (j == x) ? c : mine; }
        if (sum == G) break;
        __builtin_amdgcn_s_sleep(1);
        if ((++sp & 255u) == 0u) { if (xb_ld(&bar[XB_TMO])) break; if (sp > XB_SPIN_CAP) { atomicAdd(&bar[XB_TMO], 1u); break; } }
    }
    nloc = mine > 0u ? mine : 1u; nx = cnt > 0u ? cnt : 1u;
}
__device__ __forceinline__ void xcd_barrier(unsigned* bar, volatile LAS unsigned* st, const Ids I) {
    asm volatile("s_waitcnt vmcnt(0)" ::: "memory");
    __syncthreads();
    if (make_tid(I.wv) == 0) {
        const unsigned x = xb_xcc_id();
        __builtin_amdgcn_s_waitcnt(0);
        unsigned nloc = st[0], nx = st[1];
        if (nloc == 0u) { xcd_barrier_complete(bar, x, (unsigned)I.nb, nloc, nx); st[0] = nloc; st[1] = nx; }
        const unsigned old = xb_add(&bar[XB_XSUB(x)], 1u);
        const unsigned gen = old / nloc;
        if (old + 1u == (gen + 1u) * nloc) {
            __builtin_amdgcn_fence(__ATOMIC_RELEASE, "agent");
            asm volatile("s_waitcnt vmcnt(0)" ::: "memory");
            const unsigned og = xb_add(&bar[XB_TOP], 1u);
            const unsigned tg = og / nx;
            if (og + 1u == (tg + 1u) * nx) xb_add(&bar[XB_TOPGEN], 1u);
            else XB_SPIN(xb_ld(&bar[XB_TOPGEN]) == tg, bar);
            __builtin_amdgcn_fence(__ATOMIC_ACQUIRE, "agent");
            xb_add(&bar[XB_XGEN(x)], 1u);
            asm volatile("s_waitcnt vmcnt(0)" ::: "memory");
        } else {
            XB_SPIN(xb_ld(&bar[XB_XGEN(x)]) == gen, bar);
            __builtin_amdgcn_fence(__ATOMIC_ACQUIRE, "agent");
            asm volatile("s_waitcnt vmcnt(0)" ::: "memory");
        }
    }
    __syncthreads();
}

__global__ void __launch_bounds__(512) mega(Params Pval) {
    extern __shared__ __attribute__((aligned(16))) unsigned char lds_raw[];
    LAS unsigned char* lds = (LAS unsigned char*)lds_raw;
    cg::grid_group grid = cg::this_grid();
    const int NSTEP = 2 + 2 * 12 + 1;
    const int wave_s = __builtin_amdgcn_readfirstlane((int)threadIdx.x >> 6);
    {
        volatile LAS unsigned* st0 = (volatile LAS unsigned*)(lds + LDS_MAIN);
        if (threadIdx.x == 0) { st0[0] = 0u; st0[1] = 0u; (void)xb_add(&((unsigned*)Pval.ws)[XB_XCNT(xb_xcc_id())], 1u); }
        __syncthreads();
    }
#pragma unroll 1
    for (int step = 0; step < NSTEP; ++step) {
        Ids I; I.bid = (int)blockIdx.x; I.nb = (int)gridDim.x; int wv = wave_s;
        unsigned long long pv = (unsigned long long)__builtin_amdgcn_kernarg_segment_ptr();
        asm volatile("" : "+s"(wv), "+s"(I.bid), "+s"(I.nb), "+s"(pv));
        I.bid = __builtin_amdgcn_readfirstlane(I.bid); I.nb = __builtin_amdgcn_readfirstlane(I.nb);
        I.wv = __builtin_amdgcn_readfirstlane(wv);
        PP P = (PP)(((unsigned long long)(unsigned)__builtin_amdgcn_readfirstlane((int)(pv >> 32)) << 32) | (unsigned long long)(unsigned)__builtin_amdgcn_readfirstlane((int)pv));
        unsigned char* ws = P->ws;
        const bool mid = (step >= 2 && step < NSTEP - 1);
        const int l = mid ? (step - 2) / 12 : 0, sub = mid ? (step - 2) % 12 : -1;
        int nrep = 1;
#if PROBE == 1
        if (step == 1 || sub == 1 || sub == 4 || sub == 10) nrep = 2;
#elif PROBE == 2
        if (sub == 6) nrep = 2;
#elif PROBE == 3
        if (step == 0 || sub == 0 || sub == 3 || sub == 9 || sub == 5) nrep = 2;
#elif PROBE == 4
        if (step == 0) nrep = 2;
#elif PROBE == 5
        if (sub == 5) nrep = 2;
#elif PROBE == 6
        if (sub == 3 || sub == 9) nrep = 2;
#elif PROBE == 7
        if (step == 1) { for (int e = 0; e < 20; ++e) xcd_barrier((unsigned*)ws, (volatile LAS unsigned*)(lds + LDS_MAIN), I); }
#endif
#pragma unroll 1
        for (int rep = 0; rep < nrep; ++rep) {
        if (step == 0) phase_prologue(P, lds, I);
        else if (step == 1) {
            if (I.nb > 144) { if (I.bid < 72) { EpiAda E{(float*)(ws + WS_MOD), P->in[I_BADA]}; run_gemm(lds, (const bf16_t*)(ws + WS_AADA), (const bf16_t*)(ws + WS_R2), 256, 2 * 9216, 1024, E, I); }
                              else { Ids J = I; J.bid = I.bid - 72; J.nb = I.nb - 72; convert_layer(P, 0, lds, J); } }
            else { EpiAda E{(float*)(ws + WS_MOD), P->in[I_BADA]}; run_gemm(lds, (const bf16_t*)(ws + WS_AADA), (const bf16_t*)(ws + WS_R2), 256, 2 * 9216, 1024, E, I); convert_layer(P, 0, lds, I); } }
        else if (step == NSTEP - 1) phase_norm(P, 0, 3, FF / 256, (const float*)(ws + WS_MOD) + (size_t)1 * NMR * 9216 + 8 * 1024, 0.5f, I);
        else {
            const float* modl = (const float*)(ws + WS_MOD) + (size_t)l * NMR * 9216;
            if (sub == 0 || sub == 3 || sub == 9) {
                if (sub == 0 && l == 1) convert_layer(P, 1, lds, I);
                const int nsl = (sub == 0) ? (l == 1 ? FF / 256 : 0) : (sub == 3 ? FF / 256 : 1024 / 256);
                const float* fg = (sub == 0) ? (const float*)(ws + WS_MOD) + 8 * 1024 : modl + (sub == 3 ? 2 : 5) * 1024;
                phase_norm(P, l, sub == 0 ? 0 : (sub == 3 ? 1 : 2), nsl, fg, sub == 9 ? 1.0f : 0.5f, I);
            } else if (sub == 1 || sub == 10) {
                EpiSwiGLU E{(bf16_t*)(ws + WS_R1)}; run_gemm(lds, (const bf16_t*)(ws + WS_HB), (const bf16_t*)(ws + (sub == 1 ? WS_WGU1 : WS_WGU2)), MT, 2 * FF, 1024, E, I);
            } else if (sub == 2 || sub == 8 || sub == 11) {
                const int gk = sub == 2 ? 2 : (sub == 8 ? 5 : 8);
                const float scl = sub == 8 ? 1.0f : 0.5f; const int Kd = sub == 8 ? 1024 : FF;
                EpiResid E{P->out, modl + gk * 1024, scl};
                const bf16_t* A = (const bf16_t*)(ws + (sub == 8 ? WS_HB : WS_R1)); const bf16_t* Bt = (const bf16_t*)(ws + (sub == 2 ? WS_WD1 : (sub == 8 ? WS_WOUT : WS_WD2)));
                run_gemm(lds, A, Bt, MTP, 1024, Kd, E, I);
                EpiPartial EA{(float*)(ws + WS_R2)};
                run_gemm_splitk(lds, A + (size_t)MTP * Kd, Bt, MTS, 1024, Kd, 256, EA, I);
            } else if (sub == 4) {
                EpiProj E{(bf16_t*)(ws + WS_R1)}; run_gemm(lds, (const bf16_t*)(ws + WS_HB), (const bf16_t*)(ws + WS_WIN), MT, INW, 1024, E, I);
            } else if (sub == 5) phase_m1(P, l, lds, I);
            else if (sub == 6) phase_scan(P, l, lds, I);
            else phase_m2(P, l, lds, I);
        }
        if (step == 0) grid.sync();
        else if (step != NSTEP - 1) xcd_barrier((unsigned*)ws, (volatile LAS unsigned*)(lds + LDS_MAIN), I);
        }
    }
}

extern "C" void kernel_launch(void* const* d_in, const int* in_sizes, int n_in, void* d_out, int out_size, void* d_ws, size_t ws_size, hipStream_t stream) {
    static int grid_blocks = 0;
    if (!grid_blocks) {
        if (n_in != 40 || ws_size < WS_END) { fprintf(stderr, "kernel_launch: need 40 inputs and %zu bytes of workspace; got %d, %zu\n", (size_t)WS_END, n_in, ws_size); grid_blocks = -1; return; }
        int dev = 0, cus = 0, per_cu = 0;
        hipGetDevice(&dev);
        hipDeviceGetAttribute(&cus, hipDeviceAttributeMultiprocessorCount, dev);
        hipFuncSetAttribute((const void*)mega, hipFuncAttributeMaxDynamicSharedMemorySize, LDS_BYTES);
        hipOccupancyMaxActiveBlocksPerMultiprocessor(&per_cu, (const void*)mega, 512, LDS_BYTES);
        if (per_cu < 1) { fprintf(stderr, "kernel_launch: occupancy query says %d blocks per CU\n", per_cu); grid_blocks = -1; return; }
        grid_blocks = cus;
    }
    if (grid_blocks < 0) return;
    Params p{};
    for (int i = 0; i < 40; ++i) p.in[i] = (const float*)d_in[i];
    p.out = (float*)d_out; p.ws = (unsigned char*)d_ws;
    if (hipMemsetAsync(d_ws, 0, 16384, stream) != hipSuccess) { fprintf(stderr, "kernel_launch: memset of the barrier words failed\n"); return; }
    void* args[] = {&p};
    hipError_t e = hipLaunchCooperativeKernel((const void*)mega, dim3(grid_blocks), dim3(512), args, LDS_BYTES, stream);
    if (e != hipSuccess) fprintf(stderr, "cooperative launch failed: %s (grid %d)\n", hipGetErrorString(e), grid_blocks);
}
```

```cpp
#include <hip/hip_runtime.h>
#include <hip/hip_cooperative_groups.h>
#include <cstdio>
namespace cg = cooperative_groups;

#define LAS __attribute__((address_space(3)))
typedef unsigned short bf16_t;
typedef short bf16x8 __attribute__((ext_vector_type(8)));
typedef float f32x4 __attribute__((ext_vector_type(4)));
typedef float f32x2 __attribute__((ext_vector_type(2)));
typedef unsigned u32x4 __attribute__((ext_vector_type(4)));
typedef unsigned u32x2 __attribute__((ext_vector_type(2)));

constexpr int D = 1024, MTP = 16384, MTS = 512, MT = 16896, FF = 2816, INW = 2816, PW = 1792, NMR = 136;
#ifndef PROBE
#define PROBE 0
#endif
constexpr int LDS_MAIN = 155648, LDS_BYTES = LDS_MAIN + 16;
constexpr size_t SZ_WGU = (size_t)5632 * 1024 * 2, SZ_WD = (size_t)1024 * 2816 * 2, SZ_WIN = (size_t)2816 * 1024 * 2, SZ_WOUT = (size_t)1024 * 1024 * 2;
constexpr size_t WS_WGU1 = 16384, WS_WD1 = WS_WGU1 + SZ_WGU, WS_WIN = WS_WD1 + SZ_WD, WS_WOUT = WS_WIN + SZ_WIN, WS_WGU2 = WS_WOUT + SZ_WOUT, WS_WD2 = WS_WGU2 + SZ_WGU;
constexpr size_t WS_MOD = WS_WD2 + SZ_WD, SZ_MOD = (size_t)2 * NMR * 9216 * 4;
constexpr size_t WS_AADA = WS_MOD + SZ_MOD, SZ_AADA = (size_t)256 * 1024 * 2;
constexpr size_t WS_HB = WS_AADA + SZ_AADA, SZ_HB = (size_t)MT * 1024 * 2;
constexpr size_t WS_R1 = WS_HB + SZ_HB, SZ_R1 = (size_t)MT * 2816 * 2;
constexpr size_t WS_R2 = WS_R1 + SZ_R1, SZ_ARR = (size_t)MT * 512 * 2;
constexpr size_t WS_END = WS_R2 + 8 * SZ_ARR;
enum { A_LA = 0, A_GX, A_R, A_EW, A_KF, A_V, A_KK, A_BB };
constexpr size_t O_PCONV = (size_t)MT * 1024, O_PH = O_PCONV + 24576, O_PSHIFT = O_PH + 8192, O_PWKV = O_PSHIFT + 28672, O_SCONV = O_PWKV + 524288,
                 O_SH = O_SCONV + 393216, O_SSHIFT = O_SH + 131072, O_SWKV = O_SSHIFT + 458752;
enum { I_XP = 0, I_XS, I_CP, I_CS, I_SCONV, I_SH, I_SSHIFT, I_SWKV, I_WADA, I_BADA, I_F1N, I_F1G, I_F1U, I_F1D, I_MIXN, I_WIN, I_WOUT, I_CONVW, I_CONVB, I_LWX, I_LBX,
       I_LWA, I_LBA, I_LAM, I_MU, I_W0, I_W2, I_A0, I_A2, I_G2, I_KK, I_KA, I_RK, I_LNW, I_LNB, I_F2N, I_F2G, I_F2U, I_F2D, I_FN };

struct Params { const float* in[40]; float* out; unsigned char* ws; };
typedef const __attribute__((address_space(4))) Params* PP;
struct Ids { int wv, bid, nb; };
__device__ __forceinline__ int make_tid(int wv) { int lane_v; asm volatile("v_mbcnt_lo_u32_b32 %0, -1, 0\n\tv_mbcnt_hi_u32_b32 %0, -1, %0" : "=v"(lane_v)); return wv * 64 + lane_v; }
#define TID tid_local
#define BID (I.bid)
#define NB (I.nb)

__device__ __forceinline__ float bf2f(bf16_t h) { return __uint_as_float((unsigned)h << 16); }
__device__ __forceinline__ unsigned cvt_pk_bf16(float lo, float hi) { unsigned r; asm("v_cvt_pk_bf16_f32 %0, %1, %2" : "=v"(r) : "v"(lo), "v"(hi)); return r; }
__device__ __forceinline__ bf16_t f2bf(float f) { return (bf16_t)(cvt_pk_bf16(f, 0.f) & 0xffffu); }
__device__ __forceinline__ float rcpf(float x) { return __builtin_amdgcn_rcpf(x); }
__device__ __forceinline__ float sigmoidf(float x) { return rcpf(1.0f + __expf(-x)); }
__device__ __forceinline__ float tanh_f(float x) { return 1.0f - 2.0f * rcpf(1.0f + __expf(2.0f * x)); }
__device__ __forceinline__ float gelu_tanh(float x) { const float u = 0.7978845608f * (x + 0.044715f * x * x * x); return 0.5f * x * (1.0f + tanh_f(u)); }
__device__ __forceinline__ float softplusf(float x) { return fmaxf(x, 0.f) + log1pf(__expf(-fabsf(x))); }
template <int CTRL> __device__ __forceinline__ float dpp_mov(float x) {
    return __builtin_bit_cast(float, __builtin_amdgcn_update_dpp(0, __builtin_bit_cast(int, x), CTRL, 0xF, 0xF, true));
}
__device__ __forceinline__ float row16_allsum(float x) {
    x += dpp_mov<0xB1>(x); x += dpp_mov<0x4E>(x); x += dpp_mov<0x141>(x); x += dpp_mov<0x140>(x); return x;
}
__device__ __forceinline__ float wave_sum(float x) {
    x = row16_allsum(x);
    const float a = __builtin_bit_cast(float, __builtin_amdgcn_readlane(__builtin_bit_cast(int, x), 0)), b = __builtin_bit_cast(float, __builtin_amdgcn_readlane(__builtin_bit_cast(int, x), 16)),
                c = __builtin_bit_cast(float, __builtin_amdgcn_readlane(__builtin_bit_cast(int, x), 32)), d = __builtin_bit_cast(float, __builtin_amdgcn_readlane(__builtin_bit_cast(int, x), 48));
    return (a + b) + (c + d);
}
__device__ __forceinline__ void unpack8(const u32x4 w, float (&f)[8]) {
#pragma unroll
    for (int i = 0; i < 4; ++i) { f[2 * i] = __uint_as_float(w[i] << 16); f[2 * i + 1] = __uint_as_float(w[i] & 0xffff0000u); }
}
__device__ __forceinline__ int mod_row(int r) { return r < MTP ? (r >> 11) : 8 + ((r - MTP) >> 2); }
__device__ __forceinline__ int t_in_seq(int r) { return r < MTP ? (r & 2047) : ((r - MTP) & 3); }

namespace pg8 {
constexpr int BM = 256, BK = 64, HALF = 128, HTB = HALF * BK * 2, STAGE_BYTES = 8 * HTB, NXCD = 8, WGM = 8;
__device__ __forceinline__ int lds_byte(int r, int c) { const int st = (r >> 4) * 2 + (c >> 5), rr = r & 15, cc = c & 31, ob = rr * 64 + cc * 2; return st * 1024 + (ob ^ (((ob >> 9) & 1) << 5)); }
__device__ __forceinline__ void stage_rc(int b, int& R, int& C) { const int st = b / 1024, sb = b % 1024, swz = sb ^ (((sb >> 9) & 1) << 5); R = (st >> 1) * 16 + swz / 64; C = (st & 1) * 32 + (swz % 64) / 2; }
struct Unit { int pm, pn, kb; };
struct Gemm { const bf16_t* A; const bf16_t* Bt; int M, N, K, ld; };
struct StaticOrder {
    int nM, nN, nwg, G, c;
    __device__ void init(int M, int N, int G_, int c_) { nM = M / BM; nN = N / BM; nwg = nM * nN; G = G_; c = c_; }
    __device__ bool next(int i, Unit& u) const {
        const long L = (long)i * G + c; if (L >= nwg) return false;
        int wgid = (int)L; { const int q = nwg / NXCD, r = nwg % NXCD, xcd = wgid % NXCD, off = wgid / NXCD; wgid = (xcd < r ? xcd * (q + 1) : r * (q + 1) + (xcd - r) * q) + off; }
        const int nig = WGM * nN, gid = wgid / nig, fm = gid * WGM, gsz = (nM - fm) < WGM ? (nM - fm) : WGM;
        u.pm = fm + ((wgid % nig) % gsz); u.pn = (wgid % nig) / gsz; u.kb = 0; return true;
    }
};
struct SplitOrder {
    int nM, nN, nS, G, c, ksb;
    __device__ void init(int M, int N, int nS_, int kslice, int G_, int c_) { nM = M / BM; nN = N / BM; nS = nS_; G = G_; c = c_; ksb = kslice * 2; }
    __device__ bool next(int i, Unit& u) const {
        const int L = i * G + c; if (L >= nM * nN * nS) return false;
        const int sl = L / (nM * nN), rem = L - sl * (nM * nN); u.pm = rem / nN; u.pn = rem - u.pm * nN; u.kb = sl * ksb; return true;
    }
};
template <class Epi, class Sched>
__device__ __forceinline__ void gemm_phase(LAS unsigned char* lds, const Gemm g, const Sched& S, const Epi& E, const Ids I) {
    const int tid_local = make_tid(I.wv);
    const int tid = TID, wid = __builtin_amdgcn_readfirstlane(tid >> 6), lane = tid & 63, wr = wid >> 2, wc = wid & 3, fr = lane & 15, fq = lane >> 4;
    const int K = g.ld, nt = g.K / BK;
    unsigned voffA[2], voffB[2];
#pragma unroll
    for (int i = 0; i < 2; ++i) { int R, C; stage_rc(tid * 16 + i * 8192, R, C); voffA[i] = (unsigned)(R * K + C) * 2u; voffB[i] = (unsigned)(R * K + C) * 2u; }
    const size_t kstep = (size_t)(BK * 2);
    const size_t hstep = (size_t)HALF * K * 2;
    const size_t tstep = 2 * hstep;
    const unsigned ldsw = (unsigned)wid * 1024u;
    const int aoff = lds_byte(wr * 64 + fr, fq * 8), boff = lds_byte(wc * 32 + fr, fq * 8);
#define PG8_SA(b, h) (((b) * 2 + (h)) * HTB)
#define PG8_SB(b, h) ((4 + (b) * 2 + (h)) * HTB)
#define PG8_STAGE(bufoff, gbase, voff) do { _Pragma("unroll") for (int _i = 0; _i < 2; ++_i) \
        __builtin_amdgcn_global_load_lds((const unsigned*)((const char*)(gbase) + (voff)[_i]), (LAS unsigned*)(lds + (bufoff) + ldsw + _i * 8192), 16, 0, 0); } while (0)
#define PG8_LDA(dst, b, h) do { _Pragma("unroll") for (int m = 0; m < 4; ++m) _Pragma("unroll") for (int k = 0; k < 2; ++k) dst[m][k] = *(const LAS bf16x8*)(lds + PG8_SA(b, h) + aoff + m * 2048 + k * 1024); } while (0)
#define PG8_LDB(dst, b, h) do { _Pragma("unroll") for (int n = 0; n < 2; ++n) _Pragma("unroll") for (int k = 0; k < 2; ++k) dst[n][k] = *(const LAS bf16x8*)(lds + PG8_SB(b, h) + boff + n * 2048 + k * 1024); } while (0)
#define PG8_MMA(ai, bj, At, Bt) do { __builtin_amdgcn_s_setprio(1); _Pragma("unroll") for (int m = 0; m < 4; ++m) _Pragma("unroll") for (int n = 0; n < 2; ++n) _Pragma("unroll") for (int k = 0; k < 2; ++k) \
        acc[ai][bj][m][n] = __builtin_amdgcn_mfma_f32_16x16x32_bf16(Bt[n][k], At[m][k], acc[ai][bj][m][n], 0, 0, 0); __builtin_amdgcn_s_setprio(0); } while (0)
#define PG8_WAIT_V(n) asm volatile("s_waitcnt vmcnt(" #n ")" ::: "memory")
#define PG8_WAIT_L(n) asm volatile("s_waitcnt lgkmcnt(" #n ")" ::: "memory")
#define PG8_BAR __builtin_amdgcn_s_barrier()
#define PG8_SCHED __builtin_amdgcn_sched_barrier(0)
    Unit cur, nxt; int ui = 0;
    if (!S.next(0, cur)) return;
    f32x4 acc[2][2][4][2];
#pragma unroll
    for (int a = 0; a < 2; ++a)
#pragma unroll
        for (int b = 0; b < 2; ++b)
#pragma unroll
            for (int m = 0; m < 4; ++m)
#pragma unroll
                for (int n = 0; n < 2; ++n) acc[a][b][m][n] = (f32x4){0.f, 0.f, 0.f, 0.f};
    bf16x8 At[4][2], B0[2][2], B1[2][2];
    const char* cA = (const char*)g.A + (size_t)cur.pm * tstep + cur.kb; const char* cB = (const char*)g.Bt + (size_t)cur.pn * tstep + cur.kb;
    PG8_STAGE(PG8_SB(0, 0), cB, voffB); PG8_STAGE(PG8_SA(0, 0), cA, voffA); PG8_STAGE(PG8_SB(0, 1), cB + hstep, voffB); PG8_STAGE(PG8_SA(0, 1), cA + hstep, voffA);
    if (wr == 1) PG8_BAR;
    PG8_WAIT_V(4); PG8_BAR;
    PG8_STAGE(PG8_SB(1, 0), cB + kstep, voffB); PG8_STAGE(PG8_SA(1, 0), cA + kstep, voffA); PG8_STAGE(PG8_SB(1, 1), cB + hstep + kstep, voffB);
    PG8_WAIT_V(6); PG8_BAR;
    for (;;) {
        const bool has_next = S.next(ui + 1, nxt);
        const char* nA = has_next ? (const char*)g.A + (size_t)nxt.pm * tstep + nxt.kb : cA; const char* nB = has_next ? (const char*)g.Bt + (size_t)nxt.pn * tstep + nxt.kb : cB;
        for (int t = 0; t < nt; t += 2) {
            const bool last = (t == nt - 2);
            const char* a1 = cA + (size_t)(t + 1) * kstep;
            const char* a2 = last ? nA : cA + (size_t)(t + 2) * kstep; const char* b2 = last ? nB : cB + (size_t)(t + 2) * kstep;
            const char* a3 = a2 + kstep; const char* b3 = b2 + kstep;
            PG8_LDB(B0, 0, 0); PG8_SCHED; PG8_LDA(At, 0, 0); PG8_STAGE(PG8_SA(1, 1), a1 + hstep, voffA);
            PG8_WAIT_L(8); PG8_BAR; PG8_WAIT_L(0); PG8_MMA(0, 0, At, B0); PG8_BAR; PG8_SCHED;
            PG8_LDB(B1, 0, 1); PG8_STAGE(PG8_SB(0, 0), b2, voffB);
            PG8_BAR; PG8_WAIT_L(0); PG8_MMA(0, 1, At, B1); PG8_BAR;
            PG8_LDA(At, 0, 1); PG8_STAGE(PG8_SA(0, 0), a2, voffA);
            PG8_BAR; PG8_WAIT_L(0); PG8_MMA(1, 0, At, B0); PG8_BAR; PG8_SCHED;
            PG8_STAGE(PG8_SB(0, 1), b2 + hstep, voffB);
            PG8_WAIT_V(6); PG8_BAR; PG8_MMA(1, 1, At, B1); PG8_BAR;
            PG8_LDB(B0, 1, 0); PG8_SCHED; PG8_LDA(At, 1, 0); PG8_STAGE(PG8_SA(0, 1), a2 + hstep, voffA);
            PG8_WAIT_L(8); PG8_BAR; PG8_WAIT_L(0); PG8_MMA(0, 0, At, B0); PG8_BAR; PG8_SCHED;
            PG8_LDB(B1, 1, 1); PG8_STAGE(PG8_SB(1, 0), b3, voffB);
            PG8_BAR; PG8_WAIT_L(0); PG8_MMA(0, 1, At, B1); PG8_BAR;
            PG8_LDA(At, 1, 1); PG8_STAGE(PG8_SA(1, 0), a3, voffA);
            PG8_BAR; PG8_WAIT_L(0); PG8_MMA(1, 0, At, B0); PG8_BAR; PG8_SCHED;
            PG8_STAGE(PG8_SB(1, 1), b3 + hstep, voffB);
            PG8_WAIT_V(6); PG8_BAR; PG8_MMA(1, 1, At, B1); PG8_BAR;
        }
        E(acc, cur, wr, wc, fr, fq);
        if (!has_next) break;
#pragma unroll
        for (int a = 0; a < 2; ++a)
#pragma unroll
            for (int b = 0; b < 2; ++b)
#pragma unroll
                for (int m = 0; m < 4; ++m)
#pragma unroll
                    for (int n = 0; n < 2; ++n) acc[a][b][m][n] = (f32x4){0.f, 0.f, 0.f, 0.f};
        cur = nxt; cA = nA; cB = nB; ++ui;
    }
    PG8_WAIT_V(0);
    if (wr == 0) PG8_BAR;
    PG8_BAR;
#undef PG8_SA
#undef PG8_SB
#undef PG8_STAGE
#undef PG8_LDA
#undef PG8_LDB
#undef PG8_MMA
#undef PG8_WAIT_V
#undef PG8_WAIT_L
#undef PG8_BAR
#undef PG8_SCHED
}
}

struct EpiSwiGLU {
    bf16_t* act;
    __device__ __forceinline__ void operator()(const f32x4 (&acc)[2][2][4][2], const pg8::Unit& u, int wr, int wc, int fr, int fq) const {
        const int row0 = u.pm * 256 + wr * 64 + fr, col0 = u.pn * 128 + wc * 32 + 8 * fq;
#pragma unroll
        for (int ai = 0; ai < 2; ++ai)
#pragma unroll
            for (int m = 0; m < 4; ++m) { bf16_t* rowp = act + (size_t)(row0 + ai * 128 + m * 16) * FF + col0; float o[8];
#pragma unroll
                for (int n = 0; n < 2; ++n) { const f32x4 gv = acc[ai][0][m][n], uv = acc[ai][1][m][n];
#pragma unroll
                    for (int j = 0; j < 4; ++j) o[4 * n + j] = gv[j] * sigmoidf(gv[j]) * uv[j]; }
                u32x4 w; w.x = cvt_pk_bf16(o[0], o[1]); w.y = cvt_pk_bf16(o[2], o[3]); w.z = cvt_pk_bf16(o[4], o[5]); w.w = cvt_pk_bf16(o[6], o[7]); *(u32x4*)rowp = w; }
    }
};
struct EpiResid {
    float* x; const float* gate; float scale;
    __device__ __forceinline__ void operator()(const f32x4 (&acc)[2][2][4][2], const pg8::Unit& u, int wr, int wc, int fr, int fq) const {
        const int row0 = u.pm * 256 + wr * 64 + fr, col0 = u.pn * 256 + wc * 32 + 4 * fq; const float* gp = gate + (size_t)((u.pm * 256) >> 11) * 9216 + col0;
        f32x4 gv[2][2];
#pragma unroll
        for (int bj = 0; bj < 2; ++bj)
#pragma unroll
            for (int n = 0; n < 2; ++n) gv[bj][n] = *(const f32x4*)(gp + bj * 128 + n * 16) * scale;
#pragma unroll
        for (int ai = 0; ai < 2; ++ai)
#pragma unroll
            for (int m = 0; m < 4; ++m) { const int row = row0 + ai * 128 + m * 16; float* rowp = x + (size_t)row * D + col0;
#pragma unroll
                for (int bj = 0; bj < 2; ++bj)
#pragma unroll
                    for (int n = 0; n < 2; ++n) { const f32x4 xv = *(const f32x4*)(rowp + bj * 128 + n * 16);
                        *(f32x4*)(rowp + bj * 128 + n * 16) = xv + gv[bj][n] * acc[ai][bj][m][n]; }
                asm volatile("" ::: "memory"); }
    }
};
struct EpiPartial {
    float* part;
    __device__ __forceinline__ void operator()(const f32x4 (&acc)[2][2][4][2], const pg8::Unit& u, int wr, int wc, int fr, int fq) const {
        const int row0 = u.pm * 256 + wr * 64 + fr, col0 = u.pn * 256 + wc * 32 + 4 * fq; float* base = part + (size_t)(u.kb >> 9) * MTS * D;
#pragma unroll
        for (int ai = 0; ai < 2; ++ai)
#pragma unroll
            for (int m = 0; m < 4; ++m) { float* rowp = base + (size_t)(row0 + ai * 128 + m * 16) * D + col0;
#pragma unroll
                for (int bj = 0; bj < 2; ++bj)
#pragma unroll
                    for (int n = 0; n < 2; ++n) *(f32x4*)(rowp + bj * 128 + n * 16) = acc[ai][bj][m][n]; }
    }
};
struct EpiProj {
    bf16_t* o;
    __device__ __forceinline__ void operator()(const f32x4 (&acc)[2][2][4][2], const pg8::Unit& u, int wr, int wc, int fr, int fq) const {
        const int row0 = u.pm * 256 + wr * 64 + fr, col0 = u.pn * 256 + wc * 32 + 8 * fq;
#pragma unroll
        for (int ai = 0; ai < 2; ++ai)
#pragma unroll
            for (int m = 0; m < 4; ++m) { bf16_t* rowp = o + (size_t)(row0 + ai * 128 + m * 16) * INW + col0;
#pragma unroll
                for (int bj = 0; bj < 2; ++bj) { const f32x4 v0 = acc[ai][bj][m][0], v1 = acc[ai][bj][m][1];
                    u32x4 w; w.x = cvt_pk_bf16(v0[0], v0[1]); w.y = cvt_pk_bf16(v0[2], v0[3]); w.z = cvt_pk_bf16(v1[0], v1[1]); w.w = cvt_pk_bf16(v1[2], v1[3]); *(u32x4*)(rowp + bj * 128) = w; } }
    }
};
struct EpiAda {
    float* mod; const float* bias;
    __device__ __forceinline__ void operator()(const f32x4 (&acc)[2][2][4][2], const pg8::Unit& u, int wr, int wc, int fr, int fq) const {
        const int row0 = wr * 64 + fr, colg0 = u.pn * 256 + wc * 32 + 4 * fq; const int l = (u.pn >= 36) ? 1 : 0; const int col0 = colg0 - l * 9216;
#pragma unroll
        for (int ai = 0; ai < 2; ++ai)
#pragma unroll
            for (int m = 0; m < 4; ++m) { const int row = row0 + ai * 128 + m * 16;
                if (row < NMR) { float* rowp = mod + ((size_t)l * NMR + row) * 9216 + col0;
#pragma unroll
                    for (int bj = 0; bj < 2; ++bj)
#pragma unroll
                        for (int n = 0; n < 2; ++n) { const f32x4 bv = *(const f32x4*)(bias + colg0 + bj * 128 + n * 16); *(f32x4*)(rowp + bj * 128 + n * 16) = acc[ai][bj][m][n] + bv; } } }
    }
};
template <class Epi> __device__ __forceinline__ void run_gemm(LAS unsigned char* lds, const bf16_t* A, const bf16_t* Bt, int M, int N, int K, const Epi& E, const Ids I) {
    pg8::Gemm g{A, Bt, M, N, K, K}; pg8::StaticOrder S; S.init(M, N, (int)NB, (int)BID); pg8::gemm_phase<Epi, pg8::StaticOrder>(lds, g, S, E, I);
}
template <class Epi> __device__ __forceinline__ void run_gemm_splitk(LAS unsigned char* lds, const bf16_t* A, const bf16_t* Bt, int M, int N, int K, int kslice, const Epi& E, const Ids I) {
    pg8::Gemm g{A, Bt, M, N, kslice, K}; pg8::SplitOrder S; S.init(M, N, K / kslice, kslice, (int)NB, (int)BID); pg8::gemm_phase<Epi, pg8::SplitOrder>(lds, g, S, E, I);
}

__device__ __forceinline__ void conv_tile4(const float* __restrict__ src, int K, int N, bf16_t* __restrict__ dst, int mode, int u4, LAS float* T, const Ids I) {
    const int tid_local = make_tid(I.wv);
    const int tid = TID; const int tilesN = N >> 6;
    f32x4 v[4][2];
#pragma unroll
    for (int q = 0; q < 4; ++q) { const int u = u4 * 4 + q, tk = u / tilesN, tn = u - tk * tilesN;
#pragma unroll
        for (int i = 0; i < 2; ++i) { const int kk = (tid >> 4) + 32 * i, n4 = (tid & 15) * 4; v[q][i] = *(const f32x4*)(src + (size_t)(tk * 64 + kk) * N + tn * 64 + n4); } }
#pragma unroll
    for (int q = 0; q < 4; ++q)
#pragma unroll
        for (int i = 0; i < 2; ++i) { const int kk = (tid >> 4) + 32 * i, n4 = (tid & 15) * 4; LAS float* Tq = T + q * (64 * 65);
            Tq[(n4 + 0) * 65 + kk] = v[q][i][0]; Tq[(n4 + 1) * 65 + kk] = v[q][i][1]; Tq[(n4 + 2) * 65 + kk] = v[q][i][2]; Tq[(n4 + 3) * 65 + kk] = v[q][i][3]; }
    __syncthreads();
#pragma unroll
    for (int q = 0; q < 4; ++q) { const int u = u4 * 4 + q, tk = u / tilesN, tn = u - tk * tilesN;
        const int n = tid >> 3, k8 = (tid & 7) * 8; const int ng = tn * 64 + n; const int m3 = mode & 3; int dr = (m3 == 0) ? ng : (((ng >> 7) << 8) + (m3 == 2 ? 128 : 0) + (ng & 127));
        if (mode & 4) { const int c = dr & 31; dr = (dr & ~31) + 16 * ((c >> 2) & 1) + 4 * (c >> 3) + (c & 3); }
        const LAS float* tp = T + q * (64 * 65) + n * 65 + k8;
        u32x4 w; w.x = cvt_pk_bf16(tp[0], tp[1]); w.y = cvt_pk_bf16(tp[2], tp[3]); w.z = cvt_pk_bf16(tp[4], tp[5]); w.w = cvt_pk_bf16(tp[6], tp[7]);
        *(u32x4*)(dst + (size_t)dr * K + tk * 64 + k8) = w; }
    __syncthreads();
}
__device__ __forceinline__ void convert_layer(PP P, int l, LAS unsigned char* lds, const Ids I) {
    LAS float* T = (LAS float*)lds; unsigned char* ws = P->ws;
    const size_t wl = (size_t)l * 1024 * 2816;
    for (int u = BID; u < 7 * 176 + 64; u += NB) {
        const int mi = u / 176, uu = u - mi * 176;
        if (mi == 0)      conv_tile4(P->in[I_F1G] + wl, 1024, 2816, (bf16_t*)(ws + WS_WGU1), 5, uu, T, I);
        else if (mi == 1) conv_tile4(P->in[I_F1U] + wl, 1024, 2816, (bf16_t*)(ws + WS_WGU1), 6, uu, T, I);
        else if (mi == 2) conv_tile4(P->in[I_F1D] + wl, 2816, 1024, (bf16_t*)(ws + WS_WD1), 0, uu, T, I);
        else if (mi == 3) conv_tile4(P->in[I_WIN] + wl, 1024, 2816, (bf16_t*)(ws + WS_WIN), 4, uu, T, I);
        else if (mi == 4) conv_tile4(P->in[I_F2G] + wl, 1024, 2816, (bf16_t*)(ws + WS_WGU2), 5, uu, T, I);
        else if (mi == 5) conv_tile4(P->in[I_F2U] + wl, 1024, 2816, (bf16_t*)(ws + WS_WGU2), 6, uu, T, I);
        else if (mi == 6) conv_tile4(P->in[I_F2D] + wl, 2816, 1024, (bf16_t*)(ws + WS_WD2), 0, uu, T, I);
        else              conv_tile4(P->in[I_WOUT] + (size_t)l * 1024 * 1024, 1024, 1024, (bf16_t*)(ws + WS_WOUT), 0, uu, T, I);
    }
}
__device__ __forceinline__ void phase_prologue(PP P, LAS unsigned char* lds, const Ids I) {
    const int tid_local = make_tid(I.wv);
    LAS float* T = (LAS float*)lds;
    for (int u = BID; u < 2 * 576; u += NB) {
        const int l = u / 576, uu = u - l * 576;
        conv_tile4(P->in[I_WADA] + (size_t)l * 1024 * 9216, 1024, 9216, (bf16_t*)(P->ws + WS_R2) + (size_t)l * 9216 * 1024, 0, uu, T, I);
    }
    bf16_t* aada = (bf16_t*)(P->ws + WS_AADA);
    for (int idx = BID * 512 + TID; idx < 256 * 1024; idx += NB * 512) {
        const int row = idx >> 10, col = idx & 1023; float v = 0.f;
        if (row < 8) v = P->in[I_CP][row * 1024 + col]; else if (row < NMR) v = P->in[I_CS][(row - 8) * 1024 + col];
        aada[idx] = f2bf(v * sigmoidf(v));
    }
}

__device__ __forceinline__ void phase_norm(PP P, int l, int which, int nsl, const float* fgate, float fscale, const Ids I) {
    const int tid_local = make_tid(I.wv);
    const int lane = TID & 63, gw = BID * 8 + __builtin_amdgcn_readfirstlane(TID >> 6), nw = NB * 8;
    float* xb = P->out; bf16_t* hb = (bf16_t*)(P->ws + WS_HB);
    const float* gamma = which == 0 ? P->in[I_F1N] + l * 1024 : which == 1 ? P->in[I_MIXN] + l * 1024 : which == 2 ? P->in[I_F2N] + l * 1024 : P->in[I_FN];
    const float* modl = (const float*)(P->ws + WS_MOD) + (size_t)l * NMR * 9216;
    const bool from_in = (which == 0 && l == 0);
    for (int row0 = gw; row0 < MT; row0 += 2 * nw) {
        const int rows[2] = {row0, (row0 + nw < MT) ? row0 + nw : row0};
        f32x4 v[2][4]; float ss[2];
#pragma unroll
        for (int j = 0; j < 2; ++j) { const int row = rows[j];
            const float* xr = from_in ? (row < MTP ? P->in[I_XP] + (size_t)row * D : P->in[I_XS] + (size_t)(row - MTP) * D) : xb + (size_t)row * D;
#pragma unroll
            for (int i = 0; i < 4; ++i) v[j][i] = *(const f32x4*)(xr + lane * 4 + 256 * i);
            if (nsl > 0 && row >= MTP && !(j == 1 && row == row0)) {
                const float* pp = (const float*)(P->ws + WS_R2) + (size_t)(row - MTP) * D + lane * 4; const float* gp = fgate + (size_t)mod_row(row) * 9216 + lane * 4;
#pragma unroll
                for (int i = 0; i < 4; ++i) { f32x4 a = (f32x4){0.f, 0.f, 0.f, 0.f};
                    for (int sl = 0; sl < nsl; ++sl) a += *(const f32x4*)(pp + (size_t)sl * MTS * D + 256 * i);
                    v[j][i] += (*(const f32x4*)(gp + 256 * i) * fscale) * a;
                    if (which != 3) *(f32x4*)(xb + (size_t)row * D + lane * 4 + 256 * i) = v[j][i]; } } }
#pragma unroll
        for (int j = 0; j < 2; ++j) { float a = 0.f;
#pragma unroll
            for (int i = 0; i < 4; ++i) a += v[j][i][0] * v[j][i][0] + v[j][i][1] * v[j][i][1] + v[j][i][2] * v[j][i][2] + v[j][i][3] * v[j][i][3];
            ss[j] = wave_sum(a); }
#pragma unroll
        for (int j = 0; j < 2; ++j) { const int row = rows[j];
            if (j == 1 && row == row0) continue;
            const float rstd = rsqrtf(ss[j] * (1.0f / 1024.0f) + 1e-6f);
            if (which == 3) {
#pragma unroll
                for (int i = 0; i < 4; ++i) { const int col = lane * 4 + 256 * i; const f32x4 g4 = *(const f32x4*)(gamma + col); *(f32x4*)(xb + (size_t)row * D + col) = v[j][i] * rstd * g4; }
            } else {
                const float* mr = modl + (size_t)mod_row(row) * 9216 + which * 3 * 1024;
#pragma unroll
                for (int i = 0; i < 4; ++i) { const int col = lane * 4 + 256 * i; const f32x4 g4 = *(const f32x4*)(gamma + col), sh = *(const f32x4*)(mr + col), sc = *(const f32x4*)(mr + 1024 + col);
                    const f32x4 h = (v[j][i] * rstd * g4) * (sc + 1.0f) + sh; u32x2 w; w.x = cvt_pk_bf16(h[0], h[1]); w.y = cvt_pk_bf16(h[2], h[3]);
                    *(u32x2*)(hb + (size_t)row * D + col) = w;
                    if (from_in) *(f32x4*)(xb + (size_t)row * D + col) = v[j][i]; }
            }
        }
    }
}

__device__ __forceinline__ void phase_m1(PP P, int l, LAS unsigned char* lds, const Ids I) {
    const int tid_local = make_tid(I.wv);
    const int tid = TID; unsigned char* ws = P->ws;
    const bf16_t* PR = (const bf16_t*)(ws + WS_R1);
    bf16_t* arr = (bf16_t*)(ws + WS_R2); const size_t AS = (size_t)MT * 512;
#pragma unroll 1
    for (int rep13 = 0; rep13 < (PROBE == 13 ? 2 : 1); ++rep13)
    {
        LAS float* XC = (LAS float*)lds;
        LAS bf16_t* XB = (LAS bf16_t*)(XC + 64 * 68);
        LAS bf16_t* OB = XB + 64 * 72;
        const int d = tid & 63, tg = tid >> 6, lane = tid & 63, quad = lane >> 4, l15 = lane & 15, wv = __builtin_amdgcn_readfirstlane(tid >> 6), mt = wv & 3, half = wv >> 2;
        bf16x8 bfr[4][2]; float bias4[4], sp4[4];
        for (int u = BID; u < 264 * 8; u += NB) {
            const int tt = u >> 3, n = u & 7, r0 = tt * 64, chg = n * 64 + d;
            if (u == BID || (NB & 7) != 0) {
                const float* wsrc = P->in[half ? I_LWA : I_LWX] + ((size_t)l * 8 + n) * 4096;
#pragma unroll
                for (int nt = 0; nt < 4; ++nt) { const int dd = nt * 16 + l15;
#pragma unroll
                    for (int ks = 0; ks < 2; ++ks) { const float* wp = wsrc + (size_t)(ks * 32 + quad * 8) * 64 + dd; u32x4 pk;
                        pk.x = cvt_pk_bf16(wp[0], wp[64]); pk.y = cvt_pk_bf16(wp[128], wp[192]); pk.z = cvt_pk_bf16(wp[256], wp[320]); pk.w = cvt_pk_bf16(wp[384], wp[448]);
                        bfr[nt][ks] = __builtin_bit_cast(bf16x8, pk); }
                    bias4[nt] = P->in[half ? I_LBA : I_LBX][l * 512 + n * 64 + dd]; sp4[nt] = softplusf(-P->in[I_LAM][l * 512 + n * 64 + dd]); } }
            const float* cw = P->in[I_CONVW] + (size_t)l * 4 * 512; const float cwv[4] = {cw[chg], cw[512 + chg], cw[1024 + chg], cw[1536 + chg]}; const float cb = P->in[I_CONVB][l * 512 + chg];
#pragma unroll
            for (int i = 0; i < 8; ++i) { const int r = r0 + tg * 8 + i, t = t_in_seq(r); float a = cb;
#pragma unroll
                for (int j = 0; j < 4; ++j) { const int ts = t - 3 + j; float xv;
                    if (ts >= 0) xv = bf2f(PR[(size_t)(r - 3 + j) * INW + chg]);
                    else xv = (r < MTP) ? 0.f : P->in[I_SCONV][(((size_t)l * 128 + ((r - MTP) >> 2)) * 3 + (ts + 3)) * 512 + chg];
                    a += xv * cwv[j]; }
                XC[d * 68 + tg * 8 + i] = a; XB[(tg * 8 + i) * 72 + d] = f2bf(a); }
            __syncthreads();
            f32x4 acc[4];
#pragma unroll
            for (int nt = 0; nt < 4; ++nt) acc[nt] = (f32x4){0.f, 0.f, 0.f, 0.f};
#pragma unroll
            for (int ks = 0; ks < 2; ++ks) { const bf16x8 af = *(const LAS bf16x8*)(XB + (mt * 16 + l15) * 72 + ks * 32 + quad * 8);
#pragma unroll
                for (int nt = 0; nt < 4; ++nt) acc[nt] = __builtin_amdgcn_mfma_f32_16x16x32_bf16(af, bfr[nt][ks], acc[nt], 0, 0, 0); }
#pragma unroll
            for (int nt = 0; nt < 4; ++nt) { const int dd = nt * 16 + l15;
#pragma unroll
                for (int j = 0; j < 4; ++j) { const int tok = mt * 16 + quad * 4 + j; const float g = sigmoidf(acc[nt][j] + bias4[nt]);
                    if (half) OB[tok * 64 + dd] = f2bf(-8.0f * g * sp4[nt]);
                    else OB[4096 + tok * 64 + dd] = f2bf(g * XC[dd * 68 + tok]); } }
            __syncthreads();
#pragma unroll
            for (int i = 0; i < 2; ++i) { const int idx = tid + 512 * i, a = idx >> 9, rem = idx & 511, tok = rem >> 3, c8 = (rem & 7) * 8;
                *(u32x4*)(arr + (a == 0 ? A_LA : A_GX) * AS + (size_t)(r0 + tok) * 512 + n * 64 + c8) = *(const LAS u32x4*)(OB + a * 4096 + tok * 64 + c8); }
            __syncthreads();
        }
    }
    {
        LAS bf16_t* XSB = (LAS bf16_t*)lds;
        LAS bf16_t* AL = XSB + 16 * 1536;
        LAS bf16_t* OR = AL + 16 * 136;
        const int lane = tid & 63, quad = lane >> 4, l15 = lane & 15, hd = __builtin_amdgcn_readfirstlane(tid >> 6); const float* mu = P->in[I_MU] + (size_t)l * PW;
        bf16x8 bfw[4][2], bfa[4][2]; float w0v[4], a0v[4], kkv[4], kav[4];
#pragma unroll
        for (int nt = 0; nt < 4; ++nt) { const int dd = hd * 64 + nt * 16 + l15;
            w0v[nt] = P->in[I_W0][l * 512 + dd]; a0v[nt] = P->in[I_A0][l * 512 + dd]; kkv[nt] = P->in[I_KK][l * 512 + dd]; kav[nt] = P->in[I_KA][l * 512 + dd];
#pragma unroll
            for (int ks = 0; ks < 2; ++ks) { const float* wp = P->in[I_W2] + ((size_t)l * 64 + ks * 32 + quad * 8) * 512 + dd; const float* ap = P->in[I_A2] + ((size_t)l * 64 + ks * 32 + quad * 8) * 512 + dd; u32x4 pk;
                pk.x = cvt_pk_bf16(wp[0], wp[512]); pk.y = cvt_pk_bf16(wp[1024], wp[1536]); pk.z = cvt_pk_bf16(wp[2048], wp[2560]); pk.w = cvt_pk_bf16(wp[3072], wp[3584]); bfw[nt][ks] = __builtin_bit_cast(bf16x8, pk);
                pk.x = cvt_pk_bf16(ap[0], ap[512]); pk.y = cvt_pk_bf16(ap[1024], ap[1536]); pk.z = cvt_pk_bf16(ap[2048], ap[2560]); pk.w = cvt_pk_bf16(ap[3072], ap[3584]); bfa[nt][ks] = __builtin_bit_cast(bf16x8, pk); } }
        for (int u = BID; u < MT / 16; u += NB) {
            const int r0 = u * 16;
#pragma unroll
            for (int it = 0; it < 7; ++it) { const int e = tid + 512 * it;
                if (e < 16 * 208) { const int tok = e / 208, col = (e - tok * 208) * 8, r = r0 + tok, t = t_in_seq(r);
                    float cf[8], pf[8]; unpack8(*(const u32x4*)(PR + (size_t)r * INW + 1024 + col), cf);
                    if (t > 0) unpack8(*(const u32x4*)(PR + (size_t)(r - 1) * INW + 1024 + col), pf);
                    else if (r < MTP) {
#pragma unroll
                        for (int j = 0; j < 8; ++j) pf[j] = 0.f; }
                    else { const float* sp = P->in[I_SSHIFT] + ((size_t)l * 128 + ((r - MTP) >> 2)) * PW + col; const f32x4 s0 = *(const f32x4*)sp, s1 = *(const f32x4*)(sp + 4);
#pragma unroll
                        for (int j = 0; j < 4; ++j) { pf[j] = s0[j]; pf[4 + j] = s1[j]; } }
                    const f32x4 m0 = *(const f32x4*)(mu + col), m1 = *(const f32x4*)(mu + col + 4); float xs[8];
#pragma unroll
                    for (int j = 0; j < 4; ++j) { xs[j] = cf[j] + (pf[j] - cf[j]) * m0[j]; xs[4 + j] = cf[4 + j] + (pf[4 + j] - cf[4 + j]) * m1[j]; }
                    if (col >= 1536 && col < 1600) {
#pragma unroll
                        for (int j = 0; j < 8; ++j) xs[j] = tanh_f(xs[j]); }
                    u32x4 w; w.x = cvt_pk_bf16(xs[0], xs[1]); w.y = cvt_pk_bf16(xs[2], xs[3]); w.z = cvt_pk_bf16(xs[4], xs[5]); w.w = cvt_pk_bf16(xs[6], xs[7]);
                    if (col < 1536) *(LAS u32x4*)(XSB + tok * 1536 + col) = w; else *(LAS u32x4*)(AL + tok * 136 + (col - 1536)) = w; } }
            __syncthreads();
            f32x4 aw[4], aa[4];
#pragma unroll
            for (int nt = 0; nt < 4; ++nt) { aw[nt] = (f32x4){0.f, 0.f, 0.f, 0.f}; aa[nt] = (f32x4){0.f, 0.f, 0.f, 0.f}; }
#pragma unroll
            for (int ks = 0; ks < 2; ++ks) { const bf16x8 fw = *(const LAS bf16x8*)(AL + l15 * 136 + ks * 32 + quad * 8), fa = *(const LAS bf16x8*)(AL + l15 * 136 + 64 + ks * 32 + quad * 8);
#pragma unroll
                for (int nt = 0; nt < 4; ++nt) { aw[nt] = __builtin_amdgcn_mfma_f32_16x16x32_bf16(fw, bfw[nt][ks], aw[nt], 0, 0, 0); aa[nt] = __builtin_amdgcn_mfma_f32_16x16x32_bf16(fa, bfa[nt][ks], aa[nt], 0, 0, 0); } }
#pragma unroll
            for (int j = 0; j < 4; ++j) { const int tk = quad * 4 + j; const LAS bf16_t* xp = XSB + tk * 1536 + hd * 64 + l15; float xk[4], ar[4], kk[4]; float ssq = 0.f;
#pragma unroll
                for (int nt = 0; nt < 4; ++nt) { xk[nt] = bf2f(xp[512 + nt * 16]); ar[nt] = sigmoidf(a0v[nt] + aa[nt][j]); kk[nt] = xk[nt] * kkv[nt]; ssq += kk[nt] * kk[nt]; }
                const float rn = 1.0f / fmaxf(sqrtf(row16_allsum(ssq)), 1e-12f);
#pragma unroll
                for (int nt = 0; nt < 4; ++nt) { LAS bf16_t* ob = OR + tk * 512 + hd * 64 + nt * 16 + l15; const float kn = kk[nt] * rn;
                    ob[0] = xp[nt * 16];
                    ob[8192] = f2bf(0.60653066f * sigmoidf(w0v[nt] + aw[nt][j]));
                    ob[2 * 8192] = f2bf(xk[nt] * (1.0f + (ar[nt] - 1.0f) * kav[nt]));
                    ob[3 * 8192] = xp[1024 + nt * 16];
                    ob[4 * 8192] = f2bf(kn); ob[5 * 8192] = f2bf(kn * ar[nt]); } }
            __syncthreads();
#pragma unroll
            for (int i = 0; i < 2; ++i) { const int idx = tid + 512 * i, tok = idx >> 6, c8 = (idx & 63) * 8; const size_t o = (size_t)(r0 + tok) * 512 + c8; const LAS bf16_t* ob = OR + tok * 512 + c8;
                *(u32x4*)(arr + A_R * AS + o) = *(const LAS u32x4*)(ob); *(u32x4*)(arr + A_EW * AS + o) = *(const LAS u32x4*)(ob + 8192); *(u32x4*)(arr + A_KF * AS + o) = *(const LAS u32x4*)(ob + 2 * 8192);
                *(u32x4*)(arr + A_V * AS + o) = *(const LAS u32x4*)(ob + 3 * 8192); *(u32x4*)(arr + A_KK * AS + o) = *(const LAS u32x4*)(ob + 4 * 8192); *(u32x4*)(arr + A_BB * AS + o) = *(const LAS u32x4*)(ob + 5 * 8192); }
        }
        __syncthreads();
    }
    for (int idx = BID * 512 + tid; idx < NMR * 3328; idx += NB * 512) {
        const int m = idx / 3328, e = idx - m * 3328;
        if (e < 1536) { const int j = e >> 9, ch = e & 511; const int row = (m < 8) ? m * 2048 + 2045 + j : MTP + (m - 8) * 4 + 1 + j; const float v = bf2f(PR[(size_t)row * INW + ch]);
            if (m < 8) P->out[O_PCONV + (((size_t)l * 8 + m) * 3 + j) * 512 + ch] = v; else P->out[O_SCONV + (((size_t)l * 128 + (m - 8)) * 3 + j) * 512 + ch] = v; }
        else { const int col = e - 1536; const int row = (m < 8) ? m * 2048 + 2047 : MTP + (m - 8) * 4 + 3; const float v = bf2f(PR[(size_t)row * INW + 1024 + col]);
            if (m < 8) P->out[O_PSHIFT + ((size_t)l * 8 + m) * PW + col] = v; else P->out[O_SSHIFT + ((size_t)l * 128 + (m - 8)) * PW + col] = v; }
    }
}

__device__ __forceinline__ void scan_lru(PP P, int l, LAS unsigned char* lds, const Ids I) {
    const int tid = make_tid(I.wv); unsigned char* ws = P->ws;
    const bf16_t* PR = (const bf16_t*)(ws + WS_R1); const bf16_t* LA = (const bf16_t*)(ws + WS_R2) + (size_t)A_LA * MT * 512; const bf16_t* GX = (const bf16_t*)(ws + WS_R2) + (size_t)A_GX * MT * 512;
    bf16_t* ymix = (bf16_t*)(ws + WS_HB); float* out = P->out;
    for (int g = BID * 512 + tid; g < 128 * 512; g += NB * 512) {
        const int sb = g >> 9, ch = g & 511; float h = P->in[I_SH][(unsigned)(l * 128 + sb) * 512u + ch];
#pragma unroll
        for (unsigned s = 0; s < 4; ++s) { const unsigned row = (unsigned)MTP + sb * 4 + s, o = row * 512u + ch; const float la = bf2f(LA[o]), gx = bf2f(GX[o]); const float a = __expf(la), bb = sqrtf(fmaxf(1.f - a * a, 0.f)) * gx;
            h = a * h + bb; const float gb = bf2f(PR[row * (unsigned)INW + 512u + ch]); ymix[row * 1024u + ch] = f2bf(h * gelu_tanh(gb)); }
        out[O_SH + (unsigned)(l * 128 + sb) * 512u + ch] = h;
    }
}
__device__ __forceinline__ f32x4 unpack4(const u32x2 w) { return (f32x4){__uint_as_float(w[0] << 16), __uint_as_float(w[0] & 0xffff0000u), __uint_as_float(w[1] << 16), __uint_as_float(w[1] & 0xffff0000u)}; }
__device__ __forceinline__ void scan_wkv_sample(PP P, int l, const Ids I) {
    const int tid = make_tid(I.wv), wave = __builtin_amdgcn_readfirstlane(tid >> 6), lane = tid & 63, rowl = lane >> 4, kseg = lane & 15; unsigned char* ws = P->ws;
    const bf16_t* arr = (const bf16_t*)(ws + WS_R2); const unsigned AS = (unsigned)MT * 512u; bf16_t* ymix = (bf16_t*)(ws + WS_HB);
    const float* sin_ = P->in[I_SWKV]; float* out = P->out;
    const int gw = BID * 8 + wave, nw = NB * 8;
    for (int q = gw; q < 128 * 8 * 16; q += nw) {
        const int pair = q >> 4, rgp = q & 15, sb = pair >> 3, h = pair & 7, vrow = rgp * 4 + rowl;
        const unsigned so = ((unsigned)((l * 128 + sb) * 8 + h) * 64u + vrow) * 64u + kseg * 4;
        f32x4 S = *(const f32x4*)(sin_ + so);
        f32x4 r_[4], w_[4], k_[4], a_[4], b_[4]; float v_[4];
#pragma unroll
        for (int s = 0; s < 4; ++s) { const unsigned row = (unsigned)MTP + sb * 4 + s, o = row * 512u + h * 64 + kseg * 4;
            r_[s] = unpack4(*(const u32x2*)(arr + A_R * AS + o)); w_[s] = unpack4(*(const u32x2*)(arr + A_EW * AS + o)); k_[s] = unpack4(*(const u32x2*)(arr + A_KF * AS + o));
            a_[s] = unpack4(*(const u32x2*)(arr + A_KK * AS + o)); b_[s] = unpack4(*(const u32x2*)(arr + A_BB * AS + o)); v_[s] = bf2f(arr[A_V * AS + row * 512u + h * 64 + vrow]); }
#pragma unroll
        for (int s = 0; s < 4; ++s) { const unsigned row = (unsigned)MTP + sb * 4 + s;
            const float p = (S[0] * a_[s][0] + S[1] * a_[s][1]) + (S[2] * a_[s][2] + S[3] * a_[s][3]); const float sa = -row16_allsum(p);
#pragma unroll
            for (int j = 0; j < 4; ++j) S[j] = fmaf(S[j], __expf(-w_[s][j]), fmaf(sa, b_[s][j], v_[s] * k_[s][j]));
            const float y = row16_allsum((S[0] * r_[s][0] + S[1] * r_[s][1]) + (S[2] * r_[s][2] + S[3] * r_[s][3]));
            if (kseg == 0) ymix[row * 1024u + 512u + h * 64 + vrow] = f2bf(y); }
        *(f32x4*)(out + O_SWKV + so) = S;
    }
}
__device__ __forceinline__ float fma_asm(float a, float b, float c) { float d; asm("v_fma_f32 %0, %1, %2, %3" : "=v"(d) : "v"(a), "v"(b), "v"(c)); return d; }
__device__ __forceinline__ float fnma_asm(float a, float b, float c) { float d; asm("v_fma_f32 %0, -%1, %2, %3" : "=v"(d) : "v"(a), "v"(b), "v"(c)); return d; }
__device__ __forceinline__ float mul_asm(float a, float b) { float d; asm("v_mul_f32 %0, %1, %2" : "=v"(d) : "v"(a), "v"(b)); return d; }
__device__ __forceinline__ void scan_wkv_prompt(PP P, int l, LAS unsigned char* lds, const Ids I) {
    const int tid = make_tid(I.wv), wave = __builtin_amdgcn_readfirstlane(tid >> 6), lane = tid & 63, rowl = lane >> 4, kseg = lane & 15; unsigned char* ws = P->ws;
    const bf16_t* arr = (const bf16_t*)(ws + WS_R2); const unsigned AS = (unsigned)MT * 512u; bf16_t* ymix = (bf16_t*)(ws + WS_HB); float* out = P->out;
    LAS float* buf = (LAS float*)lds;
    LAS float* ybuf = buf + 2 * 32 * 336;
    LAS unsigned char* raw = lds + 90112;
#define WKV_BAR() do { asm volatile("s_waitcnt lgkmcnt(0)" ::: "memory"); __builtin_amdgcn_s_barrier(); asm volatile("" ::: "memory"); } while (0)
    for (int u = BID; u < 256; u += NB) {
        const int bh = u >> 2, rg = u & 3, b = bh >> 3, h = bh & 7; const unsigned rowbase = (unsigned)b * 2048u;
        if (wave >= 4) {
            const int lw = wave - 4, lsl = lane >> 3, part = lane & 7, ls = lw * 8 + lsl;
            const bf16_t* g5[5] = {arr + A_R * AS, arr + A_EW * AS, arr + A_KF * AS, arr + A_KK * AS, arr + A_BB * AS};
#define WKV_DMA(cc) do { const unsigned row = rowbase + (unsigned)(cc) * 32u + ls; const unsigned o = row * 512u + h * 64 + part * 8; LAS unsigned char* slot = raw + ((cc) & 1) * 21504 + lw * 1024; \
            _Pragma("unroll") for (int a = 0; a < 5; ++a) __builtin_amdgcn_global_load_lds((const unsigned*)(g5[a] + o), (LAS unsigned*)(slot + a * 4096), 16, 0, 0); \
            __builtin_amdgcn_global_load_lds((const unsigned*)(arr + A_V * AS + row * 512u + h * 64 + rg * 16 + part * 2), (LAS unsigned*)(raw + ((cc) & 1) * 21504 + 20480 + lw * 256), 4, 0, 0); } while (0)
#define WKV_CONVERT(cc) do { const LAS unsigned char* slot = raw + ((cc) & 1) * 21504 + lw * 1024 + lane * 16; LAS float* dp = buf + ((cc) & 1) * (32 * 336) + ls * 336 + part * 8; float f[8]; \
            const u32x4 vr = *(const LAS u32x4*)(slot), vw = *(const LAS u32x4*)(slot + 4096), vk = *(const LAS u32x4*)(slot + 8192), va = *(const LAS u32x4*)(slot + 12288), vb = *(const LAS u32x4*)(slot + 16384); \
            const u32x4 vvv = *(const LAS u32x4*)(raw + ((cc) & 1) * 21504 + 20480 + lw * 256 + lsl * 32 + (part & 1) * 16); \
            unpack8(vr, f); *(LAS f32x4*)(dp) = (f32x4){f[0], f[1], f[2], f[3]}; *(LAS f32x4*)(dp + 4) = (f32x4){f[4], f[5], f[6], f[7]}; \
            unpack8(vw, f); *(LAS f32x4*)(dp + 64) = (f32x4){__expf(-f[0]), __expf(-f[1]), __expf(-f[2]), __expf(-f[3])}; *(LAS f32x4*)(dp + 68) = (f32x4){__expf(-f[4]), __expf(-f[5]), __expf(-f[6]), __expf(-f[7])}; \
            unpack8(vk, f); *(LAS f32x4*)(dp + 128) = (f32x4){f[0], f[1], f[2], f[3]}; *(LAS f32x4*)(dp + 132) = (f32x4){f[4], f[5], f[6], f[7]}; \
            unpack8(va, f); *(LAS f32x4*)(dp + 192) = (f32x4){f[0], f[1], f[2], f[3]}; *(LAS f32x4*)(dp + 196) = (f32x4){f[4], f[5], f[6], f[7]}; \
            unpack8(vb, f); *(LAS f32x4*)(dp + 256) = (f32x4){f[0], f[1], f[2], f[3]}; *(LAS f32x4*)(dp + 260) = (f32x4){f[4], f[5], f[6], f[7]}; \
            if (part < 2) { unpack8(vvv, f); *(LAS f32x4*)(dp + 320) = (f32x4){f[0], f[1], f[2], f[3]}; *(LAS f32x4*)(dp + 324) = (f32x4){f[4], f[5], f[6], f[7]}; } } while (0)
#define WKV_FLUSH(cc) do { const LAS float* yb = ybuf + ((cc) & 1) * 512 + ls * 16 + part * 2; const unsigned row = rowbase + (unsigned)(cc) * 32u + ls - 1u;     \
            if ((cc) > 0 || ls > 0) *(unsigned*)(ymix + row * 1024u + 512u + h * 64 + rg * 16 + part * 2) = cvt_pk_bf16(yb[0], yb[1]); } while (0)
            WKV_DMA(0); WKV_DMA(1);
            asm volatile("s_waitcnt vmcnt(6)" ::: "memory");
            WKV_CONVERT(0);
            LAS f32x2* LAB = (LAS f32x2*)(lds + 133120);
            const bf16_t* LAp = arr + A_LA * AS; const bf16_t* GXp = arr + A_GX * AS; const bf16_t* PRp = (const bf16_t*)(ws + WS_R1);
            const int lck = (tid & 255) >> 4, lcl = tid & 15, lch = (u & 31) * 16 + lcl; const unsigned lrow0 = (unsigned)(u >> 5) * 2048u + (unsigned)lck * 128u;
            float lA = 1.f, lB = 0.f, lh = 0.f;
#pragma unroll 1
            for (int c = 0; c < 64; ++c) {
                WKV_BAR();
                asm volatile("s_waitcnt vmcnt(0)" ::: "memory");
                const unsigned lr = lrow0 + (unsigned)(c & 31) * 4u; bf16_t vla[4], vgx[4], vgb[4];
#pragma unroll
                for (int k = 0; k < 4; ++k) { vla[k] = LAp[(lr + k) * 512u + lch]; vgx[k] = GXp[(lr + k) * 512u + lch]; vgb[k] = PRp[(lr + k) * (unsigned)INW + 512u + lch]; }
                if (c > 0) WKV_FLUSH(c - 1);
                if (c + 2 < 64) WKV_DMA(c + 2);
                if (c + 1 < 64) WKV_CONVERT(c + 1);
                if (c == 32) { for (int q = 0; q < lck; ++q) { const f32x2 ab = LAB[q * 16 + lcl]; lh = ab.x * lh + ab.y; } }
#pragma unroll
                for (int k = 0; k < 4; ++k) { const float la = bf2f(vla[k]), gx = bf2f(vgx[k]); const float a = __expf(la), bb = sqrtf(fmaxf(1.f - a * a, 0.f)) * gx;
                    if (c < 32) { lB = a * lB + bb; lA *= a; }
                    else { lh = a * lh + bb; ymix[(lr + k) * 1024u + lch] = f2bf(lh * gelu_tanh(bf2f(vgb[k]))); } }
                if (c == 31) LAB[lck * 16 + lcl] = (f32x2){lA, lB};
            }
            if (lck == 15) out[O_PH + (unsigned)(l * 8 + (u >> 5)) * 512u + lch] = lh;
            WKV_BAR();
            WKV_FLUSH(63);
            WKV_BAR();
#undef WKV_DMA
#undef WKV_CONVERT
#undef WKV_FLUSH
        } else {
#define DPPA(x, ctl) "v_add_f32_dpp " x ", " x ", " x " " ctl " row_mask:0xf bank_mask:0xf bound_ctrl:1\n\t"
            float S0 = 0.f, S1 = 0.f, S2 = 0.f, S3 = 0.f; f32x4 rp = (f32x4){0.f, 0.f, 0.f, 0.f};
#if PROBE == 11 || PROBE == 12
            float dmy = 0.f, dmy2;
#endif
            __builtin_amdgcn_s_setprio(3);
#pragma unroll 1
            for (int c = 0; c < 64; ++c) {
                WKV_BAR();
                const LAS float* bp = buf + (c & 1) * (32 * 336) + kseg * 4; LAS float* yb = ybuf + (c & 1) * 512; const int vo = 320 + wave * 4 + rowl - kseg * 4;
#define WKV_LDS6(R, W, K, A, B, V, pre, OFF) asm volatile(pre "ds_read_b128 %0, %6 offset:%8\n\tds_read_b128 %1, %6 offset:%9\n\tds_read_b128 %2, %6 offset:%10\n\tds_read_b128 %3, %6 offset:%11\n\tds_read_b128 %4, %6 offset:%12\n\tds_read_b32 %5, %7 offset:%8" \
                    : "=&v"(R), "=&v"(W), "=&v"(K), "=&v"(A), "=&v"(B), "=&v"(V) : "v"(ap), "v"(apv), "i"(OFF), "i"((OFF) + 256), "i"((OFF) + 512), "i"((OFF) + 768), "i"((OFF) + 1024))
                const unsigned ap = (unsigned)(size_t)bp, apv = (unsigned)(size_t)(bp + vo);
                f32x4 r4, w4, k4, a4, b4, nr4, nw4, nk4, na4, nb4; float vv, nvv;
                WKV_LDS6(r4, w4, k4, a4, b4, vv, "", 0);
                WKV_LDS6(nr4, nw4, nk4, na4, nb4, nvv, "", 1344);
                float ykeep = 0.f;
#pragma unroll
                for (int s = 0; s < 32; ++s) {
                    f32x4 mr4 = r4, mw4 = w4, mk4 = k4, ma4 = a4, mb4 = b4; float mvv = vv;
                    if (s < 30) { WKV_LDS6(mr4, mw4, mk4, ma4, mb4, mvv, "s_waitcnt lgkmcnt(6)\n\t", (s + 2) * 1344); }
                    else if (s == 30) asm volatile("s_waitcnt lgkmcnt(6)" ::: "memory");
                    else asm volatile("s_waitcnt lgkmcnt(0)" ::: "memory");
                    __builtin_amdgcn_sched_barrier(0);
                    float sum, y, p1, q1, t0, t1, t2, t3;
                    asm volatile(
                        "v_mul_f32 %0, %8, %12\n\t"  "v_mul_f32 %1, %8, %16\n\t"
                        "v_fma_f32 %0, %9, %13, %0\n\t"  "v_fma_f32 %1, %9, %17, %1\n\t"
                        "v_mul_f32 %2, %10, %14\n\t"  "v_mul_f32 %3, %10, %18\n\t"
                        "v_fma_f32 %2, %11, %15, %2\n\t"  "v_fma_f32 %3, %11, %19, %3\n\t"
                        "v_add_f32 %0, %0, %2\n\t"  "v_add_f32 %1, %1, %3\n\t"
                        "v_mul_f32 %4, %20, %21\n\t"  "v_mul_f32 %5, %20, %22\n\t"
                        DPPA("%0", "quad_perm:[1,0,3,2]") DPPA("%1", "quad_perm:[1,0,3,2]")
                        "v_mul_f32 %6, %20, %23\n\t"
                        DPPA("%0", "quad_perm:[2,3,0,1]") DPPA("%1", "quad_perm:[2,3,0,1]")
                        "v_mul_f32 %7, %20, %24\n\t"
                        DPPA("%0", "row_half_mirror") DPPA("%1", "row_half_mirror")
                        "s_nop 0\n\t"
                        DPPA("%0", "row_mirror") DPPA("%1", "row_mirror")
                        : "=&v"(sum), "=&v"(y), "=&v"(p1), "=&v"(q1), "=&v"(t0), "=&v"(t1), "=&v"(t2), "=&v"(t3)
                        : "v"(S0), "v"(S1), "v"(S2), "v"(S3), "v"(a4[0]), "v"(a4[1]), "v"(a4[2]), "v"(a4[3]), "v"(rp[0]), "v"(rp[1]), "v"(rp[2]), "v"(rp[3]),
                          "v"(vv), "v"(k4[0]), "v"(k4[1]), "v"(k4[2]), "v"(k4[3]));
                    asm volatile(
                        "v_fma_f32 %4, -%8, %9, %4\n\t"  "v_fma_f32 %5, -%8, %10, %5\n\t"  "v_fma_f32 %6, -%8, %11, %6\n\t"  "v_fma_f32 %7, -%8, %12, %7\n\t"
                        "v_fma_f32 %0, %0, %13, %4\n\t"  "v_fma_f32 %1, %1, %14, %5\n\t"  "v_fma_f32 %2, %2, %15, %6\n\t"  "v_fma_f32 %3, %3, %16, %7"
                        : "+v"(S0), "+v"(S1), "+v"(S2), "+v"(S3), "+v"(t0), "+v"(t1), "+v"(t2), "+v"(t3)
                        : "v"(sum), "v"(b4[0]), "v"(b4[1]), "v"(b4[2]), "v"(b4[3]), "v"(w4[0]), "v"(w4[1]), "v"(w4[2]), "v"(w4[3]));
#if PROBE == 11
                    asm volatile(DPPA("%0", "quad_perm:[1,0,3,2]") "v_mov_b32 %1, %0\n\t" DPPA("%0", "quad_perm:[2,3,0,1]") "v_mov_b32 %1, %0\n\t" DPPA("%0", "row_half_mirror") "v_mov_b32 %1, %0\n\t" DPPA("%0", "row_mirror") "v_mov_b32 %1, %0\n\t"
                                 DPPA("%0", "quad_perm:[1,0,3,2]") "v_mov_b32 %1, %0\n\t" DPPA("%0", "quad_perm:[2,3,0,1]") "v_mov_b32 %1, %0\n\t" DPPA("%0", "row_half_mirror") "v_mov_b32 %1, %0\n\t" DPPA("%0", "row_mirror") "v_mov_b32 %1, %0" : "+v"(dmy), "=&v"(dmy2));
#elif PROBE == 12
                    asm volatile("v_add_f32 %0, %0, %0\n\tv_mov_b32 %1, %0\n\tv_add_f32 %0, %0, %0\n\tv_mov_b32 %1, %0\n\tv_add_f32 %0, %0, %0\n\tv_mov_b32 %1, %0\n\tv_add_f32 %0, %0, %0\n\tv_mov_b32 %1, %0\n\t"
                                 "v_add_f32 %0, %0, %0\n\tv_mov_b32 %1, %0\n\tv_add_f32 %0, %0, %0\n\tv_mov_b32 %1, %0\n\tv_add_f32 %0, %0, %0\n\tv_mov_b32 %1, %0\n\tv_add_f32 %0, %0, %0\n\tv_mov_b32 %1, %0" : "+v"(dmy), "=&v"(dmy2));
#endif
                    ykeep = (kseg == (s & 15)) ? y : ykeep;
                    rp = r4; r4 = nr4; w4 = nw4; k4 = nk4; a4 = na4; b4 = nb4; vv = nvv;
                    nr4 = mr4; nw4 = mw4; nk4 = mk4; na4 = ma4; nb4 = mb4; nvv = mvv;
                    __builtin_amdgcn_sched_barrier(0);
                    if ((s & 15) == 15) yb[((s & 16) + kseg) * 16 + wave * 4 + rowl] = ykeep;
                }
            }
            __builtin_amdgcn_s_setprio(0);
            WKV_BAR();
            { const int vrow = rg * 16 + wave * 4 + rowl; *(f32x4*)(out + O_PWKV + ((unsigned)((l * 8 + b) * 8 + h) * 64u + vrow) * 64u + kseg * 4) = (f32x4){S0, S1, S2, S3};
              const float ylast = row16_allsum((S0 * rp[0] + S1 * rp[1]) + (S2 * rp[2] + S3 * rp[3]));
              if (kseg == 0) ymix[(rowbase + 2047u) * 1024u + 512u + h * 64 + vrow] = (bf16_t)(cvt_pk_bf16(ylast, 0.f) & 0xffffu); }
            WKV_BAR();
#undef DPPA
        }
    }
#undef WKV_BAR
}
__device__ __forceinline__ void phase_scan(PP P, int l, LAS unsigned char* lds, const Ids I) {
#pragma unroll 1
    for (int rep = 0; rep < (PROBE == 8 ? 2 : 1); ++rep) scan_lru(P, l, lds, I);
#pragma unroll 1
    for (int rep = 0; rep < (PROBE == 9 ? 2 : 1); ++rep) scan_wkv_sample(P, l, I);
    scan_wkv_prompt(P, l, lds, I);
}

__device__ __forceinline__ void split_pk(float a, float b, unsigned& hi, unsigned& lo) {
    hi = cvt_pk_bf16(a, b); lo = cvt_pk_bf16(a - __uint_as_float(hi << 16), b - __uint_as_float(hi & 0xffff0000u));
}
__device__ __forceinline__ void phase_m2(PP P, int l, LAS unsigned char* lds, const Ids I) {
    const int tid_local = make_tid(I.wv);
    const int tid = TID, d = tid; unsigned char* ws = P->ws;
    const bf16_t* PR = (const bf16_t*)(ws + WS_R1); const bf16_t* arr = (const bf16_t*)(ws + WS_R2); const size_t AS = (size_t)MT * 512;
    bf16_t* ymix = (bf16_t*)(ws + WS_HB);
    LAS bf16_t* SGH = (LAS bf16_t*)lds; LAS bf16_t* SGL = SGH + 16 * 136;
    LAS float* LY = (LAS float*)(SGL + 16 * 136); LAS float* LR = LY + 5632; LAS float* LK = LR + 5632; LAS float* LV = LK + 5632; LAS float* G = LV + 5632;
    const float* mu = P->in[I_MU] + (size_t)l * PW;
    const float lnw = P->in[I_LNW][l * 512 + d], lnb = P->in[I_LNB][l * 512 + d], rk = P->in[I_RK][l * 512 + d];
    const int lane = tid & 63, quad = lane >> 4, l15 = lane & 15, hd = __builtin_amdgcn_readfirstlane(tid >> 6);
    bf16x8 bfh[4][4], bfl[4][4];
#pragma unroll
    for (int nt = 0; nt < 4; ++nt) { const int dd = hd * 64 + nt * 16 + l15;
#pragma unroll
        for (int ks = 0; ks < 4; ++ks) { const float* gp = P->in[I_G2] + ((size_t)l * 128 + ks * 32 + quad * 8) * 512 + dd; unsigned h0, h1, h2, h3, l0, l1, l2, l3;
            split_pk(gp[0], gp[512], h0, l0); split_pk(gp[1024], gp[1536], h1, l1); split_pk(gp[2048], gp[2560], h2, l2); split_pk(gp[3072], gp[3584], h3, l3);
            bfh[nt][ks] = __builtin_bit_cast(bf16x8, (u32x4){h0, h1, h2, h3}); bfl[nt][ks] = __builtin_bit_cast(bf16x8, (u32x4){l0, l1, l2, l3}); } }
    for (int idx = tid; idx < 5 * 136; idx += 512) { SGH[11 * 136 + idx] = (bf16_t)0; SGL[11 * 136 + idx] = (bf16_t)0; }
    for (int u = BID; u < MT / 11; u += NB) {
        const int r0 = u * 11;
#pragma unroll
        for (int i = 0; i < 3; ++i) { const int idx = tid + 512 * i; if (idx < 11 * 128) { const int tok = idx >> 7, col = idx & 127, r = r0 + tok, t = t_in_seq(r);
            const float cur = bf2f(PR[(size_t)r * INW + 2688 + col]);
            const float prev = t > 0 ? bf2f(PR[(size_t)(r - 1) * INW + 2688 + col]) : (r < MTP ? 0.f : P->in[I_SSHIFT][((size_t)l * 128 + ((r - MTP) >> 2)) * PW + 1664 + col]);
            const float sg = sigmoidf(cur + (prev - cur) * mu[1664 + col]); const bf16_t h = f2bf(sg);
            SGH[tok * 136 + col] = h; SGL[tok * 136 + col] = f2bf(sg - bf2f(h)); } }
#pragma unroll
        for (int i = 0; i < 2; ++i) { const int idx = tid + 512 * i; if (idx < 11 * 64) { const int tok = idx >> 6, c8 = (idx & 63) * 8; const size_t r = (size_t)r0 + tok; float f[8];
            unpack8(*(const u32x4*)(ymix + r * 1024 + 512 + c8), f); *(LAS f32x4*)(LY + tok * 512 + c8) = (f32x4){f[0], f[1], f[2], f[3]}; *(LAS f32x4*)(LY + tok * 512 + c8 + 4) = (f32x4){f[4], f[5], f[6], f[7]};
            unpack8(*(const u32x4*)(arr + A_R * AS + r * 512 + c8), f); *(LAS f32x4*)(LR + tok * 512 + c8) = (f32x4){f[0], f[1], f[2], f[3]}; *(LAS f32x4*)(LR + tok * 512 + c8 + 4) = (f32x4){f[4], f[5], f[6], f[7]};
            unpack8(*(const u32x4*)(arr + A_KF * AS + r * 512 + c8), f); *(LAS f32x4*)(LK + tok * 512 + c8) = (f32x4){f[0], f[1], f[2], f[3]}; *(LAS f32x4*)(LK + tok * 512 + c8 + 4) = (f32x4){f[4], f[5], f[6], f[7]};
            unpack8(*(const u32x4*)(arr + A_V * AS + r * 512 + c8), f); *(LAS f32x4*)(LV + tok * 512 + c8) = (f32x4){f[0], f[1], f[2], f[3]}; *(LAS f32x4*)(LV + tok * 512 + c8 + 4) = (f32x4){f[4], f[5], f[6], f[7]}; } }
        __syncthreads();
        { f32x4 ag[4];
#pragma unroll
          for (int nt = 0; nt < 4; ++nt) ag[nt] = (f32x4){0.f, 0.f, 0.f, 0.f};
#pragma unroll
          for (int ks = 0; ks < 4; ++ks) { const bf16x8 fh = *(const LAS bf16x8*)(SGH + l15 * 136 + ks * 32 + quad * 8), fl = *(const LAS bf16x8*)(SGL + l15 * 136 + ks * 32 + quad * 8);
#pragma unroll
              for (int nt = 0; nt < 4; ++nt) { ag[nt] = __builtin_amdgcn_mfma_f32_16x16x32_bf16(fl, bfh[nt][ks], ag[nt], 0, 0, 0); ag[nt] = __builtin_amdgcn_mfma_f32_16x16x32_bf16(fh, bfl[nt][ks], ag[nt], 0, 0, 0);
                  ag[nt] = __builtin_amdgcn_mfma_f32_16x16x32_bf16(fh, bfh[nt][ks], ag[nt], 0, 0, 0); } }
#pragma unroll
          for (int nt = 0; nt < 4; ++nt)
#pragma unroll
              for (int j = 0; j < 4; ++j) if (quad * 4 + j < 11) G[(quad * 4 + j) * 512 + hd * 64 + nt * 16 + l15] = ag[nt][j]; }
        __syncthreads();
#pragma unroll 1
        for (int i = 0; i < 11; ++i) { const float y = LY[i * 512 + d], rr = LR[i * 512 + d], kf = LK[i * 512 + d], vv = LV[i * 512 + d], g = G[i * 512 + d];
            const float m = wave_sum(y) * (1.0f / 64.0f), dy = y - m, var = wave_sum(dy * dy) * (1.0f / 64.0f);
            const float yn = dy * rsqrtf(var + 64e-5f) * lnw + lnb;
            const float bs = wave_sum(rr * kf * rk);
            LY[i * 512 + d] = (yn + bs * vv) * g; }
        __syncthreads();
#pragma unroll
        for (int i = 0; i < 2; ++i) { const int idx = tid + 512 * i; if (idx < 11 * 64) { const int tok = idx >> 6, c8 = (idx & 63) * 8; const LAS float* lp = LY + tok * 512 + c8; const f32x4 a = *(const LAS f32x4*)lp, b = *(const LAS f32x4*)(lp + 4);
          u32x4 w; w.x = cvt_pk_bf16(a[0], a[1]); w.y = cvt_pk_bf16(a[2], a[3]); w.z = cvt_pk_bf16(b[0], b[1]); w.w = cvt_pk_bf16(b[2], b[3]);
          *(u32x4*)(ymix + ((size_t)r0 + tok) * 1024 + 512 + c8) = w; } }
        __syncthreads();
    }
}

#define XB_TMO      128
#define XB_XCNT(j)  (256  + 64 * (j))
#define XB_XSUB(j)  (1280 + 64 * (j))
#define XB_XGEN(j)  (2304 + 64 * (j))
#define XB_TOP      3328
#define XB_TOPGEN   3392
#define XCD_BAR_WORDS 3456
#define XB_SPIN_CAP (1u << 18)
__device__ __forceinline__ unsigned xb_ld(unsigned* p)              { return __hip_atomic_load(p, __ATOMIC_RELAXED, __HIP_MEMORY_SCOPE_AGENT); }
__device__ __forceinline__ unsigned xb_add(unsigned* p, unsigned v) { return __hip_atomic_fetch_add(p, v, __ATOMIC_RELAXED, __HIP_MEMORY_SCOPE_AGENT); }
__device__ __forceinline__ unsigned xb_xcc_id() { return (unsigned)__builtin_amdgcn_s_getreg((3 << 11) | 20) & 0xFu; }
#define XB_SPIN(cond, bar) do { unsigned _sp = 0; while (cond) { __builtin_amdgcn_s_sleep(1); \
    if ((++_sp & 255u) == 0u) { if (xb_ld(&(bar)[XB_TMO])) break; if (_sp > XB_SPIN_CAP) { atomicAdd(&(bar)[XB_TMO], 1u); break; } } } } while (0)
__device__ __forceinline__ void xcd_barrier_complete(unsigned* bar, unsigned x, unsigned G, unsigned& nloc, unsigned& nx) {
    unsigned sum, cnt, mine, sp = 0u;
    for (;;) {
        sum = 0u; cnt = 0u; mine = 0u;
#pragma unroll
        for (unsigned j = 0; j < 16; ++j) { const unsigned c = xb_ld(&bar[XB_XCNT(j)]); sum += c; cnt += (c > 0u) ? 1u : 0u; mine = (j == x) ? c : mine; }
        if (sum == G) break;
        __builtin_amdgcn_s_sleep(1);
        if ((++sp & 255u) == 0u) { if (xb_ld(&bar[XB_TMO])) break; if (sp > XB_SPIN_CAP) { atomicAdd(&bar[XB_TMO], 1u); break; } }
    }
    nloc = mine > 0u ? mine : 1u; nx = cnt > 0u ? cnt : 1u;
}
__device__ __forceinline__ void xcd_barrier(unsigned* bar, volatile LAS unsigned* st, const Ids I) {
    asm volatile("s_waitcnt vmcnt(0)" ::: "memory");
    __syncthreads();
    if (make_tid(I.wv) == 0) {
        const unsigned x = xb_xcc_id();
        __builtin_amdgcn_s_waitcnt(0);
        unsigned nloc = st[0], nx = st[1];
        if (nloc == 0u) { xcd_barrier_complete(bar, x, (unsigned)I.nb, nloc, nx); st[0] = nloc; st[1] = nx; }
        const unsigned old = xb_add(&bar[XB_XSUB(x)], 1u);
        const unsigned gen = old / nloc;
        if (old + 1u == (gen + 1u) * nloc) {
            __builtin_amdgcn_fence(__ATOMIC_RELEASE, "agent");
            asm volatile("s_waitcnt vmcnt(0)" ::: "memory");
            const unsigned og = xb_add(&bar[XB_TOP], 1u);
            const unsigned tg = og / nx;
            if (og + 1u == (tg + 1u) * nx) xb_add(&bar[XB_TOPGEN], 1u);
            else XB_SPIN(xb_ld(&bar[XB_TOPGEN]) == tg, bar);
            __builtin_amdgcn_fence(__ATOMIC_ACQUIRE, "agent");
            xb_add(&bar[XB_XGEN(x)], 1u);
            asm volatile("s_waitcnt vmcnt(0)" ::: "memory");
        } else {
            XB_SPIN(xb_ld(&bar[XB_XGEN(x)]) == gen, bar);
            __builtin_amdgcn_fence(__ATOMIC_ACQUIRE, "agent");
            asm volatile("s_waitcnt vmcnt(0)" ::: "memory");
        }
    }
    __syncthreads();
}

__global__ void __launch_bounds__(512) mega(Params Pval) {
    extern __shared__ __attribute__((aligned(16))) unsigned char lds_raw[];
    LAS unsigned char* lds = (LAS unsigned char*)lds_raw;
    cg::grid_group grid = cg::this_grid();
    const int NSTEP = 2 + 2 * 12 + 1;
    const int wave_s = __builtin_amdgcn_readfirstlane((int)threadIdx.x >> 6);
    {
        volatile LAS unsigned* st0 = (volatile LAS unsigned*)(lds + LDS_MAIN);
        if (threadIdx.x == 0) { st0[0] = 0u; st0[1] = 0u; (void)xb_add(&((unsigned*)Pval.ws)[XB_XCNT(xb_xcc_id())], 1u); }
        __syncthreads();
    }
#pragma unroll 1
    for (int step = 0; step < NSTEP; ++step) {
        Ids I; I.bid = (int)blockIdx.x; I.nb = (int)gridDim.x; int wv = wave_s;
        unsigned long long pv = (unsigned long long)__builtin_amdgcn_kernarg_segment_ptr();
        asm volatile("" : "+s"(wv), "+s"(I.bid), "+s"(I.nb), "+s"(pv));
        I.bid = __builtin_amdgcn_readfirstlane(I.bid); I.nb = __builtin_amdgcn_readfirstlane(I.nb);
        I.wv = __builtin_amdgcn_readfirstlane(wv);
        PP P = (PP)(((unsigned long long)(unsigned)__builtin_amdgcn_readfirstlane((int)(pv >> 32)) << 32) | (unsigned long long)(unsigned)__builtin_amdgcn_readfirstlane((int)pv));
        unsigned char* ws = P->ws;
        const bool mid = (step >= 2 && step < NSTEP - 1);
        const int l = mid ? (step - 2) / 12 : 0, sub = mid ? (step - 2) % 12 : -1;
        int nrep = 1;
#if PROBE == 1
        if (step == 1 || sub == 1 || sub == 4 || sub == 10) nrep = 2;
#elif PROBE == 2
        if (sub == 6) nrep = 2;
#elif PROBE == 3
        if (step == 0 || sub == 0 || sub == 3 || sub == 9 || sub == 5) nrep = 2;
#elif PROBE == 4
        if (step == 0) nrep = 2;
#elif PROBE == 5
        if (sub == 5) nrep = 2;
#elif PROBE == 6
        if (sub == 3 || sub == 9) nrep = 2;
#elif PROBE == 7
        if (step == 1) { for (int e = 0; e < 20; ++e) xcd_barrier((unsigned*)ws, (volatile LAS unsigned*)(lds + LDS_MAIN), I); }
#endif
#pragma unroll 1
        for (int rep = 0; rep < nrep; ++rep) {
        if (step == 0) phase_prologue(P, lds, I);
        else if (step == 1) {
            if (I.nb > 144) { if (I.bid < 72) { EpiAda E{(float*)(ws + WS_MOD), P->in[I_BADA]}; run_gemm(lds, (const bf16_t*)(ws + WS_AADA), (const bf16_t*)(ws + WS_R2), 256, 2 * 9216, 1024, E, I); }
                              else { Ids J = I; J.bid = I.bid - 72; J.nb = I.nb - 72; convert_layer(P, 0, lds, J); } }
            else { EpiAda E{(float*)(ws + WS_MOD), P->in[I_BADA]}; run_gemm(lds, (const bf16_t*)(ws + WS_AADA), (const bf16_t*)(ws + WS_R2), 256, 2 * 9216, 1024, E, I); convert_layer(P, 0, lds, I); } }
        else if (step == NSTEP - 1) phase_norm(P, 0, 3, FF / 256, (const float*)(ws + WS_MOD) + (size_t)1 * NMR * 9216 + 8 * 1024, 0.5f, I);
        else {
            const float* modl = (const float*)(ws + WS_MOD) + (size_t)l * NMR * 9216;
            if (sub == 0 || sub == 3 || sub == 9) {
                if (sub == 0 && l == 1) convert_layer(P, 1, lds, I);
                const int nsl = (sub == 0) ? (l == 1 ? FF / 256 : 0) : (sub == 3 ? FF / 256 : 1024 / 256);
                const float* fg = (sub == 0) ? (const float*)(ws + WS_MOD) + 8 * 1024 : modl + (sub == 3 ? 2 : 5) * 1024;
                phase_norm(P, l, sub == 0 ? 0 : (sub == 3 ? 1 : 2), nsl, fg, sub == 9 ? 1.0f : 0.5f, I);
            } else if (sub == 1 || sub == 10) {
                EpiSwiGLU E{(bf16_t*)(ws + WS_R1)}; run_gemm(lds, (const bf16_t*)(ws + WS_HB), (const bf16_t*)(ws + (sub == 1 ? WS_WGU1 : WS_WGU2)), MT, 2 * FF, 1024, E, I);
            } else if (sub == 2 || sub == 8 || sub == 11) {
                const int gk = sub == 2 ? 2 : (sub == 8 ? 5 : 8);
                const float scl = sub == 8 ? 1.0f : 0.5f; const int Kd = sub == 8 ? 1024 : FF;
                EpiResid E{P->out, modl + gk * 1024, scl};
                const bf16_t* A = (const bf16_t*)(ws + (sub == 8 ? WS_HB : WS_R1)); const bf16_t* Bt = (const bf16_t*)(ws + (sub == 2 ? WS_WD1 : (sub == 8 ? WS_WOUT : WS_WD2)));
                run_gemm(lds, A, Bt, MTP, 1024, Kd, E, I);
                EpiPartial EA{(float*)(ws + WS_R2)};
                run_gemm_splitk(lds, A + (size_t)MTP * Kd, Bt, MTS, 1024, Kd, 256, EA, I);
            } else if (sub == 4) {
                EpiProj E{(bf16_t*)(ws + WS_R1)}; run_gemm(lds, (const bf16_t*)(ws + WS_HB), (const bf16_t*)(ws + WS_WIN), MT, INW, 1024, E, I);
            } else if (sub == 5) phase_m1(P, l, lds, I);
            else if (sub == 6) phase_scan(P, l, lds, I);
            else phase_m2(P, l, lds, I);
        }
        if (step == 0) grid.sync();
        else if (step != NSTEP - 1) xcd_barrier((unsigned*)ws, (volatile LAS unsigned*)(lds + LDS_MAIN), I);
        }
    }
}

extern "C" void kernel_launch(void* const* d_in, const int* in_sizes, int n_in, void* d_out, int out_size, void* d_ws, size_t ws_size, hipStream_t stream) {
    static int grid_blocks = 0;
    if (!grid_blocks) {
        if (n_in != 40 || ws_size < WS_END) { fprintf(stderr, "kernel_launch: need 40 inputs and %zu bytes of workspace; got %d, %zu\n", (size_t)WS_END, n_in, ws_size); grid_blocks = -1; return; }
        int dev = 0, cus = 0, per_cu = 0;
        hipGetDevice(&dev);
        hipDeviceGetAttribute(&cus, hipDeviceAttributeMultiprocessorCount, dev);
        hipFuncSetAttribute((const void*)mega, hipFuncAttributeMaxDynamicSharedMemorySize, LDS_BYTES);
        hipOccupancyMaxActiveBlocksPerMultiprocessor(&per_cu, (const void*)mega, 512, LDS_BYTES);
        if (per_cu < 1) { fprintf(stderr, "kernel_launch: occupancy query says %d blocks per CU\n", per_cu); grid_blocks = -1; return; }
        grid_blocks = cus;
    }
    if (grid_blocks < 0) return;
    Params p{};
    for (int i = 0; i < 40; ++i) p.in[i] = (const float*)d_in[i];
    p.out = (float*)d_out; p.ws = (unsigned char*)d_ws;
    if (hipMemsetAsync(d_ws, 0, 16384, stream) != hipSuccess) { fprintf(stderr, "kernel_launch: memset of the barrier words failed\n"); return; }
    void* args[] = {&p};
    hipError_t e = hipLaunchCooperativeKernel((const void*)mega, dim3(grid_blocks), dim3(512), args, LDS_BYTES, stream);
    if (e != hipSuccess) fprintf(stderr, "cooperative launch failed: %s (grid %d)\n", hipGetErrorString(e), grid_blocks);
}
```
